# Optimizing an MI355X kernel written in HIP

```python
import jax, jax.numpy as jnp
from jax import lax
import numpy as np

D_MODEL = 2048
BATCH = 4
SEQ = 2048
DEPTH = 1
DEC_BATCH = 32
DEC_SEQ = 1
PAST_LEN = 16384
PAGE_SIZE = 128

MIX_WIDTH = D_MODEL
ATTN_WIDTH = MIX_WIDTH // 2
CONV_CH = MIX_WIDTH - ATTN_WIDTH
HEAD_DIM = 64
N_HEADS = ATTN_WIDTH // HEAD_DIM
N_KV_HEADS = 4
GROUP = N_HEADS // N_KV_HEADS
KV_DIM = N_KV_HEADS * HEAD_DIM
WINDOW = 128
CONV_WIDTH = 31
D_FF = 4 * D_MODEL
ROPE_THETA = 10000.0
EPS = 1e-6
IN_COLS = ATTN_WIDTH + 2 * KV_DIM + 2 * CONV_CH
NEG = -1e30

kernel_name = "hymba_conformer_swa_sink_decoder_step"


def rms_norm(x, g):
    xf = x.astype(jnp.float32)
    y = xf * lax.rsqrt(jnp.mean(xf * xf, axis=-1, keepdims=True) + EPS)
    return (y * g.astype(jnp.float32)).astype(x.dtype)


def layer_norm(x, g, b):
    xf = x.astype(jnp.float32)
    mu = jnp.mean(xf, axis=-1, keepdims=True)
    xc = xf - mu
    y = xc * lax.rsqrt(jnp.mean(xc * xc, axis=-1, keepdims=True) + EPS)
    return (y * g.astype(jnp.float32) + b.astype(jnp.float32)).astype(x.dtype)


def rope(x, pos):
    half = HEAD_DIM // 2
    inv = ROPE_THETA ** (-jnp.arange(half, dtype=jnp.float32) / half)
    ang = pos.astype(jnp.float32)[:, None] * inv[None, :]
    cos = jnp.cos(ang)[:, None, :]
    sin = jnp.sin(ang)[:, None, :]
    xf = x.astype(jnp.float32)
    x1, x2 = xf[..., :half], xf[..., half:]
    return jnp.concatenate([x1 * cos - x2 * sin, x2 * cos + x1 * sin], axis=-1).astype(x.dtype)


def softmax_with_sink(s, sinks, mask):
    sink = sinks.astype(jnp.float32).reshape(N_KV_HEADS, GROUP, 1, 1)
    s = jnp.where(mask, s, NEG)
    m = jnp.maximum(jnp.max(s, axis=-1, keepdims=True), sink)
    p = jnp.exp(s - m)
    return p / (jnp.sum(p, axis=-1, keepdims=True) + jnp.exp(sink - m))


def attn_prompt(q, k, v, sinks):
    B, S = q.shape[0], q.shape[1]
    NB = S // WINDOW
    qb = q.reshape(B, NB, WINDOW, N_KV_HEADS, GROUP, HEAD_DIM)
    kb = k.reshape(B, NB, WINDOW, N_KV_HEADS, HEAD_DIM)
    vb = v.reshape(B, NB, WINDOW, N_KV_HEADS, HEAD_DIM)
    pad = ((0, 0), (1, 0), (0, 0), (0, 0), (0, 0))
    kk = jnp.concatenate([jnp.pad(kb, pad)[:, :-1], kb], axis=2)
    vv = jnp.concatenate([jnp.pad(vb, pad)[:, :-1], vb], axis=2)
    s = jnp.einsum('bnqkgd,bnskd->bnkgqs', qb, kk,
                   preferred_element_type=jnp.float32) * (HEAD_DIM ** -0.5)
    qi = jnp.arange(WINDOW)[:, None] + WINDOW
    kj = jnp.arange(2 * WINDOW)[None, :]
    diff = qi - kj
    band = (diff >= 0) & (diff < WINDOW)
    blk = jnp.arange(NB)[:, None, None]
    valid = (blk > 0) | (kj[None] >= WINDOW)
    mask = (band[None] & valid)[None, :, None, None]
    p = softmax_with_sink(s, sinks, mask)
    o = jnp.einsum('bnkgqs,bnskd->bnqkgd', p.astype(v.dtype), vv)
    return o.reshape(B, S, N_HEADS * HEAD_DIM)


def attn_sample(q, k, v, k_buf, v_buf, sinks):
    B, DS = q.shape[0], q.shape[1]
    WB = k_buf.shape[1]
    kk = jnp.concatenate([k_buf, k], axis=1)
    vv = jnp.concatenate([v_buf, v], axis=1)
    qg = q.reshape(B, DS, N_KV_HEADS, GROUP, HEAD_DIM)
    s = jnp.einsum('bqkgd,bskd->bkgqs', qg, kk,
                   preferred_element_type=jnp.float32) * (HEAD_DIM ** -0.5)
    q_pos = PAST_LEN + jnp.arange(DS)
    k_pos = PAST_LEN - WB + jnp.arange(WB + DS)
    diff = q_pos[:, None] - k_pos[None, :]
    mask = (diff >= 0) & (diff < WINDOW)
    p = softmax_with_sink(s, sinks, mask)
    o = jnp.einsum('bkgqs,bskd->bqkgd', p.astype(v.dtype), vv)
    return o.reshape(B, DS, N_HEADS * HEAD_DIM), kk[:, -WB:], vv[:, -WB:]


def causal_dwconv(u, buf, w, b):
    full = jnp.concatenate([buf, u], axis=1)
    y = lax.conv_general_dilated(full, w[:, None, :], window_strides=(1,), padding='VALID',
                                 dimension_numbers=('NWC', 'WIO', 'NWC'),
                                 feature_group_count=CONV_CH)
    return y + b, full[:, -(CONV_WIDTH - 1):]


def layer(x, pos, k_buf, v_buf, c_buf, norm_mix_g, w_in, q_norm_g, k_norm_g, sinks,
          conv_w, conv_b, conv_ln_g, conv_ln_b, w_out, norm_mlp_g, w_up, w_down, is_prompt):
    B, S = x.shape[0], x.shape[1]
    h = rms_norm(x, norm_mix_g)
    z = h @ w_in
    q = z[..., :ATTN_WIDTH].reshape(B, S, N_HEADS, HEAD_DIM)
    k = z[..., ATTN_WIDTH:ATTN_WIDTH + KV_DIM].reshape(B, S, N_KV_HEADS, HEAD_DIM)
    v = z[..., ATTN_WIDTH + KV_DIM:ATTN_WIDTH + 2 * KV_DIM].reshape(B, S, N_KV_HEADS, HEAD_DIM)
    u_val = z[..., ATTN_WIDTH + 2 * KV_DIM:ATTN_WIDTH + 2 * KV_DIM + CONV_CH]
    u_gate = z[..., ATTN_WIDTH + 2 * KV_DIM + CONV_CH:]
    q = rope(rms_norm(q, q_norm_g), pos)
    k = rope(rms_norm(k, k_norm_g), pos)
    if is_prompt:
        a = attn_prompt(q, k, v, sinks)
        wb = min(WINDOW, S)
        new_k, new_v = k[:, -wb:], v[:, -wb:]
    else:
        a, new_k, new_v = attn_sample(q, k, v, k_buf, v_buf, sinks)
    u = u_val * jax.nn.sigmoid(u_gate)
    c, new_c = causal_dwconv(u, c_buf, conv_w, conv_b)
    c = jax.nn.silu(layer_norm(c, conv_ln_g, conv_ln_b))
    x = x + jnp.concatenate([a, c], axis=-1) @ w_out
    hm = rms_norm(x, norm_mlp_g)
    x = x + jnp.square(jax.nn.relu(hm @ w_up)) @ w_down
    return x, new_k, new_v, new_c


def setup_inputs(seed: int = 0) -> dict:
    key = jax.random.key(seed)
    ks = jax.random.split(key, 20)
    f32 = jnp.float32
    wb = min(WINDOW, PAST_LEN)
    nrm = lambda k, shp, s: jax.random.normal(k, shp, f32) * s
    return {
        "x_prompt": nrm(ks[0], (BATCH, SEQ, D_MODEL), 1.0),
        "x_sample": nrm(ks[1], (DEC_BATCH, DEC_SEQ, D_MODEL), 1.0),
        "cache_k": nrm(ks[2], (DEPTH, DEC_BATCH, wb, N_KV_HEADS, HEAD_DIM), 1.0),
        "cache_v": nrm(ks[3], (DEPTH, DEC_BATCH, wb, N_KV_HEADS, HEAD_DIM), 1.0),
        "state_conv": nrm(ks[4], (DEPTH, DEC_BATCH, CONV_WIDTH - 1, CONV_CH), 0.5),
        "norm_mix_g": 1.0 + nrm(ks[5], (DEPTH, D_MODEL), 0.02),
        "w_in": nrm(ks[6], (DEPTH, D_MODEL, IN_COLS), D_MODEL ** -0.5),
        "q_norm_g": 1.0 + nrm(ks[7], (DEPTH, HEAD_DIM), 0.02),
        "k_norm_g": 1.0 + nrm(ks[8], (DEPTH, HEAD_DIM), 0.02),
        "sinks": nrm(ks[9], (DEPTH, N_HEADS), 0.5),
        "conv_w": nrm(ks[10], (DEPTH, CONV_WIDTH, CONV_CH), CONV_WIDTH ** -0.5),
        "conv_b": nrm(ks[11], (DEPTH, CONV_CH), 0.02),
        "conv_ln_g": 1.0 + nrm(ks[12], (DEPTH, CONV_CH), 0.02),
        "conv_ln_b": nrm(ks[13], (DEPTH, CONV_CH), 0.02),
        "w_out": nrm(ks[14], (DEPTH, MIX_WIDTH, D_MODEL), MIX_WIDTH ** -0.5),
        "norm_mlp_g": 1.0 + nrm(ks[15], (DEPTH, D_MODEL), 0.02),
        "w_up": nrm(ks[16], (DEPTH, D_MODEL, D_FF), D_MODEL ** -0.5),
        "w_down": nrm(ks[17], (DEPTH, D_FF, D_MODEL), D_FF ** -0.5),
    }


def reference(x_prompt, x_sample, cache_k, cache_v, state_conv, norm_mix_g, w_in, q_norm_g,
              k_norm_g, sinks, conv_w, conv_b, conv_ln_g, conv_ln_b, w_out, norm_mlp_g,
              w_up, w_down):
    pos_p = jnp.arange(x_prompt.shape[1])
    pos_s = PAST_LEN + jnp.arange(x_sample.shape[1])
    zero_conv = jnp.zeros((x_prompt.shape[0], CONV_WIDTH - 1, CONV_CH), x_prompt.dtype)
    xp, xs = x_prompt, x_sample
    kp, vp, cp, ksm, vsm, csm = [], [], [], [], [], []
    for l in range(DEPTH):
        w = (norm_mix_g[l], w_in[l], q_norm_g[l], k_norm_g[l], sinks[l], conv_w[l], conv_b[l],
             conv_ln_g[l], conv_ln_b[l], w_out[l], norm_mlp_g[l], w_up[l], w_down[l])
        xp, nk, nv, nc = layer(xp, pos_p, None, None, zero_conv, *w, is_prompt=True)
        kp.append(nk); vp.append(nv); cp.append(nc)
        xs, nk, nv, nc = layer(xs, pos_s, cache_k[l], cache_v[l], state_conv[l], *w,
                               is_prompt=False)
        ksm.append(nk); vsm.append(nv); csm.append(nc)
    new_k_prompt = jnp.stack(kp)
    new_v_prompt = jnp.stack(vp)
    new_conv_prompt = jnp.stack(cp)
    new_k_sample = jnp.stack(ksm)
    new_v_sample = jnp.stack(vsm)
    new_conv_sample = jnp.stack(csm)
    return (xp, xs, new_k_prompt, new_v_prompt, new_conv_prompt, new_k_sample, new_v_sample, new_conv_sample)
```

```cpp
#include <hip/hip_runtime.h>
#include <hip/hip_cooperative_groups.h>
#include <cstdio>
#include <cstdint>
namespace cg = cooperative_groups;
#define MK_N_LAUNCHES 1
namespace pg8 {
#define PG8_LAS __attribute__((address_space(3)))
typedef unsigned short bf16_t;
typedef short bf16x8 __attribute__((ext_vector_type(8)));
typedef float f32x4 __attribute__((ext_vector_type(4)));
typedef unsigned u32x4 __attribute__((ext_vector_type(4)));
constexpr int BM = 256, BK = 64, HALF = 128, HTB = HALF * BK * 2  , STAGE_BYTES = 8 * HTB, NXCD = 8, WGM = 8;

__host__ __device__ __forceinline__ int lds_byte(int r, int c) { const int st = (r >> 4) * 2 + (c >> 5), rr = r & 15, cc = c & 31, ob = rr * 64 + cc * 2; return st * 1024 + (ob ^ (((ob >> 9) & 1) << 5)); }
__host__ __device__ __forceinline__ void stage_rc(int b, int& R, int& C) { const int st = b / 1024, sb = b % 1024, swz = sb ^ (((sb >> 9) & 1) << 5); R = (st >> 1) * 16 + swz / 64; C = (st & 1) * 32 + (swz % 64) / 2; }
__host__ __device__ __forceinline__ int perm32(int rho) { const int n = rho >> 4, i = rho & 15; return 8 * (i >> 2) + 4 * n + (i & 3); }

struct Unit { int pm, pn; };
struct Gemm { const bf16_t* A; const bf16_t* Bt; int M, N, K; };

struct StaticOrder {
    int nM, nN, nwg, G, c;
    __host__ __device__ void init(int M, int N, int G_, int c_) { nM = M / BM; nN = N / BM; nwg = nM * nN; G = G_; c = c_; }
    __host__ __device__ bool next(int i, Unit& u) const {
        const long L = (long)i * G + c; if (L >= nwg) return false;
        int wgid = (int)L; { const int q = nwg / NXCD, r = nwg % NXCD, xcd = wgid % NXCD, off = wgid / NXCD; wgid = (xcd < r ? xcd * (q + 1) : r * (q + 1) + (xcd - r) * q) + off; }
        const int nig = WGM * nN, gid = wgid / nig, fm = gid * WGM, gsz = (nM - fm) < WGM ? (nM - fm) : WGM;
        u.pm = fm + ((wgid % nig) % gsz); u.pn = (wgid % nig) / gsz; return true;
    }
    __device__ __forceinline__ void a_ready(const Unit&) const {}
    __device__ __forceinline__ void done(const Unit&) const {}
};

__device__ __forceinline__ unsigned cvt_pk_bf16(float lo, float hi) { unsigned r; asm volatile("v_cvt_pk_bf16_f32 %0, %1, %2" : "=v"(r) : "v"(lo), "v"(hi)); return r; }
typedef float f32x2 __attribute__((ext_vector_type(2)));
template <class Epi, class Sched, bool ALIGN_EPI = false, bool SP2 = false>
__device__ __forceinline__ void gemm_phase(PG8_LAS unsigned char* lds, const Gemm g, const Sched& S, const Epi& E) {
    const int tid = threadIdx.x, wid = __builtin_amdgcn_readfirstlane(tid >> 6), lane = tid & 63, wr = wid >> 2, wc = wid & 3, fr = lane & 15, fq = lane >> 4;
    const int K = g.K, nt = K / BK;
    unsigned voffA[2], voffB[2];
#pragma unroll
    for (int i = 0; i < 2; ++i) { int R, C; stage_rc(tid * 16 + i * 8192, R, C); const int Rb = Epi::PERM ? ((R & ~31) + perm32(R & 31)) : R;
        voffA[i] = (unsigned)(R * K + C) * 2u; voffB[i] = (unsigned)(Rb * K + C) * 2u; }
    const size_t kstep = (size_t)(BK * 2);
    const size_t hstep = (size_t)HALF * K * 2;
    const size_t tstep = 2 * hstep;
    const unsigned ldsw = (unsigned)wid * 1024u;
    const int aoff = lds_byte(wr * 64 + fr, fq * 8), boff = lds_byte(wc * 32 + fr, fq * 8);
#define PG8_SA(b, h) (((b) * 2 + (h)) * HTB)
#define PG8_SB(b, h) ((4 + (b) * 2 + (h)) * HTB)
#define PG8_STAGE(bufoff, gbase, voff) do { _Pragma("unroll") for (int _i = 0; _i < 2; ++_i) \
        __builtin_amdgcn_global_load_lds((const unsigned*)((const char*)(gbase) + (voff)[_i]), (PG8_LAS unsigned*)(lds + (bufoff) + ldsw + _i * 8192), 16, 0, 0); } while (0)
#define PG8_LDA(dst, b, h) do { _Pragma("unroll") for (int m = 0; m < 4; ++m) _Pragma("unroll") for (int k = 0; k < 2; ++k) dst[m][k] = *(const PG8_LAS bf16x8*)(lds + PG8_SA(b, h) + aoff + m * 2048 + k * 1024); } while (0)
#define PG8_LDB(dst, b, h) do { _Pragma("unroll") for (int n = 0; n < 2; ++n) _Pragma("unroll") for (int k = 0; k < 2; ++k) dst[n][k] = *(const PG8_LAS bf16x8*)(lds + PG8_SB(b, h) + boff + n * 2048 + k * 1024); } while (0)
#define PG8_MMA(ai, bj, At, Bt) do { __builtin_amdgcn_s_setprio(1); _Pragma("unroll") for (int m = 0; m < 4; ++m) _Pragma("unroll") for (int n = 0; n < 2; ++n) _Pragma("unroll") for (int k = 0; k < 2; ++k) \
        acc[ai][bj][m][n] = __builtin_amdgcn_mfma_f32_16x16x32_bf16(Bt[n][k], At[m][k], acc[ai][bj][m][n], 0, 0, 0); __builtin_amdgcn_s_setprio(0); } while (0)
#define PG8_WAIT_V(n) asm volatile("s_waitcnt vmcnt(" #n ")" ::: "memory")
#define PG8_WAIT_L(n) asm volatile("s_waitcnt lgkmcnt(" #n ")" ::: "memory")
#define PG8_BAR __builtin_amdgcn_s_barrier()
#define PG8_SCHED __builtin_amdgcn_sched_barrier(0)
    Unit cur, nxt; int ui = 0;
    if (!S.next(0, cur)) return;
    f32x4 acc[2][2][4][2];
#pragma unroll
    for (int a = 0; a < 2; ++a)
#pragma unroll
        for (int b = 0; b < 2; ++b)
#pragma unroll
            for (int m = 0; m < 4; ++m)
#pragma unroll
                for (int n = 0; n < 2; ++n) acc[a][b][m][n] = (f32x4){0.f, 0.f, 0.f, 0.f};
    bf16x8 At[4][2], B0[2][2], B1[2][2];
    const char* cA = (const char*)g.A + (size_t)cur.pm * tstep; const char* cB = (const char*)g.Bt + (size_t)cur.pn * tstep;
    S.a_ready(cur);
    if constexpr (SP2) {
        PG8_STAGE(PG8_SB(0, 0), cB, voffB); PG8_STAGE(PG8_SB(0, 1), cB + hstep, voffB); PG8_STAGE(PG8_SA(0, 0), cA, voffA); PG8_STAGE(PG8_SA(0, 1), cA + hstep, voffA);
        if (wr == 1) PG8_BAR;
        PG8_WAIT_V(2); PG8_BAR;
        PG8_STAGE(PG8_SB(1, 0), cB + kstep, voffB); PG8_STAGE(PG8_SA(1, 0), cA + kstep, voffA); PG8_STAGE(PG8_SB(1, 1), cB + hstep + kstep, voffB);
        PG8_WAIT_V(6); PG8_BAR;
    } else {
        PG8_STAGE(PG8_SB(0, 0), cB, voffB); PG8_STAGE(PG8_SA(0, 0), cA, voffA); PG8_STAGE(PG8_SB(0, 1), cB + hstep, voffB); PG8_STAGE(PG8_SA(0, 1), cA + hstep, voffA);
        if (wr == 1) PG8_BAR;
        PG8_WAIT_V(4); PG8_BAR;
        PG8_STAGE(PG8_SB(1, 0), cB + kstep, voffB); PG8_STAGE(PG8_SA(1, 0), cA + kstep, voffA); PG8_STAGE(PG8_SB(1, 1), cB + hstep + kstep, voffB);
        PG8_WAIT_V(6); PG8_BAR;
    }
    for (;;) {
        const bool has_next = S.next(ui + 1, nxt);
        const char* nA = has_next ? (const char*)g.A + (size_t)nxt.pm * tstep : cA; const char* nB = has_next ? (const char*)g.Bt + (size_t)nxt.pn * tstep : cB;
        for (int t = 0; t < nt; t += 2) {
            const bool last = (t == nt - 2);
            const char* a1 = cA + (size_t)(t + 1) * kstep;
            const char* a2 = last ? nA : cA + (size_t)(t + 2) * kstep; const char* b2 = last ? nB : cB + (size_t)(t + 2) * kstep;
            const char* a3 = a2 + kstep; const char* b3 = b2 + kstep;
            if (last && has_next) S.a_ready(nxt);
            if constexpr (SP2) {
            PG8_LDB(B0, 0, 0); PG8_LDB(B1, 0, 1); PG8_SCHED; PG8_LDA(At, 0, 0); PG8_STAGE(PG8_SA(1, 1), a1 + hstep, voffA);
            PG8_WAIT_V(8); PG8_WAIT_L(0); PG8_BAR; PG8_MMA(0, 0, At, B0); PG8_MMA(0, 1, At, B1); PG8_BAR; PG8_SCHED;
            PG8_LDA(At, 0, 1); PG8_STAGE(PG8_SB(0, 0), b2, voffB); PG8_STAGE(PG8_SB(0, 1), b2 + hstep, voffB); PG8_STAGE(PG8_SA(0, 0), a2, voffA);
            PG8_WAIT_V(8); PG8_WAIT_L(0); PG8_BAR; PG8_MMA(1, 0, At, B0); PG8_MMA(1, 1, At, B1); PG8_BAR; PG8_SCHED;
            PG8_LDB(B0, 1, 0); PG8_LDB(B1, 1, 1); PG8_SCHED; PG8_LDA(At, 1, 0); PG8_STAGE(PG8_SA(0, 1), a2 + hstep, voffA);
            PG8_WAIT_V(8); PG8_WAIT_L(0); PG8_BAR; PG8_MMA(0, 0, At, B0); PG8_MMA(0, 1, At, B1); PG8_BAR; PG8_SCHED;
            PG8_LDA(At, 1, 1); PG8_STAGE(PG8_SB(1, 0), b3, voffB); PG8_STAGE(PG8_SB(1, 1), b3 + hstep, voffB); PG8_STAGE(PG8_SA(1, 0), a3, voffA);
            PG8_WAIT_V(8); PG8_WAIT_L(0); PG8_BAR; PG8_MMA(1, 0, At, B0); PG8_MMA(1, 1, At, B1); PG8_BAR; PG8_SCHED;
            } else {
            PG8_LDB(B0, 0, 0); PG8_SCHED; PG8_LDA(At, 0, 0); PG8_STAGE(PG8_SA(1, 1), a1 + hstep, voffA);
            PG8_WAIT_L(8); PG8_BAR; PG8_WAIT_L(0); PG8_MMA(0, 0, At, B0); PG8_BAR; PG8_SCHED;
            PG8_LDB(B1, 0, 1); PG8_STAGE(PG8_SB(0, 0), b2, voffB);
            PG8_BAR; PG8_WAIT_L(0); PG8_MMA(0, 1, At, B1); PG8_BAR;
            PG8_LDA(At, 0, 1); PG8_STAGE(PG8_SA(0, 0), a2, voffA);
            PG8_BAR; PG8_WAIT_L(0); PG8_MMA(1, 0, At, B0); PG8_BAR; PG8_SCHED;
            PG8_STAGE(PG8_SB(0, 1), b2 + hstep, voffB);
            PG8_WAIT_V(6); PG8_BAR; PG8_MMA(1, 1, At, B1); PG8_BAR;
            PG8_LDB(B0, 1, 0); PG8_SCHED; PG8_LDA(At, 1, 0); PG8_STAGE(PG8_SA(0, 1), a2 + hstep, voffA);
            PG8_WAIT_L(8); PG8_BAR; PG8_WAIT_L(0); PG8_MMA(0, 0, At, B0); PG8_BAR; PG8_SCHED;
            PG8_LDB(B1, 1, 1); PG8_STAGE(PG8_SB(1, 0), b3, voffB);
            PG8_BAR; PG8_WAIT_L(0); PG8_MMA(0, 1, At, B1); PG8_BAR;
            PG8_LDA(At, 1, 1); PG8_STAGE(PG8_SA(1, 0), a3, voffA);
            PG8_BAR; PG8_WAIT_L(0); PG8_MMA(1, 0, At, B0); PG8_BAR; PG8_SCHED;
            PG8_STAGE(PG8_SB(1, 1), b3 + hstep, voffB);
            PG8_WAIT_V(6); PG8_BAR; PG8_MMA(1, 1, At, B1); PG8_BAR;
            }
        }
        if constexpr (ALIGN_EPI) { if (wr == 0) PG8_BAR; }
        if constexpr (!Epi::AFTER_DRAIN) { E(acc, cur, wr, wc, fr, fq); S.done(cur); }
        if (!has_next) break;
#pragma unroll
        for (int a = 0; a < 2; ++a)
#pragma unroll
            for (int b = 0; b < 2; ++b)
#pragma unroll
                for (int m = 0; m < 4; ++m)
#pragma unroll
                    for (int n = 0; n < 2; ++n) acc[a][b][m][n] = (f32x4){0.f, 0.f, 0.f, 0.f};
        cur = nxt; cA = nA; cB = nB; ++ui;
        if constexpr (ALIGN_EPI) { if (wr == 1) PG8_BAR; }
    }
    PG8_WAIT_V(0);
    if constexpr (!ALIGN_EPI) { if (wr == 0) PG8_BAR; }
    PG8_BAR;
    if constexpr (Epi::AFTER_DRAIN) { E.fused(acc, cur, wr, wc, fr, fq, lds, wid, lane); S.done(cur); }
#undef PG8_SA
#undef PG8_SB
#undef PG8_STAGE
#undef PG8_LDA
#undef PG8_LDB
#undef PG8_MMA
#undef PG8_WAIT_V
#undef PG8_WAIT_L
#undef PG8_BAR
#undef PG8_SCHED
}
}
#define GAS __attribute__((address_space(1)))
#define LAS __attribute__((address_space(3)))
#define XB_TMO      128
#define XB_XCNT(j)  (256  + 64 * (j))
#define XB_XSUB(j)  (1280 + 64 * (j))
#define XB_XGEN(j)  (2304 + 64 * (j))
#define XB_TOP      3328
#define XB_TOPGEN   3392
#define XCD_BAR_WORDS 3456
#define XB_SPIN_CAP (1u << 18)

__device__ __forceinline__ unsigned xb_ld(unsigned* p)              { return __hip_atomic_load(p, __ATOMIC_RELAXED, __HIP_MEMORY_SCOPE_AGENT); }
__device__ __forceinline__ unsigned xb_add(unsigned* p, unsigned v) { return __hip_atomic_fetch_add(p, v, __ATOMIC_RELAXED, __HIP_MEMORY_SCOPE_AGENT); }
__device__ __forceinline__ unsigned xb_xcc_id() { return (unsigned)__builtin_amdgcn_s_getreg((3 << 11) | 20) & 0xFu; }
#define XB_SPIN(cond, bar) do { unsigned _sp = 0; while (cond) { __builtin_amdgcn_s_sleep(1); \
    if ((++_sp & 255u) == 0u) { if (xb_ld(&(bar)[XB_TMO])) break; if (_sp > XB_SPIN_CAP) { atomicAdd(&(bar)[XB_TMO], 1u); break; } } } } while (0)

struct XcdBarrier {
    unsigned* bar; unsigned x;
    volatile LAS unsigned* st;
};

__device__ __forceinline__ XcdBarrier xcd_barrier_post(unsigned* bar, volatile LAS unsigned* st) {
    XcdBarrier b; b.bar = bar; b.x = xb_xcc_id(); b.st = st;
    if (threadIdx.x == 0) (void)xb_add(&bar[XB_XCNT(b.x)], 1u);
    return b;
}
__device__ __forceinline__ void xcd_barrier_complete(unsigned* bar, unsigned x, unsigned& nloc, unsigned& nx) {
    const unsigned G = gridDim.x * gridDim.y * gridDim.z;
    unsigned sum, cnt, mine, sp = 0u;
    for (;;) {
        sum = 0u; cnt = 0u; mine = 0u;
#pragma unroll
        for (unsigned j = 0; j < 16; ++j) { const unsigned c = xb_ld(&bar[XB_XCNT(j)]); sum += c; cnt += (c > 0u) ? 1u : 0u; mine = (j == x) ? c : mine; }
        if (sum == G) break;
        __builtin_amdgcn_s_sleep(1);
        if ((++sp & 255u) == 0u) { if (xb_ld(&bar[XB_TMO])) break; if (sp > XB_SPIN_CAP) { atomicAdd(&bar[XB_TMO], 1u); break; } }
    }
    nloc = mine > 0u ? mine : 1u; nx = cnt > 0u ? cnt : 1u;
}

__device__ __forceinline__ void xcd_barrier(const XcdBarrier& b) {
    asm volatile("s_waitcnt vmcnt(0)" ::: "memory");
    __syncthreads();
    if (threadIdx.x == 0) {
        unsigned* bar = b.bar;
        __builtin_amdgcn_s_waitcnt(0);
        unsigned nloc = b.st[0], nx = b.st[1];
        if (nloc == 0u) { xcd_barrier_complete(bar, b.x, nloc, nx); b.st[0] = nloc; b.st[1] = nx; }
        const unsigned old = xb_add(&bar[XB_XSUB(b.x)], 1u);
        const unsigned gen = old / nloc;
        if (old + 1u == (gen + 1u) * nloc) {
            __builtin_amdgcn_fence(__ATOMIC_RELEASE, "agent");
            asm volatile("s_waitcnt vmcnt(0)" ::: "memory");
            const unsigned og = xb_add(&bar[XB_TOP], 1u);
            const unsigned tg = og / nx;
            if (og + 1u == (tg + 1u) * nx) xb_add(&bar[XB_TOPGEN], 1u);
            else XB_SPIN(xb_ld(&bar[XB_TOPGEN]) == tg, bar);
            __builtin_amdgcn_fence(__ATOMIC_ACQUIRE, "agent");
            xb_add(&bar[XB_XGEN(b.x)], 1u);
            asm volatile("s_waitcnt vmcnt(0)" ::: "memory");
        } else {
            XB_SPIN(xb_ld(&bar[XB_XGEN(b.x)]) == gen, bar);
            __builtin_amdgcn_fence(__ATOMIC_ACQUIRE, "agent");
            asm volatile("s_waitcnt vmcnt(0)" ::: "memory");
        }
    }
    __syncthreads();
}

#ifndef MK_N_LAUNCHES
#define MK_N_LAUNCHES 1
#endif
constexpr int NWAVES = 8;
constexpr int DM = 2048, SEQ = 2048, NBATCH = 4, MP = NBATCH * SEQ, MS = 32, MT = MP + MS;
constexpr int INC = 3584, FF = 8192, NH = 16, NKV = 4, HD = 64, CCH = 1024, CW = 31;
constexpr float EPS = 1e-6f;
constexpr size_t O_YP = 0, O_YS = (size_t)MP * DM, O_KP = O_YS + (size_t)MS * DM, O_VP = O_KP + 131072, O_CP = O_VP + 131072,
                 O_KS = O_CP + 122880, O_VS = O_KS + 1048576, O_CS = O_VS + 1048576, O_END = O_CS + 983040;
constexpr size_t MiB = 1u << 20;
constexpr size_t WS_CTL = 0, CTL_ZERO_BYTES = 1 * MiB;
constexpr size_t WS_SSQ = 512 * 1024;
constexpr size_t WS_COS = 1 * MiB, WS_SIN = 2 * MiB;
constexpr size_t WS_ZS = 3 * MiB;
constexpr size_t WS_WIN = 4 * MiB, WS_WOUT = 18 * MiB, WS_WUP = 26 * MiB, WS_WDN = 58 * MiB;
constexpr size_t WS_X1G = 90 * MiB;
constexpr size_t WS_HID = 123 * MiB;
constexpr size_t WS_XN = 123 * MiB, WS_Q = 156 * MiB, WS_K = 172 * MiB, WS_V = 176 * MiB, WS_U = 180 * MiB, WS_MIX = 196 * MiB;
constexpr size_t WS_END = 256 * MiB;
static_assert(WS_HID + (size_t)MT * FF * 2 <= WS_END && WS_MIX + (size_t)MT * DM * 2 <= WS_END && WS_X1G + (size_t)MT * DM * 2 <= WS_HID, "ws map");
constexpr int CW_BAR = 4096;
constexpr int RING_BYTES = 131072, LDSCTL_OFF = RING_BYTES, MISC_OFF = LDSCTL_OFF + 320, LDS_BYTES = 147456;

typedef unsigned short bf16;
typedef unsigned v4u __attribute__((ext_vector_type(4)));
typedef unsigned v2u __attribute__((ext_vector_type(2)));
typedef float f32x4 __attribute__((ext_vector_type(4)));
typedef float f32x2 __attribute__((ext_vector_type(2)));
typedef short bf16x8 __attribute__((ext_vector_type(8)));
#define LDS_WAIT() asm volatile("s_waitcnt lgkmcnt(0)" ::: "memory")
__device__ __forceinline__ unsigned f2bf(float f) { unsigned u = __builtin_bit_cast(unsigned, f); return (u + 0x7fffu + ((u >> 16) & 1u)) >> 16; }
__device__ __forceinline__ unsigned pk2(float lo, float hi) { return pg8::cvt_pk_bf16(lo, hi); }
__device__ __forceinline__ float bf2f(unsigned h) { return __builtin_bit_cast(float, h << 16); }
__device__ __forceinline__ float wave_sum(float v) {
#pragma unroll
    for (int o = 1; o < 64; o <<= 1) v += __shfl_xor(v, o);
    return v;
}
__device__ __forceinline__ float wave_max(float v) {
#pragma unroll
    for (int o = 1; o < 64; o <<= 1) v = fmaxf(v, __shfl_xor(v, o));
    return v;
}
__device__ __forceinline__ float dot4(f32x4 a, f32x4 b) { return (a[0] * b[0] + a[1] * b[1]) + (a[2] * b[2] + a[3] * b[3]); }
__device__ __forceinline__ float sigmoidf_(float g) { return 1.0f / (1.0f + __expf(-g)); }

__device__ __forceinline__ int win_dst_group(int sg) {
    if (sg < 48) { const int pn = sg >> 3, wc = (sg & 7) >> 1, bj = sg & 1; return 8 * pn + 4 * bj + wc; }
    if (sg < 80) { const int cc = sg - 48; return 8 * (6 + (cc >> 2)) + (cc & 3); }
    const int cc = sg - 80; return 8 * (6 + (cc >> 2)) + 4 + (cc & 3);
}
__device__ __forceinline__ int win_logical_col(int np) {
    const int dg = np >> 5, e = np & 31, pn = dg >> 3, bj = (dg >> 2) & 1, wc = dg & 3;
    if (dg < 48) return 256 * pn + 64 * wc + 32 * bj + e;
    return (bj ? 2560 : 1536) + 128 * (pn - 6) + 32 * wc + e;
}

using pg8::Unit;
struct Epi1 {
    static constexpr bool PERM = true, AFTER_DRAIN = false;
    bf16 *Q, *K, *V, *U; float* out; const float *gq, *gk, *cosT, *sinT;
    __device__ __forceinline__ void operator()(const f32x4 (&acc)[2][2][4][2], const Unit& u, int wr, int wc, int fr, int fq) const {
        const int pn = u.pn, rbase = u.pm * 256 + wr * 64 + fr;
        if (pn < 5) {
            const float* g = pn < 4 ? gq : gk; const float qs = pn < 4 ? 0.125f : 1.0f;
            const f32x4 g1a = *(const f32x4*)(g + 8 * fq), g1b = *(const f32x4*)(g + 8 * fq + 4), g2a = *(const f32x4*)(g + 32 + 8 * fq), g2b = *(const f32x4*)(g + 36 + 8 * fq);
#pragma unroll
            for (int ai = 0; ai < 2; ++ai)
#pragma unroll
                for (int m = 0; m < 4; ++m) {
                    const int r = rbase + ai * 128 + m * 16, s = r & (SEQ - 1), b = r >> 11;
                    const f32x4 x1a = acc[ai][0][m][0], x1b = acc[ai][0][m][1], x2a = acc[ai][1][m][0], x2b = acc[ai][1][m][1];
                    float ss = (dot4(x1a, x1a) + dot4(x1b, x1b)) + (dot4(x2a, x2a) + dot4(x2b, x2b));
                    ss += __shfl_xor(ss, 16); ss += __shfl_xor(ss, 32);
                    const float rstd = rsqrtf(ss * (1.0f / 64.0f) + EPS);
                    const f32x4 y1a = x1a * rstd * g1a, y1b = x1b * rstd * g1b, y2a = x2a * rstd * g2a, y2b = x2b * rstd * g2b;
                    const f32x4 ca = *(const f32x4*)(cosT + s * 32 + 8 * fq), cb = *(const f32x4*)(cosT + s * 32 + 8 * fq + 4);
                    const f32x4 sa = *(const f32x4*)(sinT + s * 32 + 8 * fq), sb = *(const f32x4*)(sinT + s * 32 + 8 * fq + 4);
                    const f32x4 o1a = y1a * ca - y2a * sa, o1b = y1b * cb - y2b * sb, o2a = y2a * ca + y1a * sa, o2b = y2b * cb + y1b * sb;
                    v4u w1, w2;
                    w1.x = pk2(o1a[0] * qs, o1a[1] * qs); w1.y = pk2(o1a[2] * qs, o1a[3] * qs); w1.z = pk2(o1b[0] * qs, o1b[1] * qs); w1.w = pk2(o1b[2] * qs, o1b[3] * qs);
                    w2.x = pk2(o2a[0] * qs, o2a[1] * qs); w2.y = pk2(o2a[2] * qs, o2a[3] * qs); w2.z = pk2(o2b[0] * qs, o2b[1] * qs); w2.w = pk2(o2b[2] * qs, o2b[3] * qs);
                    if (pn < 4) {
                        bf16* p = Q + (size_t)r * 1024 + 64 * (4 * pn + wc) + 8 * fq;
                        *(v4u*)p = w1; *(v4u*)(p + 32) = w2;
                    } else {
                        bf16* p = K + (size_t)r * 256 + 64 * wc + 8 * fq;
                        *(v4u*)p = w1; *(v4u*)(p + 32) = w2;
                        if (s >= SEQ - 128) {
                            float* o = out + O_KP + ((size_t)(b * 128 + s - (SEQ - 128)) * 4 + wc) * 64 + 8 * fq;
                            *(f32x4*)o = o1a; *(f32x4*)(o + 4) = o1b; *(f32x4*)(o + 32) = o2a; *(f32x4*)(o + 36) = o2b;
                        }
                    }
                }
        } else if (pn == 5) {
#pragma unroll
            for (int ai = 0; ai < 2; ++ai)
#pragma unroll
                for (int m = 0; m < 4; ++m) {
                    const int r = rbase + ai * 128 + m * 16, s = r & (SEQ - 1), b = r >> 11;
#pragma unroll
                    for (int bj = 0; bj < 2; ++bj) {
                        const f32x4 v0 = acc[ai][bj][m][0], v1 = acc[ai][bj][m][1];
                        v4u w; w.x = pk2(v0[0], v0[1]); w.y = pk2(v0[2], v0[3]); w.z = pk2(v1[0], v1[1]); w.w = pk2(v1[2], v1[3]);
                        *(v4u*)(V + (size_t)r * 256 + 64 * wc + 32 * bj + 8 * fq) = w;
                        if (s >= SEQ - 128) {
                            float* o = out + O_VP + ((size_t)(b * 128 + s - (SEQ - 128)) * 4 + wc) * 64 + 32 * bj + 8 * fq;
                            *(f32x4*)o = v0; *(f32x4*)(o + 4) = v1;
                        }
                    }
                }
        } else {
            const int ch = 128 * (pn - 6) + 32 * wc + 8 * fq;
#pragma unroll
            for (int ai = 0; ai < 2; ++ai)
#pragma unroll
                for (int m = 0; m < 4; ++m) {
                    const int r = rbase + ai * 128 + m * 16, s = r & (SEQ - 1), b = r >> 11;
                    const f32x4 a0 = acc[ai][0][m][0], a1 = acc[ai][0][m][1], g0 = acc[ai][1][m][0], g1 = acc[ai][1][m][1];
                    f32x4 u0, u1;
#pragma unroll
                    for (int j = 0; j < 4; ++j) { u0[j] = a0[j] * sigmoidf_(g0[j]); u1[j] = a1[j] * sigmoidf_(g1[j]); }
                    v4u w; w.x = pk2(u0[0], u0[1]); w.y = pk2(u0[2], u0[3]); w.z = pk2(u1[0], u1[1]); w.w = pk2(u1[2], u1[3]);
                    *(v4u*)(U + (size_t)r * 1024 + ch) = w;
                    if (s >= SEQ - 30) {
                        float* o = out + O_CP + (size_t)(b * 30 + s - (SEQ - 30)) * 1024 + ch;
                        *(f32x4*)o = u0; *(f32x4*)(o + 4) = u1;
                    }
                }
        }
    }
};
struct Epi3 {
    static constexpr bool PERM = true, AFTER_DRAIN = false;
    const float* xp; float* Y; bf16* X1G; const float* gm; float* SSQ;
    __device__ __forceinline__ void operator()(const f32x4 (&acc)[2][2][4][2], const Unit& u, int wr, int wc, int fr, int fq) const {
        const int rbase = u.pm * 256 + wr * 64 + fr, col0 = u.pn * 256 + wc * 32 + 8 * fq;
        f32x4 gv[2][2];
#pragma unroll
        for (int bj = 0; bj < 2; ++bj)
#pragma unroll
            for (int n = 0; n < 2; ++n) gv[bj][n] = *(const f32x4*)(gm + col0 + bj * 128 + 4 * n);
#pragma unroll
        for (int ai = 0; ai < 2; ++ai)
#pragma unroll
            for (int m = 0; m < 4; ++m) {
                const int r = rbase + ai * 128 + m * 16; float ss = 0.f;
#pragma unroll
                for (int bj = 0; bj < 2; ++bj) {
                    const size_t off = (size_t)r * DM + col0 + bj * 128;
                    const f32x4 v0 = acc[ai][bj][m][0] + *(const f32x4*)(xp + off), v1 = acc[ai][bj][m][1] + *(const f32x4*)(xp + off + 4);
                    *(f32x4*)(Y + off) = v0; *(f32x4*)(Y + off + 4) = v1;
                    ss += dot4(v0, v0) + dot4(v1, v1);
                    const f32x4 h0 = v0 * gv[bj][0], h1 = v1 * gv[bj][1];
                    v4u w; w.x = pk2(h0[0], h0[1]); w.y = pk2(h0[2], h0[3]); w.z = pk2(h1[0], h1[1]); w.w = pk2(h1[2], h1[3]);
                    *(v4u*)(X1G + off) = w;
                }
                ss += __shfl_xor(ss, 16); ss += __shfl_xor(ss, 32);
                if (fq == 0) atomicAdd(SSQ + r, ss);
            }
    }
};
struct Epi4 {
    static constexpr bool PERM = true, AFTER_DRAIN = false;
    float* SSQ; bf16* H;
    __device__ __forceinline__ void operator()(const f32x4 (&acc)[2][2][4][2], const Unit& u, int wr, int wc, int fr, int fq) const {
        const int rbase = u.pm * 256 + wr * 64 + fr, col0 = u.pn * 256 + wc * 32 + 8 * fq;
#pragma unroll
        for (int ai = 0; ai < 2; ++ai)
#pragma unroll
            for (int m = 0; m < 4; ++m) {
                const int r = rbase + ai * 128 + m * 16;
                const float rstd = rsqrtf(__hip_atomic_load(SSQ + r, __ATOMIC_RELAXED, __HIP_MEMORY_SCOPE_AGENT) * (1.0f / DM) + EPS);
#pragma unroll
                for (int bj = 0; bj < 2; ++bj) {
                    f32x4 v0 = acc[ai][bj][m][0] * rstd, v1 = acc[ai][bj][m][1] * rstd;
#pragma unroll
                    for (int j = 0; j < 4; ++j) { v0[j] = fmaxf(v0[j], 0.f); v0[j] *= v0[j]; v1[j] = fmaxf(v1[j], 0.f); v1[j] *= v1[j]; }
                    v4u w; w.x = pk2(v0[0], v0[1]); w.y = pk2(v0[2], v0[3]); w.z = pk2(v1[0], v1[1]); w.w = pk2(v1[2], v1[3]);
                    *(v4u*)(H + (size_t)r * FF + col0 + bj * 128) = w;
                }
            }
    }
};
struct Epi5 {
    static constexpr bool PERM = true, AFTER_DRAIN = false;
    float* Y;
    __device__ __forceinline__ void operator()(const f32x4 (&acc)[2][2][4][2], const Unit& u, int wr, int wc, int fr, int fq) const {
        const int rbase = u.pm * 256 + wr * 64 + fr, col0 = u.pn * 256 + wc * 32 + 8 * fq;
#pragma unroll
        for (int ai = 0; ai < 2; ++ai)
#pragma unroll
            for (int m = 0; m < 4; ++m) {
                const int r = rbase + ai * 128 + m * 16;
#pragma unroll
                for (int bj = 0; bj < 2; ++bj) {
                    float* p = Y + (size_t)r * DM + col0 + bj * 128;
                    const f32x4 v0 = acc[ai][bj][m][0] + *(const f32x4*)p, v1 = acc[ai][bj][m][1] + *(const f32x4*)(p + 4);
                    *(f32x4*)p = v0; *(f32x4*)(p + 4) = v1;
                }
            }
    }
};

template <class EpiS>
__device__ __forceinline__ void skinny_phase(LAS unsigned char* lds, const bf16* As, const bf16* Bt, int N, int K, int start, int stride, const EpiS& E) {
    const int tid = threadIdx.x, wave = __builtin_amdgcn_readfirstlane(tid >> 6), lane = tid & 63, fr = lane & 15, fq = lane >> 4;
    LAS float* red = (LAS float*)lds;
    const int kw = K >> 3, kb = wave * kw;
    for (int unit = start; unit < (N >> 4); unit += stride) {
        f32x4 a0 = {0.f, 0.f, 0.f, 0.f}, a1 = {0.f, 0.f, 0.f, 0.f};
        const bf16* bp = Bt + (size_t)(16 * unit + fr) * K + kb + 8 * fq;
        const bf16* ap0 = As + (size_t)fr * K + kb + 8 * fq;
        const bf16* ap1 = ap0 + (size_t)16 * K;
#pragma unroll 4
        for (int k = 0; k < kw; k += 32) {
            const bf16x8 b = *(const bf16x8*)(bp + k), x0 = *(const bf16x8*)(ap0 + k), x1 = *(const bf16x8*)(ap1 + k);
            a0 = __builtin_amdgcn_mfma_f32_16x16x32_bf16(b, x0, a0, 0, 0, 0);
            a1 = __builtin_amdgcn_mfma_f32_16x16x32_bf16(b, x1, a1, 0, 0, 0);
        }
        *(LAS f32x4*)(red + (wave * 2 + 0) * 256 + lane * 4) = a0;
        *(LAS f32x4*)(red + (wave * 2 + 1) * 256 + lane * 4) = a1;
        __syncthreads();
        const int row = tid >> 4, cj = tid & 15, idx = (row >> 4) * 256 + ((row & 15) + 16 * (cj >> 2)) * 4 + (cj & 3);
        float s = 0.f;
#pragma unroll
        for (int w = 0; w < 8; ++w) s += red[w * 512 + idx];
        E(row, 16 * unit + cj, s);
        __syncthreads();
    }
}
struct EpiS1 { float* ZS; __device__ __forceinline__ void operator()(int row, int col, float v) const { ZS[row * INC + win_logical_col(col)] = v; } };
struct EpiS3 { const float* xs; float* Y; bf16* X1G; const float* gm; float* SSQ;
    __device__ __forceinline__ void operator()(int row, int col, float v) const {
        const float x1 = xs[row * DM + col] + v; Y[(size_t)(MP + row) * DM + col] = x1; X1G[(size_t)(MP + row) * DM + col] = (bf16)f2bf(x1 * gm[col]);
        float ss = x1 * x1; ss += __shfl_xor(ss, 1); ss += __shfl_xor(ss, 2); ss += __shfl_xor(ss, 4); ss += __shfl_xor(ss, 8);
        if ((threadIdx.x & 15) == 0) atomicAdd(SSQ + MP + row, ss);
    } };
struct EpiS4 { float* SSQ; bf16* H;
    __device__ __forceinline__ void operator()(int row, int col, float v) const {
        const float rstd = rsqrtf(__hip_atomic_load(SSQ + MP + row, __ATOMIC_RELAXED, __HIP_MEMORY_SCOPE_AGENT) * (1.0f / DM) + EPS);
        float h = fmaxf(v * rstd, 0.f); h *= h; H[(size_t)(MP + row) * FF + col] = (bf16)f2bf(h);
    } };
struct EpiS5 { float* Y; __device__ __forceinline__ void operator()(int row, int col, float v) const { float* p = Y + (size_t)(MP + row) * DM + col; *p = *p + v; } };

__device__ __forceinline__ void p0_transpose_item(const float* W, int K, int N, bf16* WT, int k0, int n0, int drow0, LAS float* scr, int lane) {
#pragma unroll 8
    for (int i = 0; i < 32; ++i) { const int kk = 2 * i + (lane >> 5); scr[kk * 33 + (lane & 31)] = W[(size_t)(k0 + kk) * N + n0 + (lane & 31)]; }
    LDS_WAIT(); asm volatile("" ::: "memory");
    const int c = lane & 7;
#pragma unroll
    for (int j = 0; j < 4; ++j) { const int n = (lane >> 3) + 8 * j; const LAS float* s = scr + (8 * c) * 33 + n;
        v4u o; o.x = pk2(s[0 * 33], s[1 * 33]); o.y = pk2(s[2 * 33], s[3 * 33]); o.z = pk2(s[4 * 33], s[5 * 33]); o.w = pk2(s[6 * 33], s[7 * 33]);
        *(v4u*)(WT + (size_t)(drow0 + n) * K + k0 + 8 * c) = o; }
    LDS_WAIT(); asm volatile("" ::: "memory");
}
__device__ __forceinline__ void rms_row_to_bf16(const float* xrow, const float* g, bf16* orow, int lane) {
    const f32x4* xr = (const f32x4*)xrow + lane; const f32x4* gr = (const f32x4*)g + lane;
    f32x4 v[8]; float s = 0.f;
#pragma unroll
    for (int j = 0; j < 8; ++j) { v[j] = xr[64 * j]; s += dot4(v[j], v[j]); }
    const float rstd = rsqrtf(wave_sum(s) * (1.0f / DM) + EPS);
    v2u* o8 = (v2u*)orow + lane;
#pragma unroll
    for (int j = 0; j < 8; ++j) { const f32x4 y = v[j] * rstd * gr[64 * j]; v2u w; w.x = pk2(y[0], y[1]); w.y = pk2(y[2], y[3]); o8[64 * j] = w; }
}

constexpr int KS_STRIDE = 72, VT_STRIDE = 276, KS_BYTES = 272 * KS_STRIDE * 2, VT_BYTES = 64 * VT_STRIDE * 2;
__device__ __forceinline__ void attn_unit(LAS unsigned char* lds, int b, int nb, int kh, const bf16* Q, const bf16* Kb, const bf16* Vb, bf16* MIX, const float* sinks,
                                          int tid, int wave, int lane) {
    LAS bf16* Ks = (LAS bf16*)lds; LAS bf16* Vt = (LAS bf16*)(lds + KS_BYTES);
    const int fr = lane & 15, fq = lane >> 4;
#pragma unroll
    for (int p = 0; p < 4; ++p) {
        const int idx = p * 512 + tid, key = idx >> 3, c = idx & 7, s = 128 * (nb - 1) + key;
        v4u kv = {0u, 0u, 0u, 0u}, vv = {0u, 0u, 0u, 0u};
        if (s >= 0) { const size_t off = (size_t)(b * SEQ + s) * 256 + 64 * kh + 8 * c; kv = *(const v4u*)(Kb + off); vv = *(const v4u*)(Vb + off); }
        *(LAS v4u*)(Ks + key * KS_STRIDE + 8 * c) = kv;
        LAS bf16* vp = Vt + (8 * c) * VT_STRIDE + key;
        vp[0 * VT_STRIDE] = (bf16)(vv.x & 0xffffu); vp[1 * VT_STRIDE] = (bf16)(vv.x >> 16); vp[2 * VT_STRIDE] = (bf16)(vv.y & 0xffffu); vp[3 * VT_STRIDE] = (bf16)(vv.y >> 16);
        vp[4 * VT_STRIDE] = (bf16)(vv.z & 0xffffu); vp[5 * VT_STRIDE] = (bf16)(vv.z >> 16); vp[6 * VT_STRIDE] = (bf16)(vv.w & 0xffffu); vp[7 * VT_STRIDE] = (bf16)(vv.w >> 16);
    }
    if (tid < 144) *(LAS v4u*)(Ks + 256 * KS_STRIDE + tid * 8) = (v4u){0u, 0u, 0u, 0u};
    for (int i = tid; i < 64 * 20; i += 512) Vt[(i / 20) * VT_STRIDE + 256 + (i % 20)] = 0;
    __syncthreads();
    const int g = wave >> 1, h = 4 * kh + g; const float sink = sinks[h];
#pragma unroll 1
    for (int qi = 0; qi < 4; ++qi) {
        const int qt = 4 * (wave & 1) + qi, i0 = 16 * qt;
        const size_t r = (size_t)b * SEQ + 128 * nb + i0 + fr;
        bf16x8 qf[2];
        qf[0] = *(const bf16x8*)(Q + r * 1024 + 64 * h + 8 * fq); qf[1] = *(const bf16x8*)(Q + r * 1024 + 64 * h + 32 + 8 * fq);
        f32x4 S[10];
#pragma unroll
        for (int t = 0; t < 10; ++t) {
            S[t] = (f32x4){0.f, 0.f, 0.f, 0.f};
#pragma unroll
            for (int ks = 0; ks < 2; ++ks) {
                const bf16x8 kf = *(const LAS bf16x8*)(Ks + (16 * (qt + t) + fr) * KS_STRIDE + 32 * ks + 8 * fq);
                S[t] = __builtin_amdgcn_mfma_f32_16x16x32_bf16(kf, qf[ks], S[t], 0, 0, 0);
            }
        }
        float mx = sink;
#pragma unroll
        for (int t = 0; t < 10; ++t)
#pragma unroll
            for (int j = 0; j < 4; ++j) {
                const int rel = 16 * t + 4 * fq + j - fr;
                const bool ok = rel >= 1 && rel <= 128 && (nb > 0 || (i0 + 16 * t + 4 * fq + j) >= 128);
                S[t][j] = ok ? S[t][j] : -1e30f; mx = fmaxf(mx, S[t][j]);
            }
        mx = fmaxf(mx, __shfl_xor(mx, 16)); mx = fmaxf(mx, __shfl_xor(mx, 32));
        float sum = 0.f;
#pragma unroll
        for (int t = 0; t < 10; ++t)
#pragma unroll
            for (int j = 0; j < 4; ++j) { S[t][j] = __expf(S[t][j] - mx); sum += S[t][j]; }
        sum += __shfl_xor(sum, 16); sum += __shfl_xor(sum, 32); sum += __expf(sink - mx);
        const float inv = 1.0f / sum;
        f32x4 O[4];
#pragma unroll
        for (int dt = 0; dt < 4; ++dt) O[dt] = (f32x4){0.f, 0.f, 0.f, 0.f};
#pragma unroll
        for (int k2 = 0; k2 < 5; ++k2) {
            v4u pw; pw.x = pk2(S[2 * k2][0], S[2 * k2][1]); pw.y = pk2(S[2 * k2][2], S[2 * k2][3]); pw.z = pk2(S[2 * k2 + 1][0], S[2 * k2 + 1][1]); pw.w = pk2(S[2 * k2 + 1][2], S[2 * k2 + 1][3]);
            const bf16x8 pf = __builtin_bit_cast(bf16x8, pw);
#pragma unroll
            for (int dt = 0; dt < 4; ++dt) {
                const LAS bf16* vp = Vt + (16 * dt + fr) * VT_STRIDE + 16 * (qt + 2 * k2) + 4 * fq;
                const v2u lo = *(const LAS v2u*)vp, hi = *(const LAS v2u*)(vp + 16);
                v4u vw; vw.x = lo.x; vw.y = lo.y; vw.z = hi.x; vw.w = hi.y;
                O[dt] = __builtin_amdgcn_mfma_f32_16x16x32_bf16(__builtin_bit_cast(bf16x8, vw), pf, O[dt], 0, 0, 0);
            }
        }
#pragma unroll
        for (int dt = 0; dt < 4; ++dt) {
            v2u w; w.x = pk2(O[dt][0] * inv, O[dt][1] * inv); w.y = pk2(O[dt][2] * inv, O[dt][3] * inv);
            *(v2u*)(MIX + r * DM + 64 * h + 16 * dt + 4 * fq) = w;
        }
    }
    __syncthreads();
}

__device__ __forceinline__ void conv_unit(LAS unsigned char* lds, int b, int tb, const bf16* U, bf16* MIX, const float* cw, const float* cb, const float* lg, const float* lb,
                                          int tid, int wave, int lane) {
    LAS unsigned* tile = (LAS unsigned*)lds;
    LAS float* red = (LAS float*)(lds + 62 * 2048);
    LAS float* fin = red + 512;
    const int s0 = 32 * tb;
    for (int i = tid; i < 62 * 128; i += 512) {
        const int row = i >> 7, c16 = i & 127, s = s0 - 30 + row;
        v4u v = {0u, 0u, 0u, 0u};
        if (s >= 0) v = *(const v4u*)(U + (size_t)(b * SEQ + s) * 1024 + 8 * c16);
        *(LAS v4u*)(tile + row * 512 + 4 * c16) = v;
    }
    f32x2 w[31];
#pragma unroll
    for (int j = 0; j < 31; ++j) w[j] = *(const f32x2*)(cw + j * 1024 + 2 * tid);
    const f32x2 bias = *(const f32x2*)(cb + 2 * tid);
    __syncthreads();
    const f32x2 g = *(const f32x2*)(lg + 2 * tid), be = *(const f32x2*)(lb + 2 * tid);
#pragma unroll 1
    for (int hf = 0; hf < 2; ++hf) {
        f32x2 c[16];
#pragma unroll
        for (int q = 0; q < 2; ++q) {
#pragma unroll
            for (int o = 0; o < 8; ++o) c[8 * q + o] = bias;
#pragma unroll
            for (int rr = 0; rr < 38; ++rr) {
                const unsigned pv = tile[(16 * hf + 8 * q + rr) * 512 + tid];
                const f32x2 v = {bf2f(pv & 0xffffu), bf2f(pv >> 16)};
#pragma unroll
                for (int o = 0; o < 8; ++o) { const int j = rr - o; if (j >= 0 && j <= 30) c[8 * q + o] = c[8 * q + o] + w[j] * v; }
            }
#pragma unroll
            for (int o = 0; o < 8; ++o) {
                const f32x2 x = c[8 * q + o];
                const float s1 = wave_sum(x[0] + x[1]), s2 = wave_sum(x[0] * x[0] + x[1] * x[1]);
                if (lane == 0) { red[(wave * 16 + 8 * q + o) * 2] = s1; red[(wave * 16 + 8 * q + o) * 2 + 1] = s2; }
            }
        }
        __syncthreads();
        if (tid < 32) { float s = 0.f;
#pragma unroll
            for (int wv = 0; wv < 8; ++wv) s += red[wv * 32 + tid];
            fin[tid] = s; }
        __syncthreads();
#pragma unroll
        for (int t = 0; t < 16; ++t) {
            const float mean = fin[2 * t] * (1.0f / CCH), var = fin[2 * t + 1] * (1.0f / CCH) - mean * mean, rstd = rsqrtf(fmaxf(var, 0.f) + EPS);
            const f32x2 y = (c[t] - mean) * rstd * g + be;
            const float o0 = y[0] * sigmoidf_(y[0]), o1 = y[1] * sigmoidf_(y[1]);
            *(unsigned*)(MIX + (size_t)(b * SEQ + s0 + 16 * hf + t) * DM + 1024 + 2 * tid) = pk2(o0, o1);
        }
    }
    __syncthreads();
}

__device__ __forceinline__ void sample_mixer(LAS unsigned char* lds, int b, const float* ZS, const float* cache_k, const float* cache_v, const float* state,
                                             const float* gq, const float* gk, const float* sinks, const float* cw, const float* cb, const float* lg, const float* lb,
                                             const float* cosT, const float* sinT, float* out, bf16* MIX, int tid, int wave, int lane) {
    LAS float* zs = (LAS float*)lds;
    LAS float* qs = zs + 3584;
    LAS float* kn = qs + 1024;
    LAS float* vn = kn + 256;
    LAS float* sc = vn + 256;
    LAS float* rd = sc + 2048;
    for (int i = tid; i < INC; i += 512) zs[i] = ZS[b * INC + i];
    __syncthreads();
    for (int hh = wave; hh < 20; hh += 8) {
        const int base = hh < 16 ? 64 * hh : 1024 + 64 * (hh - 16);
        const float x = zs[base + lane];
        const float rstd = rsqrtf(wave_sum(x * x) * (1.0f / 64.0f) + EPS);
        const float y = x * rstd * (hh < 16 ? gq : gk)[lane];
        const float p = __shfl_xor(y, 32);
        const float co = cosT[2048 * 32 + (lane & 31)], si = sinT[2048 * 32 + (lane & 31)];
        const float o = lane < 32 ? y * co - p * si : y * co + p * si;
        if (hh < 16) qs[hh * 64 + lane] = o * 0.125f;
        else { kn[(hh - 16) * 64 + lane] = o; out[O_KS + ((size_t)(b * 128 + 127) * 4 + (hh - 16)) * 64 + lane] = o; }
    }
    if (tid < 256) { const float vv = zs[1280 + tid]; vn[tid] = vv; out[O_VS + (size_t)(b * 128 + 127) * 256 + tid] = vv; }
    __syncthreads();
    {
        const int jj = tid >> 2, kh = tid & 3, j = jj + 1;
        float d0 = 0.f, d1 = 0.f, d2 = 0.f, d3 = 0.f;
        const LAS float* q0 = qs + (4 * kh) * 64;
        if (j < 128) {
            const f32x4* kr = (const f32x4*)(cache_k + ((size_t)(b * 128 + j) * 4 + kh) * 64);
#pragma unroll 4
            for (int d4 = 0; d4 < 16; ++d4) { const f32x4 kv = kr[d4];
                d0 += dot4(kv, *(const LAS f32x4*)(q0 + 4 * d4)); d1 += dot4(kv, *(const LAS f32x4*)(q0 + 64 + 4 * d4));
                d2 += dot4(kv, *(const LAS f32x4*)(q0 + 128 + 4 * d4)); d3 += dot4(kv, *(const LAS f32x4*)(q0 + 192 + 4 * d4)); }
        } else {
#pragma unroll 4
            for (int d4 = 0; d4 < 16; ++d4) { const f32x4 kv = *(const LAS f32x4*)(kn + kh * 64 + 4 * d4);
                d0 += dot4(kv, *(const LAS f32x4*)(q0 + 4 * d4)); d1 += dot4(kv, *(const LAS f32x4*)(q0 + 64 + 4 * d4));
                d2 += dot4(kv, *(const LAS f32x4*)(q0 + 128 + 4 * d4)); d3 += dot4(kv, *(const LAS f32x4*)(q0 + 192 + 4 * d4)); }
        }
        sc[(4 * kh + 0) * 128 + jj] = d0; sc[(4 * kh + 1) * 128 + jj] = d1; sc[(4 * kh + 2) * 128 + jj] = d2; sc[(4 * kh + 3) * 128 + jj] = d3;
    }
    __syncthreads();
    for (int h = 2 * wave; h < 2 * wave + 2; ++h) {
        const float a = sc[h * 128 + lane], c2 = sc[h * 128 + 64 + lane], sink = sinks[h];
        const float m = fmaxf(wave_max(fmaxf(a, c2)), sink);
        const float pa = __expf(a - m), pb = __expf(c2 - m);
        const float den = wave_sum(pa + pb) + __expf(sink - m), inv = 1.0f / den;
        sc[h * 128 + lane] = pa * inv; sc[h * 128 + 64 + lane] = pb * inv;
    }
    __syncthreads();
    {
        const int d = tid & 63;
#pragma unroll
        for (int hi = 0; hi < 2; ++hi) {
            const int h = (tid >> 6) + 8 * hi, kh = h >> 2; float o = 0.f;
            const float* vb = cache_v + ((size_t)(b * 128) * 4 + kh) * 64 + d;
#pragma unroll 8
            for (int jj = 0; jj < 127; ++jj) o += sc[h * 128 + jj] * vb[(size_t)(jj + 1) * 256];
            o += sc[h * 128 + 127] * vn[kh * 64 + d];
            MIX[(size_t)(MP + b) * DM + 64 * h + d] = (bf16)f2bf(o);
        }
    }
    {
        const int ch = 2 * tid;
        const float u0 = zs[1536 + ch] * sigmoidf_(zs[2560 + ch]), u1 = zs[1536 + ch + 1] * sigmoidf_(zs[2560 + ch + 1]);
        *(f32x2*)(out + O_CS + (size_t)(b * 30 + 29) * 1024 + ch) = (f32x2){u0, u1};
        f32x2 c = *(const f32x2*)(cb + ch);
#pragma unroll 6
        for (int j = 0; j < 30; ++j) c = c + *(const f32x2*)(cw + j * 1024 + ch) * *(const f32x2*)(state + (size_t)(b * 30 + j) * 1024 + ch);
        c = c + *(const f32x2*)(cw + 30 * 1024 + ch) * (f32x2){u0, u1};
        const float s1 = wave_sum(c[0] + c[1]), s2 = wave_sum(c[0] * c[0] + c[1] * c[1]);
        if (lane == 0) { rd[wave * 2] = s1; rd[wave * 2 + 1] = s2; }
        __syncthreads();
        float t1 = 0.f, t2 = 0.f;
#pragma unroll
        for (int wv = 0; wv < 8; ++wv) { t1 += rd[wv * 2]; t2 += rd[wv * 2 + 1]; }
        const float mean = t1 * (1.0f / CCH), var = t2 * (1.0f / CCH) - mean * mean, rstd = rsqrtf(fmaxf(var, 0.f) + EPS);
        const f32x2 y = (c - mean) * rstd * *(const f32x2*)(lg + ch) + *(const f32x2*)(lb + ch);
        *(unsigned*)(MIX + (size_t)(MP + b) * DM + 1024 + ch) = pk2(y[0] * sigmoidf_(y[0]), y[1] * sigmoidf_(y[1]));
    }
    __syncthreads();
}

#ifndef MK_CG_SEAMS
#define MK_CG_SEAMS 1
#endif
struct Args { const float* in[18]; float* out; unsigned char* ws; int ph_lo, ph_hi; };
__global__ void __launch_bounds__(NWAVES * 64, 2) mk_fwd(Args args) {
    extern __shared__ __attribute__((aligned(16))) unsigned char lds_raw[];
    LAS unsigned char* lds = (LAS unsigned char*)lds_raw;
    const int tid = threadIdx.x, lane = tid & 63, wave = __builtin_amdgcn_readfirstlane(tid >> 6);
    const int G = gridDim.x, bx = blockIdx.x;
    const int vcu = (G % 8 == 0) ? (bx % 8) * (G / 8) + bx / 8 : bx;
    unsigned char* ws = args.ws;
    const float *xp = args.in[0], *xs = args.in[1], *cache_k = args.in[2], *cache_v = args.in[3], *state = args.in[4], *g_mix = args.in[5], *w_in = args.in[6],
                *gq = args.in[7], *gk = args.in[8], *sinks = args.in[9], *conv_w = args.in[10], *conv_b = args.in[11], *ln_g = args.in[12], *ln_b = args.in[13],
                *w_out = args.in[14], *g_mlp = args.in[15], *w_up = args.in[16], *w_down = args.in[17];
    float* out = args.out;
    float* SSQ = (float*)(ws + WS_SSQ); float* cosT = (float*)(ws + WS_COS); float* sinT = (float*)(ws + WS_SIN); float* ZS = (float*)(ws + WS_ZS);
    bf16 *WinT = (bf16*)(ws + WS_WIN), *WoutT = (bf16*)(ws + WS_WOUT), *WupT = (bf16*)(ws + WS_WUP), *WdnT = (bf16*)(ws + WS_WDN);
    bf16 *X1G = (bf16*)(ws + WS_X1G), *HID = (bf16*)(ws + WS_HID), *XN = (bf16*)(ws + WS_XN), *Qb = (bf16*)(ws + WS_Q), *Kb = (bf16*)(ws + WS_K), *Vb = (bf16*)(ws + WS_V),
         *Ub = (bf16*)(ws + WS_U), *MIX = (bf16*)(ws + WS_MIX);
    for (int u = tid; u < (LDS_BYTES - LDSCTL_OFF) / 4; u += NWAVES * 64) ((LAS unsigned*)(lds + LDSCTL_OFF))[u] = 0u;
    __syncthreads();
    volatile LAS unsigned* MISC = (volatile LAS unsigned*)(lds + MISC_OFF);
    XcdBarrier bar; bar.bar = (unsigned*)(ws + WS_CTL) + CW_BAR; bar.x = 0; bar.st = nullptr;
    if (MK_N_LAUNCHES == 1) bar = xcd_barrier_post((unsigned*)(ws + WS_CTL) + CW_BAR, MISC + 8);
#define GRID_BAR(seam) do { if (MK_N_LAUNCHES == 1) { if ((MK_CG_SEAMS >> (seam)) & 1) cg::this_grid().sync(); else xcd_barrier(bar); } } while (0)
    const int lo = args.ph_lo, hi = args.ph_hi;
#define IN(k) (lo <= (k) && (k) < hi)

    if (IN(0)) {
        LAS float* scr = (LAS float*)(lds + wave * 16384);
        const int gw = vcu * NWAVES + wave, NGW = G * NWAVES;
        constexpr int I_IN = (DM / 64) * (INC / 32), I_OUT = (DM / 64) * (DM / 32), I_UP = (DM / 64) * (FF / 32), I_DN = (FF / 64) * (DM / 32), NITEMS = I_IN + I_OUT + I_UP + I_DN;
        for (int it = gw; it < NITEMS; it += NGW) {
            int r = it;
            if (r < I_IN) { const int kb = r / (INC / 32), nb = r % (INC / 32); p0_transpose_item(w_in, DM, INC, WinT, 64 * kb, 32 * nb, 32 * win_dst_group(nb), scr, lane); continue; } r -= I_IN;
            if (r < I_OUT) { const int kb = r / (DM / 32), nb = r % (DM / 32); p0_transpose_item(w_out, DM, DM, WoutT, 64 * kb, 32 * nb, 32 * nb, scr, lane); continue; } r -= I_OUT;
            if (r < I_UP) { const int kb = r / (FF / 32), nb = r % (FF / 32); p0_transpose_item(w_up, DM, FF, WupT, 64 * kb, 32 * nb, 32 * nb, scr, lane); continue; } r -= I_UP;
            { const int kb = r / (DM / 32), nb = r % (DM / 32); p0_transpose_item(w_down, FF, DM, WdnT, 64 * kb, 32 * nb, 32 * nb, scr, lane); }
        }
        for (int m = gw; m < MT; m += NGW) rms_row_to_bf16(m < MP ? xp + (size_t)m * DM : xs + (size_t)(m - MP) * DM, g_mix, XN + (size_t)m * DM, lane);
        const int gt = vcu * (NWAVES * 64) + tid, NT = G * NWAVES * 64;
        for (int i = gt; i < 2049 * 32; i += NT) {
            const int pos = i >> 5, k = i & 31; double inv = 1.0;
            for (int j = 0; j < k; ++j) inv *= 0.7498942093324559;
            const float ang = (pos == 2048 ? 16384.0f : (float)pos) * (float)inv;
            double rev = (double)ang * 0.15915494309189535; rev -= __builtin_rint(rev);
            const float rf = (float)rev;
            cosT[i] = __builtin_amdgcn_cosf(rf); sinT[i] = __builtin_amdgcn_sinf(rf);
        }
        for (int i = gt; i < 32 * 8128; i += NT) { const int b = i / 8128, o = i % 8128;
            ((f32x4*)(out + O_KS + (size_t)b * 32768))[o] = ((const f32x4*)(cache_k + (size_t)b * 32768 + 256))[o];
            ((f32x4*)(out + O_VS + (size_t)b * 32768))[o] = ((const f32x4*)(cache_v + (size_t)b * 32768 + 256))[o]; }
        for (int i = gt; i < 32 * 7424; i += NT) { const int b = i / 7424, o = i % 7424;
            ((f32x4*)(out + O_CS + (size_t)b * 30720))[o] = ((const f32x4*)(state + (size_t)b * 30720 + 1024))[o]; }
        if (IN(1)) GRID_BAR(0);
    }
    if (IN(1)) {
        pg8::Gemm g{XN, WinT, MP, INC, DM}; pg8::StaticOrder S; S.init(MP, INC, G, bx);
        Epi1 E{Qb, Kb, Vb, Ub, out, gq, gk, cosT, sinT};
        pg8::gemm_phase<Epi1, pg8::StaticOrder, true, true>(lds, g, S, E);
        EpiS1 ES{ZS};
        skinny_phase(lds, XN + (size_t)MP * DM, WinT, INC, DM, G - 1 - bx, G, ES);
        if (IN(2)) GRID_BAR(1);
    }
    if (IN(2)) {
        for (int a = bx; a < 256; a += G) attn_unit(lds, a >> 6, (a >> 2) & 15, a & 3, Qb, Kb, Vb, MIX, sinks, tid, wave, lane);
        for (int c = bx; c < 256; c += G) conv_unit(lds, c >> 6, c & 63, Ub, MIX, conv_w, conv_b, ln_g, ln_b, tid, wave, lane);
        for (int b = G - 1 - bx; b < MS; b += G) sample_mixer(lds, b, ZS, cache_k, cache_v, state, gq, gk, sinks, conv_w, conv_b, ln_g, ln_b, cosT, sinT, out, MIX, tid, wave, lane);
        if (IN(3)) GRID_BAR(2);
    }
    if (IN(3)) {
        pg8::Gemm g{MIX, WoutT, MP, DM, DM}; pg8::StaticOrder S; S.init(MP, DM, G, bx);
        Epi3 E{xp, out + O_YP, X1G, g_mlp, SSQ};
        pg8::gemm_phase<Epi3, pg8::StaticOrder, true, true>(lds, g, S, E);
        EpiS3 ES{xs, out + O_YP, X1G, g_mlp, SSQ};
        skinny_phase(lds, MIX + (size_t)MP * DM, WoutT, DM, DM, G - 1 - bx, G, ES);
        if (IN(4)) GRID_BAR(3);
    }
    if (IN(4)) {
        pg8::Gemm g{X1G, WupT, MP, FF, DM}; pg8::StaticOrder S; S.init(MP, FF, G, bx);
        Epi4 E{SSQ, HID};
        pg8::gemm_phase<Epi4, pg8::StaticOrder, true, true>(lds, g, S, E);
        EpiS4 ES{SSQ, HID};
        skinny_phase(lds, X1G + (size_t)MP * DM, WupT, FF, DM, G - 1 - bx, G, ES);
        if (IN(5)) GRID_BAR(4);
    }
    if (IN(5)) {
        pg8::Gemm g{HID, WdnT, MP, DM, FF}; pg8::StaticOrder S; S.init(MP, DM, G, bx);
        Epi5 E{out + O_YP};
        pg8::gemm_phase<Epi5, pg8::StaticOrder, true, true>(lds, g, S, E);
        EpiS5 ES{out + O_YP};
        skinny_phase(lds, HID + (size_t)MP * FF, WdnT, DM, FF, G - 1 - bx, G, ES);
    }
#undef IN
}

extern "C" void kernel_launch(void* const* d_in, const int* in_sizes, int n_in, void* d_out, int out_size, void* d_ws, size_t ws_size, hipStream_t stream) {
    static int grid = 0;
    if (grid == 0) {
        if (n_in != 18 || (size_t)out_size != O_END || ws_size < WS_END) { fprintf(stderr, "kernel_launch: unexpected shapes: n_in %d out %d ws %zu\n", n_in, out_size, ws_size); grid = -1; return; }
        int dev = 0, cus = 0, per_cu = 0;
        if (hipGetDevice(&dev) != hipSuccess || hipDeviceGetAttribute(&cus, hipDeviceAttributeMultiprocessorCount, dev) != hipSuccess) { grid = -1; return; }
        if (hipFuncSetAttribute((const void*)mk_fwd, hipFuncAttributeMaxDynamicSharedMemorySize, LDS_BYTES) != hipSuccess) { fprintf(stderr, "kernel_launch: hipFuncSetAttribute failed\n"); grid = -1; return; }
        if (hipOccupancyMaxActiveBlocksPerMultiprocessor(&per_cu, (const void*)mk_fwd, NWAVES * 64, LDS_BYTES) != hipSuccess || per_cu < 1) { fprintf(stderr, "kernel_launch: occupancy query says %d\n", per_cu); (void)hipGetLastError(); grid = -1; return; }
        grid = cus;
    }
    if (grid < 0) return;
    (void)hipMemsetAsync((char*)d_ws + WS_CTL, 0, CTL_ZERO_BYTES, stream);
    Args a{};
    for (int i = 0; i < 18; ++i) a.in[i] = (const float*)d_in[i];
    a.out = (float*)d_out; a.ws = (unsigned char*)d_ws;
#if MK_N_LAUNCHES == 1
    a.ph_lo = 0; a.ph_hi = 6;
    void* params[] = {&a};
    hipError_t e = hipLaunchCooperativeKernel((const void*)mk_fwd, dim3(grid), dim3(NWAVES * 64), params, LDS_BYTES, stream);
    if (e != hipSuccess) fprintf(stderr, "kernel_launch: cooperative launch failed: %s (grid %d)\n", hipGetErrorString(e), grid);
#else
    for (int p = 0; p < 6; ++p) { a.ph_lo = p; a.ph_hi = p + 1; hipLaunchKernelGGL(mk_fwd, dim3(grid), dim3(NWAVES * 64), LDS_BYTES, stream, a); }
#endif
}
```

```cpp
#include <hip/hip_runtime.h>
#include <hip/hip_cooperative_groups.h>
#include <cstdio>
#include <cstdint>
namespace cg = cooperative_groups;
#define MK_N_LAUNCHES 1
namespace pg8 {
#define PG8_LAS __attribute__((address_space(3)))
typedef unsigned short bf16_t;
typedef short bf16x8 __attribute__((ext_vector_type(8)));
typedef float f32x4 __attribute__((ext_vector_type(4)));
typedef unsigned u32x4 __attribute__((ext_vector_type(4)));
constexpr int BM = 256, BK = 64, HALF = 128, HTB = HALF * BK * 2  , STAGE_BYTES = 8 * HTB, NXCD = 8, WGM = 8;

__host__ __device__ __forceinline__ int lds_byte(int r, int c) { const int st = (r >> 4) * 2 + (c >> 5), rr = r & 15, cc = c & 31, ob = rr * 64 + cc * 2; return st * 1024 + (ob ^ (((ob >> 9) & 1) << 5)); }
__host__ __device__ __forceinline__ void stage_rc(int b, int& R, int& C) { const int st = b / 1024, sb = b % 1024, swz = sb ^ (((sb >> 9) & 1) << 5); R = (st >> 1) * 16 + swz / 64; C = (st & 1) * 32 + (swz % 64) / 2; }
__host__ __device__ __forceinline__ int perm32(int rho) { const int n = rho >> 4, i = rho & 15; return 8 * (i >> 2) + 4 * n + (i & 3); }

struct Unit { int pm, pn; };
struct Gemm { const bf16_t* A; const bf16_t* Bt; int M, N, K; };

struct StaticOrder {
    int nM, nN, nwg, G, c;
    __host__ __device__ void init(int M, int N, int G_, int c_) { nM = M / BM; nN = N / BM; nwg = nM * nN; G = G_; c = c_; }
    __host__ __device__ bool next(int i, Unit& u) const {
        const long L = (long)i * G + c; if (L >= nwg) return false;
        int wgid = (int)L; { const int q = nwg / NXCD, r = nwg % NXCD, xcd = wgid % NXCD, off = wgid / NXCD; wgid = (xcd < r ? xcd * (q + 1) : r * (q + 1) + (xcd - r) * q) + off; }
        const int nig = WGM * nN, gid = wgid / nig, fm = gid * WGM, gsz = (nM - fm) < WGM ? (nM - fm) : WGM;
        u.pm = fm + ((wgid % nig) % gsz); u.pn = (wgid % nig) / gsz; return true;
    }
    __device__ __forceinline__ void a_ready(const Unit&) const {}
    __device__ __forceinline__ void done(const Unit&) const {}
};

__device__ __forceinline__ unsigned cvt_pk_bf16(float lo, float hi) { unsigned r; asm volatile("v_cvt_pk_bf16_f32 %0, %1, %2" : "=v"(r) : "v"(lo), "v"(hi)); return r; }
typedef float f32x2 __attribute__((ext_vector_type(2)));
template <class Epi, class Sched, bool ALIGN_EPI = false, bool SP2 = false>
__device__ __forceinline__ void gemm_phase(PG8_LAS unsigned char* lds, const Gemm g, const Sched& S, const Epi& E) {
    const int tid = threadIdx.x, wid = __builtin_amdgcn_readfirstlane(tid >> 6), lane = tid & 63, wr = wid >> 2, wc = wid & 3, fr = lane & 15, fq = lane >> 4;
    const int K = g.K, nt = K / BK;
    unsigned voffA[2], voffB[2];
#pragma unroll
    for (int i = 0; i < 2; ++i) { int R, C; stage_rc(tid * 16 + i * 8192, R, C); const int Rb = Epi::PERM ? ((R & ~31) + perm32(R & 31)) : R;
        voffA[i] = (unsigned)(R * K + C) * 2u; voffB[i] = (unsigned)(Rb * K + C) * 2u; }
    const size_t kstep = (size_t)(BK * 2);
    const size_t hstep = (size_t)HALF * K * 2;
    const size_t tstep = 2 * hstep;
    const unsigned ldsw = (unsigned)wid * 1024u;
    const int aoff = lds_byte(wr * 64 + fr, fq * 8), boff = lds_byte(wc * 32 + fr, fq * 8);
#define PG8_SA(b, h) (((b) * 2 + (h)) * HTB)
#define PG8_SB(b, h) ((4 + (b) * 2 + (h)) * HTB)
#define PG8_STAGE(bufoff, gbase, voff) do { _Pragma("unroll") for (int _i = 0; _i < 2; ++_i) \
        __builtin_amdgcn_global_load_lds((const unsigned*)((const char*)(gbase) + (voff)[_i]), (PG8_LAS unsigned*)(lds + (bufoff) + ldsw + _i * 8192), 16, 0, 0); } while (0)
#define PG8_LDA(dst, b, h) do { _Pragma("unroll") for (int m = 0; m < 4; ++m) _Pragma("unroll") for (int k = 0; k < 2; ++k) dst[m][k] = *(const PG8_LAS bf16x8*)(lds + PG8_SA(b, h) + aoff + m * 2048 + k * 1024); } while (0)
#define PG8_LDB(dst, b, h) do { _Pragma("unroll") for (int n = 0; n < 2; ++n) _Pragma("unroll") for (int k = 0; k < 2; ++k) dst[n][k] = *(const PG8_LAS bf16x8*)(lds + PG8_SB(b, h) + boff + n * 2048 + k * 1024); } while (0)
#define PG8_MMA(ai, bj, At, Bt) do { __builtin_amdgcn_s_setprio(1); _Pragma("unroll") for (int m = 0; m < 4; ++m) _Pragma("unroll") for (int n = 0; n < 2; ++n) _Pragma("unroll") for (int k = 0; k < 2; ++k) \
        acc[ai][bj][m][n] = __builtin_amdgcn_mfma_f32_16x16x32_bf16(Bt[n][k], At[m][k], acc[ai][bj][m][n], 0, 0, 0); __builtin_amdgcn_s_setprio(0); } while (0)
#define PG8_WAIT_V(n) asm volatile("s_waitcnt vmcnt(" #n ")" ::: "memory")
#define PG8_WAIT_L(n) asm volatile("s_waitcnt lgkmcnt(" #n ")" ::: "memory")
#define PG8_BAR __builtin_amdgcn_s_barrier()
#define PG8_SCHED __builtin_amdgcn_sched_barrier(0)
    Unit cur, nxt; int ui = 0;
    if (!S.next(0, cur)) return;
    f32x4 acc[2][2][4][2];
#pragma unroll
    for (int a = 0; a < 2; ++a)
#pragma unroll
        for (int b = 0; b < 2; ++b)
#pragma unroll
            for (int m = 0; m < 4; ++m)
#pragma unroll
                for (int n = 0; n < 2; ++n) acc[a][b][m][n] = (f32x4){0.f, 0.f, 0.f, 0.f};
    bf16x8 At[4][2], B0[2][2], B1[2][2];
    const char* cA = (const char*)g.A + (size_t)cur.pm * tstep; const char* cB = (const char*)g.Bt + (size_t)cur.pn * tstep;
    S.a_ready(cur);
    if constexpr (SP2) {
        PG8_STAGE(PG8_SB(0, 0), cB, voffB); PG8_STAGE(PG8_SB(0, 1), cB + hstep, voffB); PG8_STAGE(PG8_SA(0, 0), cA, voffA); PG8_STAGE(PG8_SA(0, 1), cA + hstep, voffA);
        if (wr == 1) PG8_BAR;
        PG8_WAIT_V(2); PG8_BAR;
        PG8_STAGE(PG8_SB(1, 0), cB + kstep, voffB); PG8_STAGE(PG8_SA(1, 0), cA + kstep, voffA); PG8_STAGE(PG8_SB(1, 1), cB + hstep + kstep, voffB);
        PG8_WAIT_V(6); PG8_BAR;
    } else {
        PG8_STAGE(PG8_SB(0, 0), cB, voffB); PG8_STAGE(PG8_SA(0, 0), cA, voffA); PG8_STAGE(PG8_SB(0, 1), cB + hstep, voffB); PG8_STAGE(PG8_SA(0, 1), cA + hstep, voffA);
        if (wr == 1) PG8_BAR;
        PG8_WAIT_V(4); PG8_BAR;
        PG8_STAGE(PG8_SB(1, 0), cB + kstep, voffB); PG8_STAGE(PG8_SA(1, 0), cA + kstep, voffA); PG8_STAGE(PG8_SB(1, 1), cB + hstep + kstep, voffB);
        PG8_WAIT_V(6); PG8_BAR;
    }
    for (;;) {
        const bool has_next = S.next(ui + 1, nxt);
        const char* nA = has_next ? (const char*)g.A + (size_t)nxt.pm * tstep : cA; const char* nB = has_next ? (const char*)g.Bt + (size_t)nxt.pn * tstep : cB;
        for (int t = 0; t < nt; t += 2) {
            const bool last = (t == nt - 2);
            const char* a1 = cA + (size_t)(t + 1) * kstep;
            const char* a2 = last ? nA : cA + (size_t)(t + 2) * kstep; const char* b2 = last ? nB : cB + (size_t)(t + 2) * kstep;
            const char* a3 = a2 + kstep; const char* b3 = b2 + kstep;
            if (last && has_next) S.a_ready(nxt);
            if constexpr (SP2) {
            PG8_LDB(B0, 0, 0); PG8_LDB(B1, 0, 1); PG8_SCHED; PG8_LDA(At, 0, 0); PG8_STAGE(PG8_SA(1, 1), a1 + hstep, voffA);
            PG8_WAIT_V(8); PG8_WAIT_L(0); PG8_BAR; PG8_MMA(0, 0, At, B0); PG8_MMA(0, 1, At, B1); PG8_BAR; PG8_SCHED;
            PG8_LDA(At, 0, 1); PG8_STAGE(PG8_SB(0, 0), b2, voffB); PG8_STAGE(PG8_SB(0, 1), b2 + hstep, voffB); PG8_STAGE(PG8_SA(0, 0), a2, voffA);
            PG8_WAIT_V(8); PG8_WAIT_L(0); PG8_BAR; PG8_MMA(1, 0, At, B0); PG8_MMA(1, 1, At, B1); PG8_BAR; PG8_SCHED;
            PG8_LDB(B0, 1, 0); PG8_LDB(B1, 1, 1); PG8_SCHED; PG8_LDA(At, 1, 0); PG8_STAGE(PG8_SA(0, 1), a2 + hstep, voffA);
            PG8_WAIT_V(8); PG8_WAIT_L(0); PG8_BAR; PG8_MMA(0, 0, At, B0); PG8_MMA(0, 1, At, B1); PG8_BAR; PG8_SCHED;
            PG8_LDA(At, 1, 1); PG8_STAGE(PG8_SB(1, 0), b3, voffB); PG8_STAGE(PG8_SB(1, 1), b3 + hstep, voffB); PG8_STAGE(PG8_SA(1, 0), a3, voffA);
            PG8_WAIT_V(8); PG8_WAIT_L(0); PG8_BAR; PG8_MMA(1, 0, At, B0); PG8_MMA(1, 1, At, B1); PG8_BAR; PG8_SCHED;
            } else {
            PG8_LDB(B0, 0, 0); PG8_SCHED; PG8_LDA(At, 0, 0); PG8_STAGE(PG8_SA(1, 1), a1 + hstep, voffA);
            PG8_WAIT_L(8); PG8_BAR; PG8_WAIT_L(0); PG8_MMA(0, 0, At, B0); PG8_BAR; PG8_SCHED;
            PG8_LDB(B1, 0, 1); PG8_STAGE(PG8_SB(0, 0), b2, voffB);
            PG8_BAR; PG8_WAIT_L(0); PG8_MMA(0, 1, At, B1); PG8_BAR;
            PG8_LDA(At, 0, 1); PG8_STAGE(PG8_SA(0, 0), a2, voffA);
            PG8_BAR; PG8_WAIT_L(0); PG8_MMA(1, 0, At, B0); PG8_BAR; PG8_SCHED;
            PG8_STAGE(PG8_SB(0, 1), b2 + hstep, voffB);
            PG8_WAIT_V(6); PG8_BAR; PG8_MMA(1, 1, At, B1); PG8_BAR;
            PG8_LDB(B0, 1, 0); PG8_SCHED; PG8_LDA(At, 1, 0); PG8_STAGE(PG8_SA(0, 1), a2 + hstep, voffA);
            PG8_WAIT_L(8); PG8_BAR; PG8_WAIT_L(0); PG8_MMA(0, 0, At, B0); PG8_BAR; PG8_SCHED;
            PG8_LDB(B1, 1, 1); PG8_STAGE(PG8_SB(1, 0), b3, voffB);
            PG8_BAR; PG8_WAIT_L(0); PG8_MMA(0, 1, At, B1); PG8_BAR;
            PG8_LDA(At, 1, 1); PG8_STAGE(PG8_SA(1, 0), a3, voffA);
            PG8_BAR; PG8_WAIT_L(0); PG8_MMA(1, 0, At, B0); PG8_BAR; PG8_SCHED;
            PG8_STAGE(PG8_SB(1, 1), b3 + hstep, voffB);
            PG8_WAIT_V(6); PG8_BAR; PG8_MMA(1, 1, At, B1); PG8_BAR;
            }
        }
        if constexpr (ALIGN_EPI) { if (wr == 0) PG8_BAR; }
        if constexpr (!Epi::AFTER_DRAIN) { E(acc, cur, wr, wc, fr, fq); S.done(cur); }
        if (!has_next) break;
#pragma unroll
        for (int a = 0; a < 2; ++a)
#pragma unroll
            for (int b = 0; b < 2; ++b)
#pragma unroll
                for (int m = 0; m < 4; ++m)
#pragma unroll
                    for (int n = 0; n < 2; ++n) acc[a][b][m][n] = (f32x4){0.f, 0.f, 0.f, 0.f};
        cur = nxt; cA = nA; cB = nB; ++ui;
        if constexpr (ALIGN_EPI) { if (wr == 1) PG8_BAR; }
    }
    PG8_WAIT_V(0);
    if constexpr (!ALIGN_EPI) { if (wr == 0) PG8_BAR; }
    PG8_BAR;
    if constexpr (Epi::AFTER_DRAIN) { E.fused(acc, cur, wr, wc, fr, fq, lds, wid, lane); S.done(cur); }
#undef PG8_SA
#undef PG8_SB
#undef PG8_STAGE
#undef PG8_LDA
#undef PG8_LDB
#undef PG8_MMA
#undef PG8_WAIT_V
#undef PG8_WAIT_L
#undef PG8_BAR
#undef PG8_SCHED
}
}
#define GAS __attribute__((address_space(1)))
#define LAS __attribute__((address_space(3)))
#define XB_TMO      128
#define XB_XCNT(j)  (256  + 64 * (j))
#define XB_XSUB(j)  (1280 + 64 * (j))
#define XB_XGEN(j)  (2304 + 64 * (j))
#define XB_TOP      3328
#define XB_TOPGEN   3392
#define XCD_BAR_WORDS 3456
#define XB_SPIN_CAP (1u << 18)

__device__ __forceinline__ unsigned xb_ld(unsigned* p)              { return __hip_atomic_load(p, __ATOMIC_RELAXED, __HIP_MEMORY_SCOPE_AGENT); }
__device__ __forceinline__ unsigned xb_add(unsigned* p, unsigned v) { return __hip_atomic_fetch_add(p, v, __ATOMIC_RELAXED, __HIP_MEMORY_SCOPE_AGENT); }
__device__ __forceinline__ unsigned xb_xcc_id() { return (unsigned)__builtin_amdgcn_s_getreg((3 << 11) | 20) & 0xFu; }
#define XB_SPIN(cond, bar) do { unsigned _sp = 0; while (cond) { __builtin_amdgcn_s_sleep(1); \
    if ((++_sp & 255u) == 0u) { if (xb_ld(&(bar)[XB_TMO])) break; if (_sp > XB_SPIN_CAP) { atomicAdd(&(bar)[XB_TMO], 1u); break; } } } } while (0)

struct XcdBarrier {
    unsigned* bar; unsigned x;
    volatile LAS unsigned* st;
};

__device__ __forceinline__ XcdBarrier xcd_barrier_post(unsigned* bar, volatile LAS unsigned* st) {
    XcdBarrier b; b.bar = bar; b.x = xb_xcc_id(); b.st = st;
    if (threadIdx.x == 0) (void)xb_add(&bar[XB_XCNT(b.x)], 1u);
    return b;
}
__device__ __forceinline__ void xcd_barrier_complete(unsigned* bar, unsigned x, unsigned& nloc, unsigned& nx) {
    const unsigned G = gridDim.x * gridDim.y * gridDim.z;
    unsigned sum, cnt, mine, sp = 0u;
    for (;;) {
        sum = 0u; cnt = 0u; mine = 0u;
#pragma unroll
        for (unsigned j = 0; j < 16; ++j) { const unsigned c = xb_ld(&bar[XB_XCNT(j)]); sum += c; cnt += (c > 0u) ? 1u : 0u; mine = (j == x) ? c : mine; }
        if (sum == G) break;
        __builtin_amdgcn_s_sleep(1);
        if ((++sp & 255u) == 0u) { if (xb_ld(&bar[XB_TMO])) break; if (sp > XB_SPIN_CAP) { atomicAdd(&bar[XB_TMO], 1u); break; } }
    }
    nloc = mine > 0u ? mine : 1u; nx = cnt > 0u ? cnt : 1u;
}

__device__ __forceinline__ void xcd_barrier(const XcdBarrier& b) {
    asm volatile("s_waitcnt vmcnt(0)" ::: "memory");
    __syncthreads();
    if (threadIdx.x == 0) {
        unsigned* bar = b.bar;
        __builtin_amdgcn_s_waitcnt(0);
        unsigned nloc = b.st[0], nx = b.st[1];
        if (nloc == 0u) { xcd_barrier_complete(bar, b.x, nloc, nx); b.st[0] = nloc; b.st[1] = nx; }
        const unsigned old = xb_add(&bar[XB_XSUB(b.x)], 1u);
        const unsigned gen = old / nloc;
        if (old + 1u == (gen + 1u) * nloc) {
            __builtin_amdgcn_fence(__ATOMIC_RELEASE, "agent");
            asm volatile("s_waitcnt vmcnt(0)" ::: "memory");
            const unsigned og = xb_add(&bar[XB_TOP], 1u);
            const unsigned tg = og / nx;
            if (og + 1u == (tg + 1u) * nx) xb_add(&bar[XB_TOPGEN], 1u);
            else XB_SPIN(xb_ld(&bar[XB_TOPGEN]) == tg, bar);
            __builtin_amdgcn_fence(__ATOMIC_ACQUIRE, "agent");
            xb_add(&bar[XB_XGEN(b.x)], 1u);
            asm volatile("s_waitcnt vmcnt(0)" ::: "memory");
        } else {
            XB_SPIN(xb_ld(&bar[XB_XGEN(b.x)]) == gen, bar);
            __builtin_amdgcn_fence(__ATOMIC_ACQUIRE, "agent");
            asm volatile("s_waitcnt vmcnt(0)" ::: "memory");
        }
    }
    __syncthreads();
}

#ifndef MK_N_LAUNCHES
#define MK_N_LAUNCHES 1
#endif
constexpr int NWAVES = 8;
constexpr int DM = 2048, SEQ = 2048, NBATCH = 4, MP = NBATCH * SEQ, MS = 32, MT = MP + MS;
constexpr int INC = 3584, FF = 8192, NH = 16, NKV = 4, HD = 64, CCH = 1024, CW = 31;
constexpr float EPS = 1e-6f;
constexpr size_t O_YP = 0, O_YS = (size_t)MP * DM, O_KP = O_YS + (size_t)MS * DM, O_VP = O_KP + 131072, O_CP = O_VP + 131072,
                 O_KS = O_CP + 122880, O_VS = O_KS + 1048576, O_CS = O_VS + 1048576, O_END = O_CS + 983040;
constexpr size_t MiB = 1u << 20;
constexpr size_t WS_CTL = 0, CTL_ZERO_BYTES = 1 * MiB;
constexpr size_t WS_SSQ = 512 * 1024;
constexpr size_t WS_COS = 1 * MiB, WS_SIN = 2 * MiB;
constexpr size_t WS_ZS = 3 * MiB;
constexpr size_t WS_WIN = 4 * MiB, WS_WOUT = 18 * MiB, WS_WUP = 26 * MiB, WS_WDN = 58 * MiB;
constexpr size_t WS_X1G = 90 * MiB;
constexpr size_t WS_HID = 123 * MiB;
constexpr size_t WS_XN = 123 * MiB, WS_Q = 156 * MiB, WS_K = 172 * MiB, WS_V = 176 * MiB, WS_U = 180 * MiB, WS_MIX = 196 * MiB;
constexpr size_t WS_END = 256 * MiB;
static_assert(WS_HID + (size_t)MT * FF * 2 <= WS_END && WS_MIX + (size_t)MT * DM * 2 <= WS_END && WS_X1G + (size_t)MT * DM * 2 <= WS_HID, "ws map");
constexpr int CW_BAR = 4096;
constexpr int RING_BYTES = 131072, LDSCTL_OFF = RING_BYTES, MISC_OFF = LDSCTL_OFF + 320, LDS_BYTES = 147456;

typedef unsigned short bf16;
typedef unsigned v4u __attribute__((ext_vector_type(4)));
typedef unsigned v2u __attribute__((ext_vector_type(2)));
typedef float f32x4 __attribute__((ext_vector_type(4)));
typedef float f32x2 __attribute__((ext_vector_type(2)));
typedef short bf16x8 __attribute__((ext_vector_type(8)));
#define LDS_WAIT() asm volatile("s_waitcnt lgkmcnt(0)" ::: "memory")
__device__ __forceinline__ unsigned f2bf(float f) { unsigned u = __builtin_bit_cast(unsigned, f); return (u + 0x7fffu + ((u >> 16) & 1u)) >> 16; }
__device__ __forceinline__ unsigned pk2(float lo, float hi) { return pg8::cvt_pk_bf16(lo, hi); }
__device__ __forceinline__ float bf2f(unsigned h) { return __builtin_bit_cast(float, h << 16); }
__device__ __forceinline__ float wave_sum(float v) {
#pragma unroll
    for (int o = 1; o < 64; o <<= 1) v += __shfl_xor(v, o);
    return v;
}
__device__ __forceinline__ float wave_max(float v) {
#pragma unroll
    for (int o = 1; o < 64; o <<= 1) v = fmaxf(v, __shfl_xor(v, o));
    return v;
}
__device__ __forceinline__ float dot4(f32x4 a, f32x4 b) { return (a[0] * b[0] + a[1] * b[1]) + (a[2] * b[2] + a[3] * b[3]); }
__device__ __forceinline__ float sigmoidf_(float g) { return 1.0f / (1.0f + __expf(-g)); }

__device__ __forceinline__ int win_dst_group(int sg) {
    if (sg < 48) { const int pn = sg >> 3, wc = (sg & 7) >> 1, bj = sg & 1; return 8 * pn + 4 * bj + wc; }
    if (sg < 80) { const int cc = sg - 48; return 8 * (6 + (cc >> 2)) + (cc & 3); }
    const int cc = sg - 80; return 8 * (6 + (cc >> 2)) + 4 + (cc & 3);
}
__device__ __forceinline__ int win_logical_col(int np) {
    const int dg = np >> 5, e = np & 31, pn = dg >> 3, bj = (dg >> 2) & 1, wc = dg & 3;
    if (dg < 48) return 256 * pn + 64 * wc + 32 * bj + e;
    return (bj ? 2560 : 1536) + 128 * (pn - 6) + 32 * wc + e;
}

using pg8::Unit;
struct Epi1 {
    static constexpr bool PERM = true, AFTER_DRAIN = false;
    bf16 *Q, *K, *V, *U; float* out; const float *gq, *gk, *cosT, *sinT;
    __device__ __forceinline__ void operator()(const f32x4 (&acc)[2][2][4][2], const Unit& u, int wr, int wc, int fr, int fq) const {
        const int pn = u.pn, rbase = u.pm * 256 + wr * 64 + fr;
        if (pn < 5) {
            const float* g = pn < 4 ? gq : gk; const float qs = pn < 4 ? 0.125f : 1.0f;
            const f32x4 g1a = *(const f32x4*)(g + 8 * fq), g1b = *(const f32x4*)(g + 8 * fq + 4), g2a = *(const f32x4*)(g + 32 + 8 * fq), g2b = *(const f32x4*)(g + 36 + 8 * fq);
#pragma unroll
            for (int ai = 0; ai < 2; ++ai)
#pragma unroll
                for (int m = 0; m < 4; ++m) {
                    const int r = rbase + ai * 128 + m * 16, s = r & (SEQ - 1), b = r >> 11;
                    const f32x4 x1a = acc[ai][0][m][0], x1b = acc[ai][0][m][1], x2a = acc[ai][1][m][0], x2b = acc[ai][1][m][1];
                    float ss = (dot4(x1a, x1a) + dot4(x1b, x1b)) + (dot4(x2a, x2a) + dot4(x2b, x2b));
                    ss += __shfl_xor(ss, 16); ss += __shfl_xor(ss, 32);
                    const float rstd = rsqrtf(ss * (1.0f / 64.0f) + EPS);
                    const f32x4 y1a = x1a * rstd * g1a, y1b = x1b * rstd * g1b, y2a = x2a * rstd * g2a, y2b = x2b * rstd * g2b;
                    const f32x4 ca = *(const f32x4*)(cosT + s * 32 + 8 * fq), cb = *(const f32x4*)(cosT + s * 32 + 8 * fq + 4);
                    const f32x4 sa = *(const f32x4*)(sinT + s * 32 + 8 * fq), sb = *(const f32x4*)(sinT + s * 32 + 8 * fq + 4);
                    const f32x4 o1a = y1a * ca - y2a * sa, o1b = y1b * cb - y2b * sb, o2a = y2a * ca + y1a * sa, o2b = y2b * cb + y1b * sb;
                    v4u w1, w2;
                    w1.x = pk2(o1a[0] * qs, o1a[1] * qs); w1.y = pk2(o1a[2] * qs, o1a[3] * qs); w1.z = pk2(o1b[0] * qs, o1b[1] * qs); w1.w = pk2(o1b[2] * qs, o1b[3] * qs);
                    w2.x = pk2(o2a[0] * qs, o2a[1] * qs); w2.y = pk2(o2a[2] * qs, o2a[3] * qs); w2.z = pk2(o2b[0] * qs, o2b[1] * qs); w2.w = pk2(o2b[2] * qs, o2b[3] * qs);
                    if (pn < 4) {
                        bf16* p = Q + (size_t)r * 1024 + 64 * (4 * pn + wc) + 8 * fq;
                        *(v4u*)p = w1; *(v4u*)(p + 32) = w2;
                    } else {
                        bf16* p = K + (size_t)r * 256 + 64 * wc + 8 * fq;
                        *(v4u*)p = w1; *(v4u*)(p + 32) = w2;
                        if (s >= SEQ - 128) {
                            float* o = out + O_KP + ((size_t)(b * 128 + s - (SEQ - 128)) * 4 + wc) * 64 + 8 * fq;
                            *(f32x4*)o = o1a; *(f32x4*)(o + 4) = o1b; *(f32x4*)(o + 32) = o2a; *(f32x4*)(o + 36) = o2b;
                        }
                    }
                }
        } else if (pn == 5) {
#pragma unroll
            for (int ai = 0; ai < 2; ++ai)
#pragma unroll
                for (int m = 0; m < 4; ++m) {
                    const int r = rbase + ai * 128 + m * 16, s = r & (SEQ - 1), b = r >> 11;
#pragma unroll
                    for (int bj = 0; bj < 2; ++bj) {
                        const f32x4 v0 = acc[ai][bj][m][0], v1 = acc[ai][bj][m][1];
                        v4u w; w.x = pk2(v0[0], v0[1]); w.y = pk2(v0[2], v0[3]); w.z = pk2(v1[0], v1[1]); w.w = pk2(v1[2], v1[3]);
                        *(v4u*)(V + (size_t)r * 256 + 64 * wc + 32 * bj + 8 * fq) = w;
                        if (s >= SEQ - 128) {
                            float* o = out + O_VP + ((size_t)(b * 128 + s - (SEQ - 128)) * 4 + wc) * 64 + 32 * bj + 8 * fq;
                            *(f32x4*)o = v0; *(f32x4*)(o + 4) = v1;
                        }
                    }
                }
        } else {
            const int ch = 128 * (pn - 6) + 32 * wc + 8 * fq;
#pragma unroll
            for (int ai = 0; ai < 2; ++ai)
#pragma unroll
                for (int m = 0; m < 4; ++m) {
                    const int r = rbase + ai * 128 + m * 16, s = r & (SEQ - 1), b = r >> 11;
                    const f32x4 a0 = acc[ai][0][m][0], a1 = acc[ai][0][m][1], g0 = acc[ai][1][m][0], g1 = acc[ai][1][m][1];
                    f32x4 u0, u1;
#pragma unroll
                    for (int j = 0; j < 4; ++j) { u0[j] = a0[j] * sigmoidf_(g0[j]); u1[j] = a1[j] * sigmoidf_(g1[j]); }
                    v4u w; w.x = pk2(u0[0], u0[1]); w.y = pk2(u0[2], u0[3]); w.z = pk2(u1[0], u1[1]); w.w = pk2(u1[2], u1[3]);
                    *(v4u*)(U + (size_t)r * 1024 + ch) = w;
                    if (s >= SEQ - 30) {
                        float* o = out + O_CP + (size_t)(b * 30 + s - (SEQ - 30)) * 1024 + ch;
                        *(f32x4*)o = u0; *(f32x4*)(o + 4) = u1;
                    }
                }
        }
    }
};
struct Epi3 {
    static constexpr bool PERM = true, AFTER_DRAIN = false;
    const float* xp; float* Y; bf16* X1G; const float* gm; float* SSQ;
    __device__ __forceinline__ void operator()(const f32x4 (&acc)[2][2][4][2], const Unit& u, int wr, int wc, int fr, int fq) const {
        const int rbase = u.pm * 256 + wr * 64 + fr, col0 = u.pn * 256 + wc * 32 + 8 * fq;
        f32x4 gv[2][2];
#pragma unroll
        for (int bj = 0; bj < 2; ++bj)
#pragma unroll
            for (int n = 0; n < 2; ++n) gv[bj][n] = *(const f32x4*)(gm + col0 + bj * 128 + 4 * n);
#pragma unroll
        for (int ai = 0; ai < 2; ++ai)
#pragma unroll
            for (int m = 0; m < 4; ++m) {
                const int r = rbase + ai * 128 + m * 16; float ss = 0.f;
#pragma unroll
                for (int bj = 0; bj < 2; ++bj) {
                    const size_t off = (size_t)r * DM + col0 + bj * 128;
                    const f32x4 v0 = acc[ai][bj][m][0] + *(const f32x4*)(xp + off), v1 = acc[ai][bj][m][1] + *(const f32x4*)(xp + off + 4);
                    *(f32x4*)(Y + off) = v0; *(f32x4*)(Y + off + 4) = v1;
                    ss += dot4(v0, v0) + dot4(v1, v1);
                    const f32x4 h0 = v0 * gv[bj][0], h1 = v1 * gv[bj][1];
                    v4u w; w.x = pk2(h0[0], h0[1]); w.y = pk2(h0[2], h0[3]); w.z = pk2(h1[0], h1[1]); w.w = pk2(h1[2], h1[3]);
                    *(v4u*)(X1G + off) = w;
                }
                ss += __shfl_xor(ss, 16); ss += __shfl_xor(ss, 32);
                if (fq == 0) atomicAdd(SSQ + r, ss);
            }
    }
};
struct Epi4 {
    static constexpr bool PERM = true, AFTER_DRAIN = false;
    float* SSQ; bf16* H;
    __device__ __forceinline__ void operator()(const f32x4 (&acc)[2][2][4][2], const Unit& u, int wr, int wc, int fr, int fq) const {
        const int rbase = u.pm * 256 + wr * 64 + fr, col0 = u.pn * 256 + wc * 32 + 8 * fq;
#pragma unroll
        for (int ai = 0; ai < 2; ++ai)
#pragma unroll
            for (int m = 0; m < 4; ++m) {
                const int r = rbase + ai * 128 + m * 16;
                const float rstd = rsqrtf(__hip_atomic_load(SSQ + r, __ATOMIC_RELAXED, __HIP_MEMORY_SCOPE_AGENT) * (1.0f / DM) + EPS);
#pragma unroll
                for (int bj = 0; bj < 2; ++bj) {
                    f32x4 v0 = acc[ai][bj][m][0] * rstd, v1 = acc[ai][bj][m][1] * rstd;
#pragma unroll
                    for (int j = 0; j < 4; ++j) { v0[j] = fmaxf(v0[j], 0.f); v0[j] *= v0[j]; v1[j] = fmaxf(v1[j], 0.f); v1[j] *= v1[j]; }
                    v4u w; w.x = pk2(v0[0], v0[1]); w.y = pk2(v0[2], v0[3]); w.z = pk2(v1[0], v1[1]); w.w = pk2(v1[2], v1[3]);
                    *(v4u*)(H + (size_t)r * FF + col0 + bj * 128) = w;
                }
            }
    }
};
struct Epi5 {
    static constexpr bool PERM = true, AFTER_DRAIN = false;
    float* Y; float sc;
    __device__ __forceinline__ void operator()(const f32x4 (&acc)[2][2][4][2], const Unit& u, int wr, int wc, int fr, int fq) const {
        const int rbase = u.pm * 256 + wr * 64 + fr, col0 = u.pn * 256 + wc * 32 + 8 * fq;
#pragma unroll
        for (int ai = 0; ai < 2; ++ai)
#pragma unroll
            for (int m = 0; m < 4; ++m) {
                const int r = rbase + ai * 128 + m * 16;
#pragma unroll
                for (int bj = 0; bj < 2; ++bj) {
                    float* p = Y + (size_t)r * DM + col0 + bj * 128;
                    const f32x4 v0 = acc[ai][bj][m][0] * sc + *(const f32x4*)p, v1 = acc[ai][bj][m][1] * sc + *(const f32x4*)(p + 4);
                    *(f32x4*)p = v0; *(f32x4*)(p + 4) = v1;
                }
            }
    }
};

template <class EpiS>
__device__ __forceinline__ void skinny_phase(LAS unsigned char* lds, const bf16* As, const bf16* Bt, int N, int K, int start, int stride, const EpiS& E) {
    const int tid = threadIdx.x, wave = __builtin_amdgcn_readfirstlane(tid >> 6), lane = tid & 63, fr = lane & 15, fq = lane >> 4;
    LAS float* red = (LAS float*)lds;
    const int kw = K >> 3, kb = wave * kw;
    for (int unit = start; unit < (N >> 4); unit += stride) {
        f32x4 a0 = {0.f, 0.f, 0.f, 0.f}, a1 = {0.f, 0.f, 0.f, 0.f};
        const bf16* bp = Bt + (size_t)(16 * unit + fr) * K + kb + 8 * fq;
        const bf16* ap0 = As + (size_t)fr * K + kb + 8 * fq;
        const bf16* ap1 = ap0 + (size_t)16 * K;
#pragma unroll 4
        for (int k = 0; k < kw; k += 32) {
            const bf16x8 b = *(const bf16x8*)(bp + k), x0 = *(const bf16x8*)(ap0 + k), x1 = *(const bf16x8*)(ap1 + k);
            a0 = __builtin_amdgcn_mfma_f32_16x16x32_bf16(b, x0, a0, 0, 0, 0);
            a1 = __builtin_amdgcn_mfma_f32_16x16x32_bf16(b, x1, a1, 0, 0, 0);
        }
        *(LAS f32x4*)(red + (wave * 2 + 0) * 256 + lane * 4) = a0;
        *(LAS f32x4*)(red + (wave * 2 + 1) * 256 + lane * 4) = a1;
        __syncthreads();
        const int row = tid >> 4, cj = tid & 15, idx = (row >> 4) * 256 + ((row & 15) + 16 * (cj >> 2)) * 4 + (cj & 3);
        float s = 0.f;
#pragma unroll
        for (int w = 0; w < 8; ++w) s += red[w * 512 + idx];
        E(row, 16 * unit + cj, s);
        __syncthreads();
    }
}
struct EpiS1 { float* ZS; __device__ __forceinline__ void operator()(int row, int col, float v) const { ZS[row * INC + win_logical_col(col)] = v; } };
struct EpiS3 { const float* xs; float* Y; bf16* X1G; const float* gm; float* SSQ;
    __device__ __forceinline__ void operator()(int row, int col, float v) const {
        const float x1 = xs[row * DM + col] + v; Y[(size_t)(MP + row) * DM + col] = x1; X1G[(size_t)(MP + row) * DM + col] = (bf16)f2bf(x1 * gm[col]);
        float ss = x1 * x1; ss += __shfl_xor(ss, 1); ss += __shfl_xor(ss, 2); ss += __shfl_xor(ss, 4); ss += __shfl_xor(ss, 8);
        if ((threadIdx.x & 15) == 0) atomicAdd(SSQ + MP + row, ss);
    } };
struct EpiS4 { float* SSQ; bf16* H;
    __device__ __forceinline__ void operator()(int row, int col, float v) const {
        const float rstd = rsqrtf(__hip_atomic_load(SSQ + MP + row, __ATOMIC_RELAXED, __HIP_MEMORY_SCOPE_AGENT) * (1.0f / DM) + EPS);
        float h = fmaxf(v * rstd, 0.f); h *= h; H[(size_t)(MP + row) * FF + col] = (bf16)f2bf(h);
    } };
struct EpiS5 { float* Y; float sc; __device__ __forceinline__ void operator()(int row, int col, float v) const { float* p = Y + (size_t)(MP + row) * DM + col; *p = *p + v * sc; } };

template <class Dec>
__device__ __forceinline__ void cvt_items(LAS float* scr, int first, int total, int stride, int lane, const Dec& D) {
    const int r8 = lane >> 3, c4 = lane & 7;
    int it = first; if (it >= total) return;
    const float* src; bf16* dst; int N, K;
    D(it, src, N, dst, K);
    f32x4 v[8], vn[8];
#pragma unroll
    for (int i = 0; i < 8; ++i) v[i] = __builtin_nontemporal_load((const f32x4*)(src + (size_t)(r8 + 8 * i) * N + 4 * c4));
    for (;;) {
        const int nx = it + stride; const bool has = nx < total;
        const float* src2 = src; bf16* dst2 = dst; int N2 = N, K2 = K;
        if (has) { D(nx, src2, N2, dst2, K2);
#pragma unroll
            for (int i = 0; i < 8; ++i) vn[i] = __builtin_nontemporal_load((const f32x4*)(src2 + (size_t)(r8 + 8 * i) * N2 + 4 * c4)); }
#pragma unroll
        for (int i = 0; i < 8; ++i) { LAS float* s = scr + (r8 + 8 * i) * 33 + 4 * c4; s[0] = v[i][0]; s[1] = v[i][1]; s[2] = v[i][2]; s[3] = v[i][3]; }
        LDS_WAIT(); asm volatile("" ::: "memory");
        const int c = lane & 7;
#pragma unroll
        for (int j = 0; j < 4; ++j) { const int n = (lane >> 3) + 8 * j; const LAS float* s = scr + (8 * c) * 33 + n;
            v4u o; o.x = pk2(s[0 * 33], s[1 * 33]); o.y = pk2(s[2 * 33], s[3 * 33]); o.z = pk2(s[4 * 33], s[5 * 33]); o.w = pk2(s[6 * 33], s[7 * 33]);
            *(v4u*)(dst + (size_t)n * K + 8 * c) = o; }
        LDS_WAIT(); asm volatile("" ::: "memory");
        if (!has) break;
#pragma unroll
        for (int i = 0; i < 8; ++i) v[i] = vn[i];
        dst = dst2; K = K2; it = nx;
    }
}
struct DecP0 { const float *w_in, *w_out; bf16 *WinT, *WoutT;
    __device__ __forceinline__ void operator()(int it, const float*& src, int& N, bf16*& dst, int& K) const {
        constexpr int I_IN = (DM / 64) * (INC / 32);
        if (it < I_IN) { const int kb = it / (INC / 32), nb = it % (INC / 32); src = w_in + (size_t)(64 * kb) * INC + 32 * nb; N = INC; K = DM; dst = WinT + (size_t)(32 * win_dst_group(nb)) * DM + 64 * kb; }
        else { const int r = it - I_IN, kb = r / (DM / 32), nb = r % (DM / 32); src = w_out + (size_t)(64 * kb) * DM + 32 * nb; N = DM; K = DM; dst = WoutT + (size_t)(32 * nb) * DM + 64 * kb; }
    } };
struct DecP1 { const float *w_up, *w_down; bf16 *WupT, *WdnT;
    __device__ __forceinline__ void operator()(int it, const float*& src, int& N, bf16*& dst, int& K) const {
        constexpr int I_UP = (DM / 64) * (FF / 32);
        if (it < I_UP) { const int kb = it / (FF / 32), nb = it % (FF / 32); src = w_up + (size_t)(64 * kb) * FF + 32 * nb; N = FF; K = DM; dst = WupT + (size_t)(32 * nb) * DM + 64 * kb; }
        else { const int r = it - I_UP, kb = r / (DM / 32), nb = r % (DM / 32); src = w_down + (size_t)(64 * kb) * DM + 32 * nb; N = DM; K = FF; dst = WdnT + (size_t)(32 * nb) * FF + 64 * kb; }
    } };
__device__ __forceinline__ void rms_row_to_bf16(const float* xrow, const float* g, bf16* orow, int lane) {
    const f32x4* xr = (const f32x4*)xrow + lane; const f32x4* gr = (const f32x4*)g + lane;
    f32x4 v[8]; float s = 0.f;
#pragma unroll
    for (int j = 0; j < 8; ++j) { v[j] = xr[64 * j]; s += dot4(v[j], v[j]); }
    const float rstd = rsqrtf(wave_sum(s) * (1.0f / DM) + EPS);
    v2u* o8 = (v2u*)orow + lane;
#pragma unroll
    for (int j = 0; j < 8; ++j) { const f32x4 y = v[j] * rstd * gr[64 * j]; v2u w; w.x = pk2(y[0], y[1]); w.y = pk2(y[2], y[3]); o8[64 * j] = w; }
}

constexpr int KS_STRIDE = 72, VT_STRIDE = 276, KS_BYTES = 272 * KS_STRIDE * 2, VT_BYTES = 64 * VT_STRIDE * 2;
__device__ __forceinline__ void attn_unit(LAS unsigned char* lds, int b, int nb, int kh, const bf16* Q, const bf16* Kb, const bf16* Vb, bf16* MIX, const float* sinks,
                                          int tid, int wave, int lane) {
    LAS bf16* Ks = (LAS bf16*)lds; LAS bf16* Vt = (LAS bf16*)(lds + KS_BYTES);
    const int fr = lane & 15, fq = lane >> 4;
#pragma unroll
    for (int p = 0; p < 4; ++p) {
        const int idx = p * 512 + tid, key = idx >> 3, c = idx & 7, s = 128 * (nb - 1) + key;
        v4u kv = {0u, 0u, 0u, 0u}, vv = {0u, 0u, 0u, 0u};
        if (s >= 0) { const size_t off = (size_t)(b * SEQ + s) * 256 + 64 * kh + 8 * c; kv = *(const v4u*)(Kb + off); vv = *(const v4u*)(Vb + off); }
        *(LAS v4u*)(Ks + key * KS_STRIDE + 8 * c) = kv;
        LAS bf16* vp = Vt + (8 * c) * VT_STRIDE + key;
        vp[0 * VT_STRIDE] = (bf16)(vv.x & 0xffffu); vp[1 * VT_STRIDE] = (bf16)(vv.x >> 16); vp[2 * VT_STRIDE] = (bf16)(vv.y & 0xffffu); vp[3 * VT_STRIDE] = (bf16)(vv.y >> 16);
        vp[4 * VT_STRIDE] = (bf16)(vv.z & 0xffffu); vp[5 * VT_STRIDE] = (bf16)(vv.z >> 16); vp[6 * VT_STRIDE] = (bf16)(vv.w & 0xffffu); vp[7 * VT_STRIDE] = (bf16)(vv.w >> 16);
    }
    if (tid < 144) *(LAS v4u*)(Ks + 256 * KS_STRIDE + tid * 8) = (v4u){0u, 0u, 0u, 0u};
    for (int i = tid; i < 64 * 20; i += 512) Vt[(i / 20) * VT_STRIDE + 256 + (i % 20)] = 0;
    __syncthreads();
    const int g = wave >> 1, h = 4 * kh + g; const float sink = sinks[h];
#pragma unroll 1
    for (int qi = 0; qi < 4; ++qi) {
        const int qt = 4 * (wave & 1) + qi, i0 = 16 * qt;
        const size_t r = (size_t)b * SEQ + 128 * nb + i0 + fr;
        bf16x8 qf[2];
        qf[0] = *(const bf16x8*)(Q + r * 1024 + 64 * h + 8 * fq); qf[1] = *(const bf16x8*)(Q + r * 1024 + 64 * h + 32 + 8 * fq);
        f32x4 S[10];
#pragma unroll
        for (int t = 0; t < 10; ++t) {
            S[t] = (f32x4){0.f, 0.f, 0.f, 0.f};
#pragma unroll
            for (int ks = 0; ks < 2; ++ks) {
                const bf16x8 kf = *(const LAS bf16x8*)(Ks + (16 * (qt + t) + fr) * KS_STRIDE + 32 * ks + 8 * fq);
                S[t] = __builtin_amdgcn_mfma_f32_16x16x32_bf16(kf, qf[ks], S[t], 0, 0, 0);
            }
        }
        float mx = sink;
#pragma unroll
        for (int t = 0; t < 10; ++t)
#pragma unroll
            for (int j = 0; j < 4; ++j) {
                const int rel = 16 * t + 4 * fq + j - fr;
                const bool ok = rel >= 1 && rel <= 128 && (nb > 0 || (i0 + 16 * t + 4 * fq + j) >= 128);
                S[t][j] = ok ? S[t][j] : -1e30f; mx = fmaxf(mx, S[t][j]);
            }
        mx = fmaxf(mx, __shfl_xor(mx, 16)); mx = fmaxf(mx, __shfl_xor(mx, 32));
        float sum = 0.f;
#pragma unroll
        for (int t = 0; t < 10; ++t)
#pragma unroll
            for (int j = 0; j < 4; ++j) { S[t][j] = __expf(S[t][j] - mx); sum += S[t][j]; }
        sum += __shfl_xor(sum, 16); sum += __shfl_xor(sum, 32); sum += __expf(sink - mx);
        const float inv = 1.0f / sum;
        f32x4 O[4];
#pragma unroll
        for (int dt = 0; dt < 4; ++dt) O[dt] = (f32x4){0.f, 0.f, 0.f, 0.f};
#pragma unroll
        for (int k2 = 0; k2 < 5; ++k2) {
            v4u pw; pw.x = pk2(S[2 * k2][0], S[2 * k2][1]); pw.y = pk2(S[2 * k2][2], S[2 * k2][3]); pw.z = pk2(S[2 * k2 + 1][0], S[2 * k2 + 1][1]); pw.w = pk2(S[2 * k2 + 1][2], S[2 * k2 + 1][3]);
            const bf16x8 pf = __builtin_bit_cast(bf16x8, pw);
#pragma unroll
            for (int dt = 0; dt < 4; ++dt) {
                const LAS bf16* vp = Vt + (16 * dt + fr) * VT_STRIDE + 16 * (qt + 2 * k2) + 4 * fq;
                const v2u lo = *(const LAS v2u*)vp, hi = *(const LAS v2u*)(vp + 16);
                v4u vw; vw.x = lo.x; vw.y = lo.y; vw.z = hi.x; vw.w = hi.y;
                O[dt] = __builtin_amdgcn_mfma_f32_16x16x32_bf16(__builtin_bit_cast(bf16x8, vw), pf, O[dt], 0, 0, 0);
            }
        }
#pragma unroll
        for (int dt = 0; dt < 4; ++dt) {
            v2u w; w.x = pk2(O[dt][0] * inv, O[dt][1] * inv); w.y = pk2(O[dt][2] * inv, O[dt][3] * inv);
            *(v2u*)(MIX + r * DM + 64 * h + 16 * dt + 4 * fq) = w;
        }
    }
    __syncthreads();
}

__device__ __forceinline__ void conv_unit(LAS unsigned char* lds, int b, int tb, const bf16* U, bf16* MIX, const float* cw, const float* cb, const float* lg, const float* lb,
                                          int tid, int wave, int lane) {
    LAS unsigned* tile = (LAS unsigned*)lds;
    LAS float* red = (LAS float*)(lds + 62 * 2048);
    LAS float* fin = red + 512;
    const int s0 = 32 * tb;
    for (int i = tid; i < 62 * 128; i += 512) {
        const int row = i >> 7, c16 = i & 127, s = s0 - 30 + row;
        v4u v = {0u, 0u, 0u, 0u};
        if (s >= 0) v = *(const v4u*)(U + (size_t)(b * SEQ + s) * 1024 + 8 * c16);
        *(LAS v4u*)(tile + row * 512 + 4 * c16) = v;
    }
    f32x2 w[31];
#pragma unroll
    for (int j = 0; j < 31; ++j) w[j] = *(const f32x2*)(cw + j * 1024 + 2 * tid);
    const f32x2 bias = *(const f32x2*)(cb + 2 * tid);
    __syncthreads();
    const f32x2 g = *(const f32x2*)(lg + 2 * tid), be = *(const f32x2*)(lb + 2 * tid);
#pragma unroll 1
    for (int hf = 0; hf < 2; ++hf) {
        f32x2 c[16];
#pragma unroll
        for (int q = 0; q < 2; ++q) {
#pragma unroll
            for (int o = 0; o < 8; ++o) c[8 * q + o] = bias;
#pragma unroll
            for (int rr = 0; rr < 38; ++rr) {
                const unsigned pv = tile[(16 * hf + 8 * q + rr) * 512 + tid];
                const f32x2 v = {bf2f(pv & 0xffffu), bf2f(pv >> 16)};
#pragma unroll
                for (int o = 0; o < 8; ++o) { const int j = rr - o; if (j >= 0 && j <= 30) c[8 * q + o] = c[8 * q + o] + w[j] * v; }
            }
#pragma unroll
            for (int o = 0; o < 8; ++o) {
                const f32x2 x = c[8 * q + o];
                const float s1 = wave_sum(x[0] + x[1]), s2 = wave_sum(x[0] * x[0] + x[1] * x[1]);
                if (lane == 0) { red[(wave * 16 + 8 * q + o) * 2] = s1; red[(wave * 16 + 8 * q + o) * 2 + 1] = s2; }
            }
        }
        __syncthreads();
        if (tid < 32) { float s = 0.f;
#pragma unroll
            for (int wv = 0; wv < 8; ++wv) s += red[wv * 32 + tid];
            fin[tid] = s; }
        __syncthreads();
#pragma unroll
        for (int t = 0; t < 16; ++t) {
            const float mean = fin[2 * t] * (1.0f / CCH), var = fin[2 * t + 1] * (1.0f / CCH) - mean * mean, rstd = rsqrtf(fmaxf(var, 0.f) + EPS);
            const f32x2 y = (c[t] - mean) * rstd * g + be;
            const float o0 = y[0] * sigmoidf_(y[0]), o1 = y[1] * sigmoidf_(y[1]);
            *(unsigned*)(MIX + (size_t)(b * SEQ + s0 + 16 * hf + t) * DM + 1024 + 2 * tid) = pk2(o0, o1);
        }
    }
    __syncthreads();
}

__device__ __forceinline__ void sample_mixer(LAS unsigned char* lds, int b, const float* ZS, const float* cache_k, const float* cache_v, const float* state,
                                             const float* gq, const float* gk, const float* sinks, const float* cw, const float* cb, const float* lg, const float* lb,
                                             const float* cosT, const float* sinT, float* out, bf16* MIX, int tid, int wave, int lane) {
    LAS float* zs = (LAS float*)lds;
    LAS float* qs = zs + 3584;
    LAS float* kn = qs + 1024;
    LAS float* vn = kn + 256;
    LAS float* sc = vn + 256;
    LAS float* rd = sc + 2048;
    LAS float* part = rd + 16;
    for (int i = tid; i < INC; i += 512) zs[i] = ZS[b * INC + i];
    __syncthreads();
    for (int hh = wave; hh < 20; hh += 8) {
        const int base = hh < 16 ? 64 * hh : 1024 + 64 * (hh - 16);
        const float x = zs[base + lane];
        const float rstd = rsqrtf(wave_sum(x * x) * (1.0f / 64.0f) + EPS);
        const float y = x * rstd * (hh < 16 ? gq : gk)[lane];
        const float p = __shfl_xor(y, 32);
        const float co = cosT[2048 * 32 + (lane & 31)], si = sinT[2048 * 32 + (lane & 31)];
        const float o = lane < 32 ? y * co - p * si : y * co + p * si;
        if (hh < 16) qs[hh * 64 + lane] = o * 0.125f;
        else { kn[(hh - 16) * 64 + lane] = o; out[O_KS + ((size_t)(b * 128 + 127) * 4 + (hh - 16)) * 64 + lane] = o; }
    }
    if (tid < 256) { const float vv = zs[1280 + tid]; vn[tid] = vv; out[O_VS + (size_t)(b * 128 + 127) * 256 + tid] = vv; }
    __syncthreads();
    {
        const int jj = tid >> 2, kh = tid & 3, j = jj + 1;
        float d0 = 0.f, d1 = 0.f, d2 = 0.f, d3 = 0.f;
        const LAS float* q0 = qs + (4 * kh) * 64;
        if (j < 128) {
            const f32x4* kr = (const f32x4*)(cache_k + ((size_t)(b * 128 + j) * 4 + kh) * 64);
#pragma unroll
            for (int d4 = 0; d4 < 16; ++d4) { const f32x4 kv = kr[d4];
                d0 += dot4(kv, *(const LAS f32x4*)(q0 + 4 * d4)); d1 += dot4(kv, *(const LAS f32x4*)(q0 + 64 + 4 * d4));
                d2 += dot4(kv, *(const LAS f32x4*)(q0 + 128 + 4 * d4)); d3 += dot4(kv, *(const LAS f32x4*)(q0 + 192 + 4 * d4)); }
        } else {
#pragma unroll 4
            for (int d4 = 0; d4 < 16; ++d4) { const f32x4 kv = *(const LAS f32x4*)(kn + kh * 64 + 4 * d4);
                d0 += dot4(kv, *(const LAS f32x4*)(q0 + 4 * d4)); d1 += dot4(kv, *(const LAS f32x4*)(q0 + 64 + 4 * d4));
                d2 += dot4(kv, *(const LAS f32x4*)(q0 + 128 + 4 * d4)); d3 += dot4(kv, *(const LAS f32x4*)(q0 + 192 + 4 * d4)); }
        }
        sc[(4 * kh + 0) * 128 + jj] = d0; sc[(4 * kh + 1) * 128 + jj] = d1; sc[(4 * kh + 2) * 128 + jj] = d2; sc[(4 * kh + 3) * 128 + jj] = d3;
    }
    __syncthreads();
    for (int h = 2 * wave; h < 2 * wave + 2; ++h) {
        const float a = sc[h * 128 + lane], c2 = sc[h * 128 + 64 + lane], sink = sinks[h];
        const float m = fmaxf(wave_max(fmaxf(a, c2)), sink);
        const float pa = __expf(a - m), pb = __expf(c2 - m);
        const float den = wave_sum(pa + pb) + __expf(sink - m), inv = 1.0f / den;
        sc[h * 128 + lane] = pa * inv; sc[h * 128 + 64 + lane] = pb * inv;
    }
    __syncthreads();
    {
        const int d = tid & 63, kg = wave;
#pragma unroll 1
        for (int kh = 0; kh < 4; ++kh) {
            float vv[16];
#pragma unroll
            for (int t = 0; t < 16; ++t) { const int jj = 16 * kg + t;
                vv[t] = (jj < 127) ? cache_v[((size_t)(b * 128 + jj + 1) * 4 + kh) * 64 + d] : vn[kh * 64 + d]; }
            float a0 = 0.f, a1 = 0.f, a2 = 0.f, a3 = 0.f;
            const LAS float* sp = sc + (4 * kh) * 128 + 16 * kg;
#pragma unroll
            for (int t = 0; t < 16; ++t) { a0 += sp[t] * vv[t]; a1 += sp[128 + t] * vv[t]; a2 += sp[256 + t] * vv[t]; a3 += sp[384 + t] * vv[t]; }
            LAS float* pp = part + (kg * 16 + 4 * kh) * 64 + d;
            pp[0] = a0; pp[64] = a1; pp[128] = a2; pp[192] = a3;
        }
        __syncthreads();
#pragma unroll
        for (int hi = 0; hi < 2; ++hi) {
            const int h = (tid >> 6) + 8 * hi; float o = 0.f;
#pragma unroll
            for (int k8 = 0; k8 < 8; ++k8) o += part[(k8 * 16 + h) * 64 + d];
            MIX[(size_t)(MP + b) * DM + 64 * h + d] = (bf16)f2bf(o);
        }
    }
    {
        const int ch = 2 * tid;
        const float u0 = zs[1536 + ch] * sigmoidf_(zs[2560 + ch]), u1 = zs[1536 + ch + 1] * sigmoidf_(zs[2560 + ch + 1]);
        *(f32x2*)(out + O_CS + (size_t)(b * 30 + 29) * 1024 + ch) = (f32x2){u0, u1};
        f32x2 c = *(const f32x2*)(cb + ch);
#pragma unroll 15
        for (int j = 0; j < 30; ++j) c = c + *(const f32x2*)(cw + j * 1024 + ch) * *(const f32x2*)(state + (size_t)(b * 30 + j) * 1024 + ch);
        c = c + *(const f32x2*)(cw + 30 * 1024 + ch) * (f32x2){u0, u1};
        const float s1 = wave_sum(c[0] + c[1]), s2 = wave_sum(c[0] * c[0] + c[1] * c[1]);
        if (lane == 0) { rd[wave * 2] = s1; rd[wave * 2 + 1] = s2; }
        __syncthreads();
        float t1 = 0.f, t2 = 0.f;
#pragma unroll
        for (int wv = 0; wv < 8; ++wv) { t1 += rd[wv * 2]; t2 += rd[wv * 2 + 1]; }
        const float mean = t1 * (1.0f / CCH), var = t2 * (1.0f / CCH) - mean * mean, rstd = rsqrtf(fmaxf(var, 0.f) + EPS);
        const f32x2 y = (c - mean) * rstd * *(const f32x2*)(lg + ch) + *(const f32x2*)(lb + ch);
        *(unsigned*)(MIX + (size_t)(MP + b) * DM + 1024 + ch) = pk2(y[0] * sigmoidf_(y[0]), y[1] * sigmoidf_(y[1]));
    }
    __syncthreads();
}

#ifndef MK_DUP
#define MK_DUP (-1)
#endif
#define REPS(k)
#ifndef MK_CG_SEAMS
#define MK_CG_SEAMS 0
#endif
struct Args { const float* in[18]; float* out; unsigned char* ws; int ph_lo, ph_hi, dry, pad; };
__global__ void __launch_bounds__(NWAVES * 64, 2) mk_fwd(Args args) {
    extern __shared__ __attribute__((aligned(16))) unsigned char lds_raw[];
    LAS unsigned char* lds = (LAS unsigned char*)lds_raw;
    const int tid = threadIdx.x, lane = tid & 63, wave = __builtin_amdgcn_readfirstlane(tid >> 6);
    const int G = gridDim.x, bx = blockIdx.x;
    const int vcu = (G % 8 == 0) ? (bx % 8) * (G / 8) + bx / 8 : bx;
    unsigned char* ws = args.ws;
    const float *xp = args.in[0], *xs = args.in[1], *cache_k = args.in[2], *cache_v = args.in[3], *state = args.in[4], *g_mix = args.in[5], *w_in = args.in[6],
                *gq = args.in[7], *gk = args.in[8], *sinks = args.in[9], *conv_w = args.in[10], *conv_b = args.in[11], *ln_g = args.in[12], *ln_b = args.in[13],
                *w_out = args.in[14], *g_mlp = args.in[15], *w_up = args.in[16], *w_down = args.in[17];
    float* out = args.out;
    float* SSQ = (float*)(ws + WS_SSQ); float* cosT = (float*)(ws + WS_COS); float* sinT = (float*)(ws + WS_SIN); float* ZS = (float*)(ws + WS_ZS);
    bf16 *WinT = (bf16*)(ws + WS_WIN), *WoutT = (bf16*)(ws + WS_WOUT), *WupT = (bf16*)(ws + WS_WUP), *WdnT = (bf16*)(ws + WS_WDN);
    bf16 *X1G = (bf16*)(ws + WS_X1G), *HID = (bf16*)(ws + WS_HID), *XN = (bf16*)(ws + WS_XN), *Qb = (bf16*)(ws + WS_Q), *Kb = (bf16*)(ws + WS_K), *Vb = (bf16*)(ws + WS_V),
         *Ub = (bf16*)(ws + WS_U), *MIX = (bf16*)(ws + WS_MIX);
    for (int u = tid; u < (LDS_BYTES - LDSCTL_OFF) / 4; u += NWAVES * 64) ((LAS unsigned*)(lds + LDSCTL_OFF))[u] = 0u;
    __syncthreads();
    volatile LAS unsigned* MISC = (volatile LAS unsigned*)(lds + MISC_OFF);
    XcdBarrier bar; bar.bar = (unsigned*)(ws + WS_CTL) + CW_BAR; bar.x = 0; bar.st = nullptr;
    if (MK_N_LAUNCHES == 1) bar = xcd_barrier_post((unsigned*)(ws + WS_CTL) + CW_BAR, MISC + 8);
#define GRID_BAR(seam) do { if (MK_N_LAUNCHES == 1) { if ((MK_CG_SEAMS >> (seam)) & 1) cg::this_grid().sync(); else xcd_barrier(bar); } } while (0)
    const int lo = args.ph_lo, hi = args.ph_hi;
    if (args.pad == 0x5eed) cg::this_grid().sync();
#define IN(k) (lo <= (k) && (k) < hi)

    if (IN(0)) { REPS(0) {
        LAS float* scr = (LAS float*)(lds + wave * 16384);
        const int gw = vcu * NWAVES + wave, NGW = G * NWAVES;
        { const DecP0 D{w_in, w_out, WinT, WoutT}; cvt_items(scr, gw, (DM / 64) * (INC / 32) + (DM / 64) * (DM / 32), NGW, lane, D); }
        for (int m = gw; m < MT; m += NGW) rms_row_to_bf16(m < MP ? xp + (size_t)m * DM : xs + (size_t)(m - MP) * DM, g_mix, XN + (size_t)m * DM, lane);
        const int gt = vcu * (NWAVES * 64) + tid, NT = G * NWAVES * 64;
        for (int i = gt; i < 2049 * 32; i += NT) {
            const int pos = i >> 5, k = i & 31; double inv = 1.0;
            for (int j = 0; j < k; ++j) inv *= 0.7498942093324559;
            const float ang = (pos == 2048 ? 16384.0f : (float)pos) * (float)inv;
            double rev = (double)ang * 0.15915494309189535; rev -= __builtin_rint(rev);
            const float rf = (float)rev;
            cosT[i] = __builtin_amdgcn_cosf(rf); sinT[i] = __builtin_amdgcn_sinf(rf);
        }
        for (int i = gt; i < 32 * 8128; i += NT) { const int b = i / 8128, o = i % 8128;
            ((f32x4*)(out + O_KS + (size_t)b * 32768))[o] = ((const f32x4*)(cache_k + (size_t)b * 32768 + 256))[o];
            ((f32x4*)(out + O_VS + (size_t)b * 32768))[o] = ((const f32x4*)(cache_v + (size_t)b * 32768 + 256))[o]; }
        for (int i = gt; i < 32 * 7424; i += NT) { const int b = i / 7424, o = i % 7424;
            ((f32x4*)(out + O_CS + (size_t)b * 30720))[o] = ((const f32x4*)(state + (size_t)b * 30720 + 1024))[o]; }
        }
        if (IN(1)) GRID_BAR(0);
    }
    if (IN(1)) { REPS(1) {
        pg8::Gemm g{XN, WinT, MP, INC, DM}; pg8::StaticOrder S; S.init(MP, INC, G, bx);
        Epi1 E{Qb, Kb, Vb, Ub, out, gq, gk, cosT, sinT};
        pg8::gemm_phase<Epi1, pg8::StaticOrder, true, true>(lds, g, S, E);
        EpiS1 ES{ZS};
        skinny_phase(lds, XN + (size_t)MP * DM, WinT, INC, DM, bx, G, ES);
        {
            const int nfull = ((MP / 256) * (INC / 256)) % G, nsl = nfull ? G - nfull : G;
            const bool slack = nfull ? bx >= nfull : true;
            if (slack) { const DecP1 D{w_up, w_down, WupT, WdnT}; cvt_items((LAS float*)(lds + wave * 16384), (bx - (G - nsl)) * NWAVES + wave, (DM / 64) * (FF / 32) + (FF / 64) * (DM / 32), nsl * NWAVES, lane, D); }
        }
        }
        if (IN(2)) GRID_BAR(1);
    }
    if (IN(2)) { REPS(2) {
        for (int a = bx; a < 256; a += G) attn_unit(lds, a >> 6, (a >> 2) & 15, a & 3, Qb, Kb, Vb, MIX, sinks, tid, wave, lane);
        for (int c = bx; c < 256; c += G) conv_unit(lds, c >> 6, c & 63, Ub, MIX, conv_w, conv_b, ln_g, ln_b, tid, wave, lane);
        for (int b = G - 1 - bx; b < MS; b += G) sample_mixer(lds, b, ZS, cache_k, cache_v, state, gq, gk, sinks, conv_w, conv_b, ln_g, ln_b, cosT, sinT, out, MIX, tid, wave, lane);
        }
        if (IN(3)) GRID_BAR(2);
    }
    if (IN(3)) {
        pg8::Gemm g{MIX, WoutT, MP, DM, DM}; pg8::StaticOrder S; S.init(MP, DM, G, bx);
        Epi3 E{xp, out + O_YP, X1G, g_mlp, args.dry ? SSQ + 16384 : SSQ};
        pg8::gemm_phase<Epi3, pg8::StaticOrder, true, true>(lds, g, S, E);
        EpiS3 ES{xs, out + O_YP, X1G, g_mlp, args.dry ? SSQ + 16384 : SSQ};
        skinny_phase(lds, MIX + (size_t)MP * DM, WoutT, DM, DM, G - 1 - bx, G, ES);
        if (IN(4)) GRID_BAR(3);
    }
    if (IN(4)) { REPS(4) {
        pg8::Gemm g{X1G, WupT, MP, FF, DM}; pg8::StaticOrder S; S.init(MP, FF, G, bx);
        Epi4 E{SSQ, HID};
        pg8::gemm_phase<Epi4, pg8::StaticOrder, true, true>(lds, g, S, E);
        EpiS4 ES{SSQ, HID};
        skinny_phase(lds, X1G + (size_t)MP * DM, WupT, FF, DM, G - 1 - bx, G, ES);
        }
        if (IN(5)) GRID_BAR(4);
    }
    if (IN(5)) {
        pg8::Gemm g{HID, WdnT, MP, DM, FF}; pg8::StaticOrder S; S.init(MP, DM, G, bx);
        Epi5 E{out + O_YP, args.dry ? 0.f : 1.f};
        pg8::gemm_phase<Epi5, pg8::StaticOrder, true, true>(lds, g, S, E);
        EpiS5 ES{out + O_YP, args.dry ? 0.f : 1.f};
        skinny_phase(lds, HID + (size_t)MP * FF, WdnT, DM, FF, G - 1 - bx, G, ES);
    }
#undef IN
}

extern "C" void kernel_launch(void* const* d_in, const int* in_sizes, int n_in, void* d_out, int out_size, void* d_ws, size_t ws_size, hipStream_t stream) {
    static int grid = 0;
    if (grid == 0) {
        if (n_in != 18 || (size_t)out_size != O_END || ws_size < WS_END) { fprintf(stderr, "kernel_launch: unexpected shapes: n_in %d out %d ws %zu\n", n_in, out_size, ws_size); grid = -1; return; }
        int dev = 0, cus = 0, per_cu = 0;
        if (hipGetDevice(&dev) != hipSuccess || hipDeviceGetAttribute(&cus, hipDeviceAttributeMultiprocessorCount, dev) != hipSuccess) { grid = -1; return; }
        if (hipFuncSetAttribute((const void*)mk_fwd, hipFuncAttributeMaxDynamicSharedMemorySize, LDS_BYTES) != hipSuccess) { fprintf(stderr, "kernel_launch: hipFuncSetAttribute failed\n"); grid = -1; return; }
        if (hipOccupancyMaxActiveBlocksPerMultiprocessor(&per_cu, (const void*)mk_fwd, NWAVES * 64, LDS_BYTES) != hipSuccess || per_cu < 1) { fprintf(stderr, "kernel_launch: occupancy query says %d\n", per_cu); (void)hipGetLastError(); grid = -1; return; }
        grid = cus;
    }
    if (grid < 0) return;
    (void)hipMemsetAsync((char*)d_ws + WS_CTL, 0, CTL_ZERO_BYTES, stream);
    Args a{};
    for (int i = 0; i < 18; ++i) a.in[i] = (const float*)d_in[i];
    a.out = (float*)d_out; a.ws = (unsigned char*)d_ws;
#if MK_N_LAUNCHES == 1
    a.ph_lo = 0; a.ph_hi = 6;
    void* params[] = {&a};
    hipError_t e = hipLaunchCooperativeKernel((const void*)mk_fwd, dim3(grid), dim3(NWAVES * 64), params, LDS_BYTES, stream);
    if (e != hipSuccess) fprintf(stderr, "kernel_launch: cooperative launch failed: %s (grid %d)\n", hipGetErrorString(e), grid);
#else
    for (int p = 0; p < 6; ++p) for (int rep = 0; rep < (p == MK_DUP ? 2 : 1); ++rep) { a.ph_lo = p; a.ph_hi = p + 1; a.dry = (p == MK_DUP && rep == 0 && (p == 3 || p == 5)) ? 1 : 0; hipLaunchKernelGGL(mk_fwd, dim3(grid), dim3(NWAVES * 64), LDS_BYTES, stream, a); }
#endif
}
```

```cpp
#include <hip/hip_runtime.h>
#include <hip/hip_cooperative_groups.h>
#include <cstdio>
#include <cstdint>
namespace cg = cooperative_groups;
__device__ __forceinline__ int mk_fresh_lane() { int l; asm volatile("v_mbcnt_lo_u32_b32 %0, -1, 0\n\tv_mbcnt_hi_u32_b32 %0, -1, %0" : "=v"(l)); return l; }
#define MK_PLAIN 1
#define MK_N_LAUNCHES 1
namespace pg8 {
#define PG8_LAS __attribute__((address_space(3)))
typedef unsigned short bf16_t;
typedef short bf16x8 __attribute__((ext_vector_type(8)));
typedef float f32x4 __attribute__((ext_vector_type(4)));
typedef unsigned u32x4 __attribute__((ext_vector_type(4)));
constexpr int BM = 256, BK = 64, HALF = 128, HTB = HALF * BK * 2  , STAGE_BYTES = 8 * HTB, NXCD = 8, WGM = 8;

__host__ __device__ __forceinline__ int lds_byte(int r, int c) { const int st = (r >> 4) * 2 + (c >> 5), rr = r & 15, cc = c & 31, ob = rr * 64 + cc * 2; return st * 1024 + (ob ^ (((ob >> 9) & 1) << 5)); }
__host__ __device__ __forceinline__ void stage_rc(int b, int& R, int& C) { const int st = b / 1024, sb = b % 1024, swz = sb ^ (((sb >> 9) & 1) << 5); R = (st >> 1) * 16 + swz / 64; C = (st & 1) * 32 + (swz % 64) / 2; }
__host__ __device__ __forceinline__ int perm32(int rho) { const int n = rho >> 4, i = rho & 15; return 8 * (i >> 2) + 4 * n + (i & 3); }

struct Unit { int pm, pn; };
struct Gemm { const bf16_t* A; const bf16_t* Bt; int M, N, K; };

struct StaticOrder {
    int nM, nN, nwg, G, c;
    __host__ __device__ void init(int M, int N, int G_, int c_) { nM = M / BM; nN = N / BM; nwg = nM * nN; G = G_; c = c_; }
    __host__ __device__ bool next(int i, Unit& u) const {
        const long L = (long)i * G + c; if (L >= nwg) return false;
        int wgid = (int)L; { const int q = nwg / NXCD, r = nwg % NXCD, xcd = wgid % NXCD, off = wgid / NXCD; wgid = (xcd < r ? xcd * (q + 1) : r * (q + 1) + (xcd - r) * q) + off; }
        const int nig = WGM * nN, gid = wgid / nig, fm = gid * WGM, gsz = (nM - fm) < WGM ? (nM - fm) : WGM;
        u.pm = fm + ((wgid % nig) % gsz); u.pn = (wgid % nig) / gsz; return true;
    }
    __device__ __forceinline__ void a_ready(const Unit&) const {}
    __device__ __forceinline__ void done(const Unit&) const {}
};

__device__ __forceinline__ unsigned cvt_pk_bf16(float lo, float hi) { unsigned r; asm volatile("v_cvt_pk_bf16_f32 %0, %1, %2" : "=v"(r) : "v"(lo), "v"(hi)); return r; }
typedef float f32x2 __attribute__((ext_vector_type(2)));
template <class Epi, class Sched, bool ALIGN_EPI = false, bool SP2 = false>
__device__ __forceinline__ void gemm_phase(PG8_LAS unsigned char* lds, const Gemm g, const Sched& S, const Epi& E, const int wid_in) {
    const int wid = wid_in; int tid = wid * 64 + mk_fresh_lane(); asm volatile("" : "+v"(tid));
    const int lane = tid & 63, wr = wid >> 2, wc = wid & 3, fr = lane & 15, fq = lane >> 4;
    const int K = g.K, nt = K / BK;
    unsigned voffA[2], voffB[2];
#pragma unroll
    for (int i = 0; i < 2; ++i) { int R, C; stage_rc(tid * 16 + i * 8192, R, C); const int Rb = Epi::PERM ? ((R & ~31) + perm32(R & 31)) : R;
        voffA[i] = (unsigned)(R * K + C) * 2u; voffB[i] = (unsigned)(Rb * K + C) * 2u; }
    const size_t kstep = (size_t)(BK * 2);
    const size_t hstep = (size_t)HALF * K * 2;
    const size_t tstep = 2 * hstep;
    const unsigned ldsw = (unsigned)wid * 1024u;
    const int aoff = lds_byte(wr * 64 + fr, fq * 8), boff = lds_byte(wc * 32 + fr, fq * 8);
#define PG8_SA(b, h) (((b) * 2 + (h)) * HTB)
#define PG8_SB(b, h) ((4 + (b) * 2 + (h)) * HTB)
#define PG8_STAGE(bufoff, gbase, voff) do { _Pragma("unroll") for (int _i = 0; _i < 2; ++_i) \
        __builtin_amdgcn_global_load_lds((const unsigned*)((const char*)(gbase) + (voff)[_i]), (PG8_LAS unsigned*)(lds + (bufoff) + ldsw + _i * 8192), 16, 0, 0); } while (0)
#define PG8_LDA(dst, b, h) do { _Pragma("unroll") for (int m = 0; m < 4; ++m) _Pragma("unroll") for (int k = 0; k < 2; ++k) dst[m][k] = *(const PG8_LAS bf16x8*)(lds + PG8_SA(b, h) + aoff + m * 2048 + k * 1024); } while (0)
#define PG8_LDB(dst, b, h) do { _Pragma("unroll") for (int n = 0; n < 2; ++n) _Pragma("unroll") for (int k = 0; k < 2; ++k) dst[n][k] = *(const PG8_LAS bf16x8*)(lds + PG8_SB(b, h) + boff + n * 2048 + k * 1024); } while (0)
#define PG8_MMA(ai, bj, At, Bt) do { __builtin_amdgcn_s_setprio(1); _Pragma("unroll") for (int m = 0; m < 4; ++m) _Pragma("unroll") for (int n = 0; n < 2; ++n) _Pragma("unroll") for (int k = 0; k < 2; ++k) \
        acc[ai][bj][m][n] = __builtin_amdgcn_mfma_f32_16x16x32_bf16(Bt[n][k], At[m][k], acc[ai][bj][m][n], 0, 0, 0); __builtin_amdgcn_s_setprio(0); } while (0)
#define PG8_WAIT_V(n) asm volatile("s_waitcnt vmcnt(" #n ")" ::: "memory")
#define PG8_WAIT_L(n) asm volatile("s_waitcnt lgkmcnt(" #n ")" ::: "memory")
#define PG8_BAR __builtin_amdgcn_s_barrier()
#define PG8_SCHED __builtin_amdgcn_sched_barrier(0)
    Unit cur, nxt; int ui = 0;
    if (!S.next(0, cur)) return;
    f32x4 acc[2][2][4][2];
#pragma unroll
    for (int a = 0; a < 2; ++a)
#pragma unroll
        for (int b = 0; b < 2; ++b)
#pragma unroll
            for (int m = 0; m < 4; ++m)
#pragma unroll
                for (int n = 0; n < 2; ++n) acc[a][b][m][n] = (f32x4){0.f, 0.f, 0.f, 0.f};
    bf16x8 At[4][2], B0[2][2], B1[2][2];
    const char* cA = (const char*)g.A + (size_t)cur.pm * tstep; const char* cB = (const char*)g.Bt + (size_t)cur.pn * tstep;
    S.a_ready(cur);
    if constexpr (SP2) {
        PG8_STAGE(PG8_SB(0, 0), cB, voffB); PG8_STAGE(PG8_SB(0, 1), cB + hstep, voffB); PG8_STAGE(PG8_SA(0, 0), cA, voffA); PG8_STAGE(PG8_SA(0, 1), cA + hstep, voffA);
        if (wr == 1) PG8_BAR;
        PG8_WAIT_V(2); PG8_BAR;
        PG8_STAGE(PG8_SB(1, 0), cB + kstep, voffB); PG8_STAGE(PG8_SA(1, 0), cA + kstep, voffA); PG8_STAGE(PG8_SB(1, 1), cB + hstep + kstep, voffB);
        PG8_WAIT_V(6); PG8_BAR;
    } else {
        PG8_STAGE(PG8_SB(0, 0), cB, voffB); PG8_STAGE(PG8_SA(0, 0), cA, voffA); PG8_STAGE(PG8_SB(0, 1), cB + hstep, voffB); PG8_STAGE(PG8_SA(0, 1), cA + hstep, voffA);
        if (wr == 1) PG8_BAR;
        PG8_WAIT_V(4); PG8_BAR;
        PG8_STAGE(PG8_SB(1, 0), cB + kstep, voffB); PG8_STAGE(PG8_SA(1, 0), cA + kstep, voffA); PG8_STAGE(PG8_SB(1, 1), cB + hstep + kstep, voffB);
        PG8_WAIT_V(6); PG8_BAR;
    }
    for (;;) {
        const bool has_next = S.next(ui + 1, nxt);
        const char* nA = has_next ? (const char*)g.A + (size_t)nxt.pm * tstep : cA; const char* nB = has_next ? (const char*)g.Bt + (size_t)nxt.pn * tstep : cB;
        for (int t = 0; t < nt; t += 2) {
            const bool last = (t == nt - 2);
            const char* a1 = cA + (size_t)(t + 1) * kstep;
            const char* a2 = last ? nA : cA + (size_t)(t + 2) * kstep; const char* b2 = last ? nB : cB + (size_t)(t + 2) * kstep;
            const char* a3 = a2 + kstep; const char* b3 = b2 + kstep;
            if (last && has_next) S.a_ready(nxt);
            if constexpr (SP2) {
            PG8_LDB(B0, 0, 0); PG8_LDB(B1, 0, 1); PG8_SCHED; PG8_LDA(At, 0, 0); PG8_STAGE(PG8_SA(1, 1), a1 + hstep, voffA);
            PG8_WAIT_V(8); PG8_WAIT_L(0); PG8_BAR; PG8_MMA(0, 0, At, B0); PG8_MMA(0, 1, At, B1); PG8_BAR; PG8_SCHED;
            PG8_LDA(At, 0, 1); PG8_STAGE(PG8_SB(0, 0), b2, voffB); PG8_STAGE(PG8_SB(0, 1), b2 + hstep, voffB); PG8_STAGE(PG8_SA(0, 0), a2, voffA);
            PG8_WAIT_V(8); PG8_WAIT_L(0); PG8_BAR; PG8_MMA(1, 0, At, B0); PG8_MMA(1, 1, At, B1); PG8_BAR; PG8_SCHED;
            PG8_LDB(B0, 1, 0); PG8_LDB(B1, 1, 1); PG8_SCHED; PG8_LDA(At, 1, 0); PG8_STAGE(PG8_SA(0, 1), a2 + hstep, voffA);
            PG8_WAIT_V(8); PG8_WAIT_L(0); PG8_BAR; PG8_MMA(0, 0, At, B0); PG8_MMA(0, 1, At, B1); PG8_BAR; PG8_SCHED;
            PG8_LDA(At, 1, 1); PG8_STAGE(PG8_SB(1, 0), b3, voffB); PG8_STAGE(PG8_SB(1, 1), b3 + hstep, voffB); PG8_STAGE(PG8_SA(1, 0), a3, voffA);
            PG8_WAIT_V(8); PG8_WAIT_L(0); PG8_BAR; PG8_MMA(1, 0, At, B0); PG8_MMA(1, 1, At, B1); PG8_BAR; PG8_SCHED;
            } else {
            PG8_LDB(B0, 0, 0); PG8_SCHED; PG8_LDA(At, 0, 0); PG8_STAGE(PG8_SA(1, 1), a1 + hstep, voffA);
            PG8_WAIT_L(8); PG8_BAR; PG8_WAIT_L(0); PG8_MMA(0, 0, At, B0); PG8_BAR; PG8_SCHED;
            PG8_LDB(B1, 0, 1); PG8_STAGE(PG8_SB(0, 0), b2, voffB);
            PG8_BAR; PG8_WAIT_L(0); PG8_MMA(0, 1, At, B1); PG8_BAR;
            PG8_LDA(At, 0, 1); PG8_STAGE(PG8_SA(0, 0), a2, voffA);
            PG8_BAR; PG8_WAIT_L(0); PG8_MMA(1, 0, At, B0); PG8_BAR; PG8_SCHED;
            PG8_STAGE(PG8_SB(0, 1), b2 + hstep, voffB);
            PG8_WAIT_V(6); PG8_BAR; PG8_MMA(1, 1, At, B1); PG8_BAR;
            PG8_LDB(B0, 1, 0); PG8_SCHED; PG8_LDA(At, 1, 0); PG8_STAGE(PG8_SA(0, 1), a2 + hstep, voffA);
            PG8_WAIT_L(8); PG8_BAR; PG8_WAIT_L(0); PG8_MMA(0, 0, At, B0); PG8_BAR; PG8_SCHED;
            PG8_LDB(B1, 1, 1); PG8_STAGE(PG8_SB(1, 0), b3, voffB);
            PG8_BAR; PG8_WAIT_L(0); PG8_MMA(0, 1, At, B1); PG8_BAR;
            PG8_LDA(At, 1, 1); PG8_STAGE(PG8_SA(1, 0), a3, voffA);
            PG8_BAR; PG8_WAIT_L(0); PG8_MMA(1, 0, At, B0); PG8_BAR; PG8_SCHED;
            PG8_STAGE(PG8_SB(1, 1), b3 + hstep, voffB);
            PG8_WAIT_V(6); PG8_BAR; PG8_MMA(1, 1, At, B1); PG8_BAR;
            }
        }
        if constexpr (ALIGN_EPI) { if (wr == 0) PG8_BAR; }
        if constexpr (!Epi::AFTER_DRAIN) { E(acc, cur, wr, wc, fr, fq); S.done(cur); }
        if (!has_next) break;
#pragma unroll
        for (int a = 0; a < 2; ++a)
#pragma unroll
            for (int b = 0; b < 2; ++b)
#pragma unroll
                for (int m = 0; m < 4; ++m)
#pragma unroll
                    for (int n = 0; n < 2; ++n) acc[a][b][m][n] = (f32x4){0.f, 0.f, 0.f, 0.f};
        cur = nxt; cA = nA; cB = nB; ++ui;
        if constexpr (ALIGN_EPI) { if (wr == 1) PG8_BAR; }
    }
    PG8_WAIT_V(0);
    if constexpr (!ALIGN_EPI) { if (wr == 0) PG8_BAR; }
    PG8_BAR;
    if constexpr (Epi::AFTER_DRAIN) { E.fused(acc, cur, wr, wc, fr, fq, lds, wid, lane); S.done(cur); }
#undef PG8_SA
#undef PG8_SB
#undef PG8_STAGE
#undef PG8_LDA
#undef PG8_LDB
#undef PG8_MMA
#undef PG8_WAIT_V
#undef PG8_WAIT_L
#undef PG8_BAR
#undef PG8_SCHED
}
}
#define GAS __attribute__((address_space(1)))
#define LAS __attribute__((address_space(3)))
#define XB_TMO      128
#define XB_XCNT(j)  (256  + 64 * (j))
#define XB_XSUB(j)  (1280 + 64 * (j))
#define XB_XGEN(j)  (2304 + 64 * (j))
#define XB_TOP      3328
#define XB_TOPGEN   3392
#define XCD_BAR_WORDS 3456
#define XB_SPIN_CAP (1u << 18)

__device__ __forceinline__ unsigned xb_ld(unsigned* p)              { return __hip_atomic_load(p, __ATOMIC_RELAXED, __HIP_MEMORY_SCOPE_AGENT); }
__device__ __forceinline__ unsigned xb_add(unsigned* p, unsigned v) { return __hip_atomic_fetch_add(p, v, __ATOMIC_RELAXED, __HIP_MEMORY_SCOPE_AGENT); }
__device__ __forceinline__ unsigned xb_xcc_id() { return (unsigned)__builtin_amdgcn_s_getreg((3 << 11) | 20) & 0xFu; }
#define XB_SPIN(cond, bar) do { unsigned _sp = 0; while (cond) { __builtin_amdgcn_s_sleep(1); \
    if ((++_sp & 255u) == 0u) { if (xb_ld(&(bar)[XB_TMO])) break; if (_sp > XB_SPIN_CAP) { atomicAdd(&(bar)[XB_TMO], 1u); break; } } } } while (0)

struct XcdBarrier {
    unsigned* bar; unsigned x;
    volatile LAS unsigned* st;
};

__device__ __forceinline__ XcdBarrier xcd_barrier_post(unsigned* bar, volatile LAS unsigned* st) {
    XcdBarrier b; b.bar = bar; b.x = xb_xcc_id(); b.st = st;
    if (threadIdx.x == 0) (void)xb_add(&bar[XB_XCNT(b.x)], 1u);
    return b;
}
__device__ __forceinline__ void xcd_barrier_complete(unsigned* bar, unsigned x, unsigned& nloc, unsigned& nx) {
    const unsigned G = gridDim.x * gridDim.y * gridDim.z;
    unsigned sum, cnt, mine, sp = 0u;
    for (;;) {
        sum = 0u; cnt = 0u; mine = 0u;
#pragma unroll
        for (unsigned j = 0; j < 16; ++j) { const unsigned c = xb_ld(&bar[XB_XCNT(j)]); sum += c; cnt += (c > 0u) ? 1u : 0u; mine = (j == x) ? c : mine; }
        if (sum == G) break;
        __builtin_amdgcn_s_sleep(1);
        if ((++sp & 255u) == 0u) { if (xb_ld(&bar[XB_TMO])) break; if (sp > XB_SPIN_CAP) { atomicAdd(&bar[XB_TMO], 1u); break; } }
    }
    nloc = mine > 0u ? mine : 1u; nx = cnt > 0u ? cnt : 1u;
}

__device__ __forceinline__ void xcd_barrier(const XcdBarrier& b) {
    asm volatile("s_waitcnt vmcnt(0)" ::: "memory");
    __syncthreads();
    if (threadIdx.x == 0) {
        unsigned* bar = b.bar;
        __builtin_amdgcn_s_waitcnt(0);
        unsigned nloc = b.st[0], nx = b.st[1];
        if (nloc == 0u) { xcd_barrier_complete(bar, b.x, nloc, nx); b.st[0] = nloc; b.st[1] = nx; }
        const unsigned old = xb_add(&bar[XB_XSUB(b.x)], 1u);
        const unsigned gen = old / nloc;
        if (old + 1u == (gen + 1u) * nloc) {
            __builtin_amdgcn_fence(__ATOMIC_RELEASE, "agent");
            asm volatile("s_waitcnt vmcnt(0)" ::: "memory");
            const unsigned og = xb_add(&bar[XB_TOP], 1u);
            const unsigned tg = og / nx;
            if (og + 1u == (tg + 1u) * nx) xb_add(&bar[XB_TOPGEN], 1u);
            else XB_SPIN(xb_ld(&bar[XB_TOPGEN]) == tg, bar);
            __builtin_amdgcn_fence(__ATOMIC_ACQUIRE, "agent");
            xb_add(&bar[XB_XGEN(b.x)], 1u);
            asm volatile("s_waitcnt vmcnt(0)" ::: "memory");
        } else {
            XB_SPIN(xb_ld(&bar[XB_XGEN(b.x)]) == gen, bar);
            __builtin_amdgcn_fence(__ATOMIC_ACQUIRE, "agent");
            asm volatile("s_waitcnt vmcnt(0)" ::: "memory");
        }
    }
    __syncthreads();
}

#ifndef MK_N_LAUNCHES
#define MK_N_LAUNCHES 1
#endif
constexpr int NWAVES = 8;
constexpr int DM = 2048, SEQ = 2048, NBATCH = 4, MP = NBATCH * SEQ, MS = 32, MT = MP + MS;
constexpr int INC = 3584, FF = 8192, NH = 16, NKV = 4, HD = 64, CCH = 1024, CW = 31;
constexpr float EPS = 1e-6f;
constexpr size_t O_YP = 0, O_YS = (size_t)MP * DM, O_KP = O_YS + (size_t)MS * DM, O_VP = O_KP + 131072, O_CP = O_VP + 131072,
                 O_KS = O_CP + 122880, O_VS = O_KS + 1048576, O_CS = O_VS + 1048576, O_END = O_CS + 983040;
constexpr size_t MiB = 1u << 20;
constexpr size_t WS_CTL = 0, CTL_ZERO_BYTES = 68 * 1024;
constexpr size_t WS_SSQ = 32 * 1024, WS_SSQ0 = 96 * 1024;
constexpr size_t WS_COS = 1 * MiB, WS_SIN = 2 * MiB;
constexpr size_t WS_ZS = 3 * MiB;
constexpr size_t WS_WIN = 4 * MiB, WS_WOUT = 18 * MiB, WS_WUP = 26 * MiB, WS_WDN = 58 * MiB;
constexpr size_t WS_X1G = 90 * MiB;
constexpr size_t WS_HID = 123 * MiB;
constexpr size_t WS_XN = 123 * MiB, WS_Q = 156 * MiB, WS_K = 172 * MiB, WS_V = 176 * MiB, WS_U = 180 * MiB, WS_MIX = 196 * MiB;
constexpr size_t WS_END = 256 * MiB;
static_assert(WS_HID + (size_t)MT * FF * 2 <= WS_END && WS_MIX + (size_t)MT * DM * 2 <= WS_END && WS_X1G + (size_t)MT * DM * 2 <= WS_HID, "ws map");
constexpr int CW_BAR = 4096;
constexpr int RING_BYTES = 131072, LDSCTL_OFF = RING_BYTES, MISC_OFF = LDSCTL_OFF + 320, LDS_BYTES = 147456;

typedef unsigned short bf16;
typedef unsigned v4u __attribute__((ext_vector_type(4)));
typedef unsigned v2u __attribute__((ext_vector_type(2)));
typedef float f32x4 __attribute__((ext_vector_type(4)));
typedef float f32x2 __attribute__((ext_vector_type(2)));
typedef short bf16x8 __attribute__((ext_vector_type(8)));
#define LDS_WAIT() asm volatile("s_waitcnt lgkmcnt(0)" ::: "memory")
__device__ __forceinline__ unsigned f2bf(float f) { unsigned u = __builtin_bit_cast(unsigned, f); return (u + 0x7fffu + ((u >> 16) & 1u)) >> 16; }
__device__ __forceinline__ unsigned pk2(float lo, float hi) { return pg8::cvt_pk_bf16(lo, hi); }
__device__ __forceinline__ float bf2f(unsigned h) { return __builtin_bit_cast(float, h << 16); }
template <int CTRL, int ROWMASK> __device__ __forceinline__ float dpp_get(float v) {
    return __builtin_bit_cast(float, __builtin_amdgcn_update_dpp(0, __builtin_bit_cast(int, v), CTRL, ROWMASK, 0xf, false)); }
__device__ __forceinline__ float wave_sum(float v) {
    v += dpp_get<0xB1, 0xf>(v); v += dpp_get<0x4E, 0xf>(v); v += dpp_get<0x124, 0xf>(v); v += dpp_get<0x128, 0xf>(v);
    v += dpp_get<0x142, 0xa>(v); v += dpp_get<0x143, 0xc>(v);
    return __builtin_bit_cast(float, __builtin_amdgcn_readlane(__builtin_bit_cast(int, v), 63));
}
__device__ __forceinline__ float wave_max(float v) {
    v = fmaxf(v, dpp_get<0xB1, 0xf>(v)); v = fmaxf(v, dpp_get<0x4E, 0xf>(v)); v = fmaxf(v, dpp_get<0x124, 0xf>(v)); v = fmaxf(v, dpp_get<0x128, 0xf>(v));
    const int iv = __builtin_bit_cast(int, v);
    const float a = __builtin_bit_cast(float, __builtin_amdgcn_readlane(iv, 0)), b = __builtin_bit_cast(float, __builtin_amdgcn_readlane(iv, 16)),
                c = __builtin_bit_cast(float, __builtin_amdgcn_readlane(iv, 32)), d = __builtin_bit_cast(float, __builtin_amdgcn_readlane(iv, 48));
    return fmaxf(fmaxf(a, b), fmaxf(c, d));
}
__device__ __forceinline__ float dot4(f32x4 a, f32x4 b) { return (a[0] * b[0] + a[1] * b[1]) + (a[2] * b[2] + a[3] * b[3]); }
__device__ __forceinline__ float sigmoidf_(float g) { return 1.0f / (1.0f + __expf(-g)); }

__device__ __forceinline__ int win_dst_group(int sg) {
    if (sg < 48) { const int pn = sg >> 3, wc = (sg & 7) >> 1, bj = sg & 1; return 8 * pn + 4 * bj + wc; }
    if (sg < 80) { const int cc = sg - 48; return 8 * (6 + (cc >> 2)) + (cc & 3); }
    const int cc = sg - 80; return 8 * (6 + (cc >> 2)) + 4 + (cc & 3);
}
__device__ __forceinline__ int win_logical_col(int np) {
    const int dg = np >> 5, e = np & 31, pn = dg >> 3, bj = (dg >> 2) & 1, wc = dg & 3;
    if (dg < 48) return 256 * pn + 64 * wc + 32 * bj + e;
    return (bj ? 2560 : 1536) + 128 * (pn - 6) + 32 * wc + e;
}

using pg8::Unit;
struct Epi1 {
    static constexpr bool PERM = true, AFTER_DRAIN = false;
    bf16 *Q, *K, *V, *U; float* out; const float *gq, *gk, *cosT, *sinT, *SSQ0;
    __device__ __forceinline__ void operator()(const f32x4 (&acc)[2][2][4][2], const Unit& u, int wr, int wc, int fr, int fq) const {
        const int pn = u.pn, rbase = u.pm * 256 + wr * 64 + fr;
        if (pn < 5) {
            const float* g = pn < 4 ? gq : gk; const float qs = pn < 4 ? 0.125f : 1.0f;
            const f32x4 g1a = *(const f32x4*)(g + 8 * fq), g1b = *(const f32x4*)(g + 8 * fq + 4), g2a = *(const f32x4*)(g + 32 + 8 * fq), g2b = *(const f32x4*)(g + 36 + 8 * fq);
#pragma unroll
            for (int ah = 0; ah < 4; ++ah) {
                const int ai = ah >> 1;
                f32x4 rc[4][2], rs[4][2]; float r0[4];
#pragma unroll
                for (int m = 2 * (ah & 1); m < 2 * (ah & 1) + 2; ++m) { const int s = (rbase + ai * 128 + m * 16) & (SEQ - 1);
                    r0[m] = SSQ0[rbase + ai * 128 + m * 16];
                    rc[m][0] = *(const f32x4*)(cosT + s * 32 + 8 * fq); rc[m][1] = *(const f32x4*)(cosT + s * 32 + 8 * fq + 4);
                    rs[m][0] = *(const f32x4*)(sinT + s * 32 + 8 * fq); rs[m][1] = *(const f32x4*)(sinT + s * 32 + 8 * fq + 4); }
                asm volatile("" ::: "memory");
#pragma unroll
                for (int m = 2 * (ah & 1); m < 2 * (ah & 1) + 2; ++m) {
                    const int r = rbase + ai * 128 + m * 16, s = r & (SEQ - 1), b = r >> 11;
                    const float rr = rsqrtf(r0[m] * (1.0f / DM) + EPS);
                    const f32x4 x1a = acc[ai][0][m][0] * rr, x1b = acc[ai][0][m][1] * rr, x2a = acc[ai][1][m][0] * rr, x2b = acc[ai][1][m][1] * rr;
                    float ss = (dot4(x1a, x1a) + dot4(x1b, x1b)) + (dot4(x2a, x2a) + dot4(x2b, x2b));
                    ss += __shfl_xor(ss, 16); ss += __shfl_xor(ss, 32);
                    const float rstd = rsqrtf(ss * (1.0f / 64.0f) + EPS);
                    const f32x4 y1a = x1a * rstd * g1a, y1b = x1b * rstd * g1b, y2a = x2a * rstd * g2a, y2b = x2b * rstd * g2b;
                    const f32x4 ca = rc[m][0], cb = rc[m][1], sa = rs[m][0], sb = rs[m][1];
                    const f32x4 o1a = y1a * ca - y2a * sa, o1b = y1b * cb - y2b * sb, o2a = y2a * ca + y1a * sa, o2b = y2b * cb + y1b * sb;
                    v4u w1, w2;
                    w1.x = pk2(o1a[0] * qs, o1a[1] * qs); w1.y = pk2(o1a[2] * qs, o1a[3] * qs); w1.z = pk2(o1b[0] * qs, o1b[1] * qs); w1.w = pk2(o1b[2] * qs, o1b[3] * qs);
                    w2.x = pk2(o2a[0] * qs, o2a[1] * qs); w2.y = pk2(o2a[2] * qs, o2a[3] * qs); w2.z = pk2(o2b[0] * qs, o2b[1] * qs); w2.w = pk2(o2b[2] * qs, o2b[3] * qs);
                    if (pn < 4) {
                        bf16* p = Q + (size_t)r * 1024 + 64 * (4 * pn + wc) + 8 * fq;
                        *(v4u*)p = w1; *(v4u*)(p + 32) = w2;
                    } else {
                        bf16* p = K + (size_t)r * 256 + 64 * wc + 8 * fq;
                        *(v4u*)p = w1; *(v4u*)(p + 32) = w2;
                        if (s >= SEQ - 128) {
                            float* o = out + O_KP + ((size_t)(b * 128 + s - (SEQ - 128)) * 4 + wc) * 64 + 8 * fq;
                            *(f32x4*)o = o1a; *(f32x4*)(o + 4) = o1b; *(f32x4*)(o + 32) = o2a; *(f32x4*)(o + 36) = o2b;
                        }
                    }
                }
                asm volatile("" ::: "memory");
            }
        } else if (pn == 5) {
#pragma unroll
            for (int ai = 0; ai < 2; ++ai) {
                float r0[4];
#pragma unroll
                for (int m = 0; m < 4; ++m) r0[m] = SSQ0[rbase + ai * 128 + m * 16];
                asm volatile("" ::: "memory");
#pragma unroll
                for (int m = 0; m < 4; ++m) {
                    const int r = rbase + ai * 128 + m * 16, s = r & (SEQ - 1), b = r >> 11; const float rr = rsqrtf(r0[m] * (1.0f / DM) + EPS);
#pragma unroll
                    for (int bj = 0; bj < 2; ++bj) {
                        const f32x4 v0 = acc[ai][bj][m][0] * rr, v1 = acc[ai][bj][m][1] * rr;
                        v4u w; w.x = pk2(v0[0], v0[1]); w.y = pk2(v0[2], v0[3]); w.z = pk2(v1[0], v1[1]); w.w = pk2(v1[2], v1[3]);
                        *(v4u*)(V + (size_t)r * 256 + 64 * wc + 32 * bj + 8 * fq) = w;
                        if (s >= SEQ - 128) {
                            float* o = out + O_VP + ((size_t)(b * 128 + s - (SEQ - 128)) * 4 + wc) * 64 + 32 * bj + 8 * fq;
                            *(f32x4*)o = v0; *(f32x4*)(o + 4) = v1;
                        }
                    }
                }
            }
        } else {
            const int ch = 128 * (pn - 6) + 32 * wc + 8 * fq;
#pragma unroll
            for (int ai = 0; ai < 2; ++ai) {
                float r0[4];
#pragma unroll
                for (int m = 0; m < 4; ++m) r0[m] = SSQ0[rbase + ai * 128 + m * 16];
                asm volatile("" ::: "memory");
#pragma unroll
                for (int m = 0; m < 4; ++m) {
                    const int r = rbase + ai * 128 + m * 16, s = r & (SEQ - 1), b = r >> 11;
                    const float rr = rsqrtf(r0[m] * (1.0f / DM) + EPS);
                    const f32x4 a0 = acc[ai][0][m][0] * rr, a1 = acc[ai][0][m][1] * rr, g0 = acc[ai][1][m][0] * rr, g1 = acc[ai][1][m][1] * rr;
                    f32x4 u0, u1;
#pragma unroll
                    for (int j = 0; j < 4; ++j) { u0[j] = a0[j] * sigmoidf_(g0[j]); u1[j] = a1[j] * sigmoidf_(g1[j]); }
                    v4u w; w.x = pk2(u0[0], u0[1]); w.y = pk2(u0[2], u0[3]); w.z = pk2(u1[0], u1[1]); w.w = pk2(u1[2], u1[3]);
                    *(v4u*)(U + (size_t)r * 1024 + ch) = w;
                    if (s >= SEQ - 30) {
                        float* o = out + O_CP + (size_t)(b * 30 + s - (SEQ - 30)) * 1024 + ch;
                        *(f32x4*)o = u0; *(f32x4*)(o + 4) = u1;
                    }
                }
            }
        }
    }
};
struct Epi3 {
    static constexpr bool PERM = true, AFTER_DRAIN = false;
    const bf16* XB; float* Y; bf16* X1G; const float* gm; float* SSQ;
    __device__ __forceinline__ void operator()(const f32x4 (&acc)[2][2][4][2], const Unit& u, int wr, int wc, int fr, int fq) const {
        const int rbase = u.pm * 256 + wr * 64 + fr, col0 = u.pn * 256 + wc * 32 + 8 * fq;
#pragma unroll
        for (int ai = 0; ai < 2; ++ai) {
            f32x4 pre[4][2][2];
#pragma unroll
            for (int m = 0; m < 4; ++m)
#pragma unroll
                for (int bj = 0; bj < 2; ++bj) { const v4u q = *(const v4u*)(XB + (size_t)(rbase + ai * 128 + m * 16) * DM + col0 + bj * 128);
                    pre[m][bj][0] = (f32x4){bf2f(q.x & 0xffffu), bf2f(q.x >> 16), bf2f(q.y & 0xffffu), bf2f(q.y >> 16)};
                    pre[m][bj][1] = (f32x4){bf2f(q.z & 0xffffu), bf2f(q.z >> 16), bf2f(q.w & 0xffffu), bf2f(q.w >> 16)}; }
            asm volatile("" ::: "memory");
#pragma unroll
            for (int m = 0; m < 4; ++m) {
                const int r = rbase + ai * 128 + m * 16; float ss = 0.f;
#pragma unroll
                for (int bj = 0; bj < 2; ++bj) {
                    const size_t off = (size_t)r * DM + col0 + bj * 128;
                    const f32x4 v0 = acc[ai][bj][m][0] + pre[m][bj][0], v1 = acc[ai][bj][m][1] + pre[m][bj][1];
                    ss += dot4(v0, v0) + dot4(v1, v1);
                    v4u w; w.x = pk2(v0[0], v0[1]); w.y = pk2(v0[2], v0[3]); w.z = pk2(v1[0], v1[1]); w.w = pk2(v1[2], v1[3]);
                    *(v4u*)(X1G + off) = w;
                }
                ss += __shfl_xor(ss, 16); ss += __shfl_xor(ss, 32);
                if (fq == 0) atomicAdd(SSQ + r, ss);
            }
            asm volatile("" ::: "memory");
        }
    }
};
struct Epi4 {
    static constexpr bool PERM = true, AFTER_DRAIN = false;
    const float* SSQ; bf16* H;
    __device__ __forceinline__ void operator()(const f32x4 (&acc)[2][2][4][2], const Unit& u, int wr, int wc, int fr, int fq) const {
        const int rbase = u.pm * 256 + wr * 64 + fr, col0 = u.pn * 256 + wc * 32 + 8 * fq;
        float sq[2][4];
#pragma unroll
        for (int ai = 0; ai < 2; ++ai)
#pragma unroll
            for (int m = 0; m < 4; ++m) sq[ai][m] = SSQ[rbase + ai * 128 + m * 16];
        asm volatile("" ::: "memory");
#pragma unroll
        for (int ai = 0; ai < 2; ++ai)
#pragma unroll
            for (int m = 0; m < 4; ++m) {
                const int r = rbase + ai * 128 + m * 16;
                const float rstd = rsqrtf(sq[ai][m] * (1.0f / DM) + EPS);
#pragma unroll
                for (int bj = 0; bj < 2; ++bj) {
                    f32x4 v0 = acc[ai][bj][m][0] * rstd, v1 = acc[ai][bj][m][1] * rstd;
#pragma unroll
                    for (int j = 0; j < 4; ++j) { v0[j] = fmaxf(v0[j], 0.f); v0[j] *= v0[j]; v1[j] = fmaxf(v1[j], 0.f); v1[j] *= v1[j]; }
                    v4u w; w.x = pk2(v0[0], v0[1]); w.y = pk2(v0[2], v0[3]); w.z = pk2(v1[0], v1[1]); w.w = pk2(v1[2], v1[3]);
                    *(v4u*)(H + (size_t)r * FF + col0 + bj * 128) = w;
                }
            }
    }
};
struct Epi5 {
    static constexpr bool PERM = true, AFTER_DRAIN = false;
    float* Y; const bf16* X1G;
    __device__ __forceinline__ void operator()(const f32x4 (&acc)[2][2][4][2], const Unit& u, int wr, int wc, int fr, int fq) const {
        const int rbase = u.pm * 256 + wr * 64 + fr, col0 = u.pn * 256 + wc * 32 + 8 * fq;
        v4u pre[2][4][2];
#pragma unroll
        for (int ai = 0; ai < 2; ++ai)
#pragma unroll
            for (int m = 0; m < 4; ++m)
#pragma unroll
                for (int bj = 0; bj < 2; ++bj) pre[ai][m][bj] = *(const v4u*)(X1G + (size_t)(rbase + ai * 128 + m * 16) * DM + col0 + bj * 128);
        asm volatile("" ::: "memory");
#pragma unroll
        for (int ai = 0; ai < 2; ++ai)
#pragma unroll
            for (int m = 0; m < 4; ++m)
#pragma unroll
                for (int bj = 0; bj < 2; ++bj) { float* p = Y + (size_t)(rbase + ai * 128 + m * 16) * DM + col0 + bj * 128; const v4u q = pre[ai][m][bj];
                    const f32x4 r0 = {bf2f(q.x & 0xffffu), bf2f(q.x >> 16), bf2f(q.y & 0xffffu), bf2f(q.y >> 16)}, r1 = {bf2f(q.z & 0xffffu), bf2f(q.z >> 16), bf2f(q.w & 0xffffu), bf2f(q.w >> 16)};
                    *(f32x4*)p = acc[ai][bj][m][0] + r0; *(f32x4*)(p + 4) = acc[ai][bj][m][1] + r1; }
    }
};

template <class EpiS>
__device__ __forceinline__ void skinny_phase(LAS unsigned char* lds, const bf16* As, const bf16* Bt, int N, int K, int start, int stride, const EpiS& E, const int wid_in) {
    const int wave = wid_in; int tid = wave * 64 + mk_fresh_lane(); asm volatile("" : "+v"(tid));
    const int lane = tid & 63, fr = lane & 15, fq = lane >> 4;
    LAS float* red = (LAS float*)lds;
    const int kw = K >> 3, kb = wave * kw;
    for (int unit = start; unit < (N >> 4); unit += stride) {
        f32x4 a0 = {0.f, 0.f, 0.f, 0.f}, a1 = {0.f, 0.f, 0.f, 0.f};
        const bf16* bp = Bt + (size_t)(16 * unit + fr) * K + kb + 8 * fq;
        const bf16* ap0 = As + (size_t)fr * K + kb + 8 * fq;
        const bf16* ap1 = ap0 + (size_t)16 * K;
#pragma unroll 8
        for (int k = 0; k < kw; k += 32) {
            const bf16x8 b = *(const bf16x8*)(bp + k), x0 = *(const bf16x8*)(ap0 + k), x1 = *(const bf16x8*)(ap1 + k);
            a0 = __builtin_amdgcn_mfma_f32_16x16x32_bf16(b, x0, a0, 0, 0, 0);
            a1 = __builtin_amdgcn_mfma_f32_16x16x32_bf16(b, x1, a1, 0, 0, 0);
        }
        *(LAS f32x4*)(red + (wave * 2 + 0) * 256 + lane * 4) = a0;
        *(LAS f32x4*)(red + (wave * 2 + 1) * 256 + lane * 4) = a1;
        __syncthreads();
        const int row = tid >> 4, cj = tid & 15, idx = (row >> 4) * 256 + ((row & 15) + 16 * (cj >> 2)) * 4 + (cj & 3);
        float s = 0.f;
#pragma unroll
        for (int w = 0; w < 8; ++w) s += red[w * 512 + idx];
        E(row, 16 * unit + cj, s);
        __syncthreads();
    }
}
struct EpiS1 { float* ZS; const float* SSQ0; __device__ __forceinline__ void operator()(int row, int col, float v) const { ZS[row * INC + win_logical_col(col)] = v * rsqrtf(SSQ0[MP + row] * (1.0f / DM) + EPS); } };
struct EpiS3 { const float* xs; float* Y; bf16* X1G; const float* gm; float* SSQ;
    __device__ __forceinline__ void operator()(int row, int col, float v) const {
        const float x1 = xs[row * DM + col] + v; X1G[(size_t)(MP + row) * DM + col] = (bf16)f2bf(x1);
        float ss = x1 * x1; ss += __shfl_xor(ss, 1); ss += __shfl_xor(ss, 2); ss += __shfl_xor(ss, 4); ss += __shfl_xor(ss, 8);
        if ((mk_fresh_lane() & 15) == 0) atomicAdd(SSQ + MP + row, ss);
    } };
struct EpiS4 { float* SSQ; bf16* H;
    __device__ __forceinline__ void operator()(int row, int col, float v) const {
        const float rstd = rsqrtf(__hip_atomic_load(SSQ + MP + row, __ATOMIC_RELAXED, __HIP_MEMORY_SCOPE_AGENT) * (1.0f / DM) + EPS);
        float h = fmaxf(v * rstd, 0.f); h *= h; H[(size_t)(MP + row) * FF + col] = (bf16)f2bf(h);
    } };
struct EpiS5 { float* Y; const bf16* X1G; float fac; __device__ __forceinline__ void operator()(int row, int col, float v) const { const size_t o = (size_t)(MP + row) * DM + col; Y[o] = (bf2f((unsigned)X1G[o]) + v) * fac; } };

template <int DEPTH, class Dec>
__device__ __forceinline__ void cvt_items(LAS float* scr, int first, int total, int stride, int lane, const Dec& D) {
    const int r8 = lane >> 3, c4 = lane & 7;
    int it = first; if (it >= total) return;
    const float* src; int N;
    f32x4 v[DEPTH][8]; bf16* dst[DEPTH]; int K[DEPTH];
#pragma unroll
    for (int d = 0; d < DEPTH; ++d) { dst[d] = nullptr; K[d] = 0; }
#pragma unroll
    for (int d = 0; d < DEPTH - 1; ++d)
        if (it + d * stride < total) { D(it + d * stride, src, N, dst[d], K[d]);
#pragma unroll
            for (int i = 0; i < 8; ++i) v[d][i] = __builtin_nontemporal_load((const f32x4*)(src + (size_t)(r8 + 8 * i) * N + 4 * c4)) * D.rowscale(it + d * stride, r8 + 8 * i); }
    for (;;) {
        const int nl = it + (DEPTH - 1) * stride;
        if (nl < total) { D(nl, src, N, dst[DEPTH - 1], K[DEPTH - 1]);
#pragma unroll
            for (int i = 0; i < 8; ++i) v[DEPTH - 1][i] = __builtin_nontemporal_load((const f32x4*)(src + (size_t)(r8 + 8 * i) * N + 4 * c4)) * D.rowscale(nl, r8 + 8 * i); }
#pragma unroll
        for (int i = 0; i < 8; ++i) { LAS float* s = scr + (r8 + 8 * i) * 33 + 4 * c4; s[0] = v[0][i][0]; s[1] = v[0][i][1]; s[2] = v[0][i][2]; s[3] = v[0][i][3]; }
        LDS_WAIT(); asm volatile("" ::: "memory");
        const int c = lane & 7;
#pragma unroll
        for (int j = 0; j < 4; ++j) { const int n = (lane >> 3) + 8 * j; const LAS float* s = scr + (8 * c) * 33 + n;
            v4u o; o.x = pk2(s[0 * 33], s[1 * 33]); o.y = pk2(s[2 * 33], s[3 * 33]); o.z = pk2(s[4 * 33], s[5 * 33]); o.w = pk2(s[6 * 33], s[7 * 33]);
            *(v4u*)(dst[0] + (size_t)n * K[0] + 8 * c) = o; }
        LDS_WAIT(); asm volatile("" ::: "memory");
        it += stride; if (it >= total) break;
#pragma unroll
        for (int d = 0; d < DEPTH - 1; ++d) {
#pragma unroll
            for (int i = 0; i < 8; ++i) v[d][i] = v[d + 1][i];
            dst[d] = dst[d + 1]; K[d] = K[d + 1]; }
    }
}
struct DecP0 { const float* w_in; bf16* WinT; const float* gmix;
    __device__ __forceinline__ float rowscale(int it, int kk) const { return gmix[64 * (it / (INC / 32)) + kk]; }
    __device__ __forceinline__ void operator()(int it, const float*& src, int& N, bf16*& dst, int& K) const {
        const int kb = it / (INC / 32), nb = it % (INC / 32); src = w_in + (size_t)(64 * kb) * INC + 32 * nb; N = INC; K = DM; dst = WinT + (size_t)(32 * win_dst_group(nb)) * DM + 64 * kb;
    } };
struct DecUp { const float *w_up, *w_out; bf16 *WupT, *WoutT; const float* gm;
    __device__ __forceinline__ float rowscale(int it, int kk) const { constexpr int I_UP = (DM / 64) * (FF / 32); return it < I_UP ? gm[64 * (it / (FF / 32)) + kk] : 1.0f; }
    __device__ __forceinline__ void operator()(int it, const float*& src, int& N, bf16*& dst, int& K) const {
        constexpr int I_UP = (DM / 64) * (FF / 32);
        if (it < I_UP) { const int kb = it / (FF / 32), nb = it % (FF / 32); src = w_up + (size_t)(64 * kb) * FF + 32 * nb; N = FF; K = DM; dst = WupT + (size_t)(32 * nb) * DM + 64 * kb; }
        else { const int r = it - I_UP, kb = r / (DM / 32), nb = r % (DM / 32); src = w_out + (size_t)(64 * kb) * DM + 32 * nb; N = DM; K = DM; dst = WoutT + (size_t)(32 * nb) * DM + 64 * kb; }
    } };
struct DecDn { const float* w_down; bf16* WdnT;
    __device__ __forceinline__ float rowscale(int, int) const { return 1.0f; }
    __device__ __forceinline__ void operator()(int it, const float*& src, int& N, bf16*& dst, int& K) const {
        const int kb = it / (DM / 32), nb = it % (DM / 32); src = w_down + (size_t)(64 * kb) * DM + 32 * nb; N = DM; K = FF; dst = WdnT + (size_t)(32 * nb) * FF + 64 * kb;
    } };
__device__ __forceinline__ void row_to_bf16(const float* xrow, bf16* orow, float* ssq, int lane) {
    const f32x4* xr = (const f32x4*)xrow + lane;
    f32x4 v[8]; float s = 0.f;
#pragma unroll
    for (int j = 0; j < 8; ++j) { v[j] = xr[64 * j]; s += dot4(v[j], v[j]); }
    v2u* o8 = (v2u*)orow + lane;
#pragma unroll
    for (int j = 0; j < 8; ++j) { v2u w; w.x = pk2(v[j][0], v[j][1]); w.y = pk2(v[j][2], v[j][3]); o8[64 * j] = w; }
    s = wave_sum(s);
    if (lane == 0) *ssq = s;
}

constexpr int KS_STRIDE = 72, VT_STRIDE = 276, KS_BYTES = 272 * KS_STRIDE * 2, VT_BYTES = 64 * VT_STRIDE * 2;
__device__ __forceinline__ void attn_unit(LAS unsigned char* lds, int b, int nb, int kh, const bf16* Q, const bf16* Kb, const bf16* Vb, bf16* MIX, const float* sinks,
                                          int tid, int wave, int lane) {
    LAS bf16* Ks = (LAS bf16*)lds; LAS bf16* Vt = (LAS bf16*)(lds + KS_BYTES);
    const int fr = lane & 15, fq = lane >> 4;
#pragma unroll
    for (int p = 0; p < 4; ++p) {
        const int idx = p * 512 + tid, key = idx >> 3, c = idx & 7, s = 128 * (nb - 1) + key;
        v4u kv = {0u, 0u, 0u, 0u}, vv = {0u, 0u, 0u, 0u};
        if (s >= 0) { const size_t off = (size_t)(b * SEQ + s) * 256 + 64 * kh + 8 * c; kv = *(const v4u*)(Kb + off); vv = *(const v4u*)(Vb + off); }
        *(LAS v4u*)(Ks + key * KS_STRIDE + 8 * c) = kv;
        LAS bf16* vp = Vt + (8 * c) * VT_STRIDE + key;
        vp[0 * VT_STRIDE] = (bf16)(vv.x & 0xffffu); vp[1 * VT_STRIDE] = (bf16)(vv.x >> 16); vp[2 * VT_STRIDE] = (bf16)(vv.y & 0xffffu); vp[3 * VT_STRIDE] = (bf16)(vv.y >> 16);
        vp[4 * VT_STRIDE] = (bf16)(vv.z & 0xffffu); vp[5 * VT_STRIDE] = (bf16)(vv.z >> 16); vp[6 * VT_STRIDE] = (bf16)(vv.w & 0xffffu); vp[7 * VT_STRIDE] = (bf16)(vv.w >> 16);
    }
    if (tid < 144) *(LAS v4u*)(Ks + 256 * KS_STRIDE + tid * 8) = (v4u){0u, 0u, 0u, 0u};
    for (int i = tid; i < 64 * 20; i += 512) Vt[(i / 20) * VT_STRIDE + 256 + (i % 20)] = 0;
    const int g = wave >> 1, h = 4 * kh + g; const float sink = sinks[h];
    bf16x8 qall[4][2];
#pragma unroll
    for (int qi = 0; qi < 4; ++qi) { const size_t r = (size_t)b * SEQ + 128 * nb + 16 * (4 * (wave & 1) + qi) + fr;
        qall[qi][0] = *(const bf16x8*)(Q + r * 1024 + 64 * h + 8 * fq); qall[qi][1] = *(const bf16x8*)(Q + r * 1024 + 64 * h + 32 + 8 * fq); }
    __syncthreads();
#pragma unroll
    for (int qi = 0; qi < 4; ++qi) {
        const int qt = 4 * (wave & 1) + qi, i0 = 16 * qt;
        const size_t r = (size_t)b * SEQ + 128 * nb + i0 + fr;
        bf16x8 qf[2];
        qf[0] = qall[qi][0]; qf[1] = qall[qi][1];
        f32x4 S[10];
#pragma unroll
        for (int t = 0; t < 10; ++t) {
            S[t] = (f32x4){0.f, 0.f, 0.f, 0.f};
#pragma unroll
            for (int ks = 0; ks < 2; ++ks) {
                const bf16x8 kf = *(const LAS bf16x8*)(Ks + (16 * (qt + t) + fr) * KS_STRIDE + 32 * ks + 8 * fq);
                S[t] = __builtin_amdgcn_mfma_f32_16x16x32_bf16(kf, qf[ks], S[t], 0, 0, 0);
            }
        }
        float mx = sink;
#pragma unroll
        for (int t = 0; t < 10; ++t)
#pragma unroll
            for (int j = 0; j < 4; ++j) {
                const int rel = 16 * t + 4 * fq + j - fr;
                const bool ok = rel >= 1 && rel <= 128 && (nb > 0 || (i0 + 16 * t + 4 * fq + j) >= 128);
                S[t][j] = ok ? S[t][j] : -1e30f; mx = fmaxf(mx, S[t][j]);
            }
        mx = fmaxf(mx, __shfl_xor(mx, 16)); mx = fmaxf(mx, __shfl_xor(mx, 32));
        float sum = 0.f;
#pragma unroll
        for (int t = 0; t < 10; ++t)
#pragma unroll
            for (int j = 0; j < 4; ++j) { S[t][j] = __expf(S[t][j] - mx); sum += S[t][j]; }
        sum += __shfl_xor(sum, 16); sum += __shfl_xor(sum, 32); sum += __expf(sink - mx);
        const float inv = 1.0f / sum;
        f32x4 O[4];
#pragma unroll
        for (int dt = 0; dt < 4; ++dt) O[dt] = (f32x4){0.f, 0.f, 0.f, 0.f};
#pragma unroll
        for (int k2 = 0; k2 < 5; ++k2) {
            v4u pw; pw.x = pk2(S[2 * k2][0], S[2 * k2][1]); pw.y = pk2(S[2 * k2][2], S[2 * k2][3]); pw.z = pk2(S[2 * k2 + 1][0], S[2 * k2 + 1][1]); pw.w = pk2(S[2 * k2 + 1][2], S[2 * k2 + 1][3]);
            const bf16x8 pf = __builtin_bit_cast(bf16x8, pw);
#pragma unroll
            for (int dt = 0; dt < 4; ++dt) {
                const LAS bf16* vp = Vt + (16 * dt + fr) * VT_STRIDE + 16 * (qt + 2 * k2) + 4 * fq;
                const v2u lo = *(const LAS v2u*)vp, hi = *(const LAS v2u*)(vp + 16);
                v4u vw; vw.x = lo.x; vw.y = lo.y; vw.z = hi.x; vw.w = hi.y;
                O[dt] = __builtin_amdgcn_mfma_f32_16x16x32_bf16(__builtin_bit_cast(bf16x8, vw), pf, O[dt], 0, 0, 0);
            }
        }
#pragma unroll
        for (int dt = 0; dt < 4; ++dt) {
            v2u w; w.x = pk2(O[dt][0] * inv, O[dt][1] * inv); w.y = pk2(O[dt][2] * inv, O[dt][3] * inv);
            *(v2u*)(MIX + r * DM + 64 * h + 16 * dt + 4 * fq) = w;
        }
    }
    __syncthreads();
}

constexpr int PF_LDS_OFF = 132096;
__device__ __forceinline__ void glds16_pf(const void* gsrc, unsigned lds_dst) { unsigned keep;
    asm volatile("s_mov_b32 %0, m0\n\ts_mov_b32 m0, %2\n\ts_nop 0\n\tglobal_load_lds_dwordx4 %1, off\n\ts_mov_b32 m0, %0" : "=&s"(keep) : "v"(gsrc), "s"(lds_dst) : "memory"); }
__device__ __forceinline__ void conv_unit(LAS unsigned char* lds, int b, int tb, const bf16* U, bf16* MIX, const float* cw, const float* cb, const float* lg, const float* lb,
                                          const float* xpre, int tid, int wave, int lane) {
    LAS unsigned* tile = (LAS unsigned*)lds;
    LAS float* red = (LAS float*)(lds + 62 * 2048);
    LAS float* fin = red + 512;
    const int s0 = 32 * tb;
    {   const int row0 = tid >> 7, c16 = tid & 127;
        const bf16* up = U + ((size_t)b * SEQ + s0 - 30 + row0) * 1024 + 8 * c16;
#pragma unroll
        for (int h8 = 0; h8 < 2; ++h8) {
            v4u tv[8];
#pragma unroll
            for (int t = 0; t < 8; ++t) { const int row = row0 + 4 * (8 * h8 + t);
                tv[t] = (v4u){0u, 0u, 0u, 0u};
                if (row < 62 && s0 - 30 + row >= 0) tv[t] = *(const v4u*)(up + (size_t)(4 * (8 * h8 + t)) * 1024); }
#pragma unroll
            for (int t = 0; t < 8; ++t) { const int row = row0 + 4 * (8 * h8 + t);
                if (row < 62) *(LAS v4u*)(tile + row * 512 + 4 * c16) = tv[t]; }
            asm volatile("" ::: "memory");
        }
    }
    __syncthreads();
    f32x2 w[31];
#pragma unroll
    for (int j = 0; j < 31; ++j) w[j] = *(const f32x2*)(cw + j * 1024 + 2 * tid);
    const f32x2 bias = *(const f32x2*)(cb + 2 * tid);
    const f32x2 g = *(const f32x2*)(lg + 2 * tid), be = *(const f32x2*)(lb + 2 * tid);
#pragma unroll 1
    for (int ck = 0; ck < 4; ++ck) {
        f32x2 c[8];
#pragma unroll
        for (int o = 0; o < 8; ++o) c[o] = bias;
#pragma unroll
        for (int rr = 0; rr < 38; ++rr) {
            const unsigned pv = tile[(8 * ck + rr) * 512 + tid];
            const f32x2 v = {bf2f(pv & 0xffffu), bf2f(pv >> 16)};
#pragma unroll
            for (int o = 0; o < 8; ++o) { const int j = rr - o; if (j >= 0 && j <= 30) c[o] = c[o] + w[j] * v; }
            if ((rr & 7) == 7) asm volatile("" ::: "memory");
        }
#pragma unroll
        for (int o = 0; o < 8; ++o) {
            const f32x2 x = c[o];
            const float s1 = wave_sum(x[0] + x[1]), s2 = wave_sum(x[0] * x[0] + x[1] * x[1]);
            if (lane == 0) { red[(wave * 8 + o) * 2] = s1; red[(wave * 8 + o) * 2 + 1] = s2; }
        }
        asm volatile("s_waitcnt lgkmcnt(0)\n\ts_barrier" ::: "memory");
        if (tid < 16) { float s = 0.f;
#pragma unroll
            for (int wv = 0; wv < 8; ++wv) s += red[wv * 16 + tid];
            fin[tid] = s; }
        asm volatile("s_waitcnt lgkmcnt(0)\n\ts_barrier" ::: "memory");
#pragma unroll
        for (int t = 0; t < 8; ++t) {
            const float mean = fin[2 * t] * (1.0f / CCH), var = fin[2 * t + 1] * (1.0f / CCH) - mean * mean, rstd = rsqrtf(fmaxf(var, 0.f) + EPS);
            const f32x2 y = (c[t] - mean) * rstd * g + be;
            const float o0 = y[0] * sigmoidf_(y[0]), o1 = y[1] * sigmoidf_(y[1]);
            *(unsigned*)(MIX + (size_t)(b * SEQ + s0 + 8 * ck + t) * DM + 1024 + 2 * tid) = pk2(o0, o1);
        }
        if (ck == 0 && xpre) {
            const float* xr = xpre + (size_t)(wave * 32) * DM + lane * 4;
#pragma unroll 8
            for (int i = 0; i < 32; ++i) glds16_pf(xr + (size_t)i * DM, (unsigned)(PF_LDS_OFF + wave * 1024));
        }
    }
    asm volatile("s_waitcnt lgkmcnt(0)\n\ts_barrier" ::: "memory");
}

__device__ __forceinline__ void sample_att(LAS unsigned char* lds, int b, const float* ZS, const float* cache_k, const float* cache_v, const float* state,
                                             const float* gq, const float* gk, const float* sinks, const float* cw, const float* cb, const float* lg, const float* lb,
                                             const float* cosT, const float* sinT, float* out, bf16* MIX, int tid, int wave, int lane) {
    LAS float* zs = (LAS float*)lds;
    LAS float* qs = zs + 3584;
    LAS float* kn = qs + 1024;
    LAS float* vn = kn + 256;
    LAS float* sc = vn + 256;
    LAS float* rd = sc + 2048;
    LAS float* part = rd + 16;
    for (int i = tid; i < INC; i += 512) zs[i] = ZS[b * INC + i];
    __syncthreads();
    for (int hh = wave; hh < 20; hh += 8) {
        const int base = hh < 16 ? 64 * hh : 1024 + 64 * (hh - 16);
        const float x = zs[base + lane];
        const float rstd = rsqrtf(wave_sum(x * x) * (1.0f / 64.0f) + EPS);
        const float y = x * rstd * (hh < 16 ? gq : gk)[lane];
        const float p = __shfl_xor(y, 32);
        const float co = cosT[2048 * 32 + (lane & 31)], si = sinT[2048 * 32 + (lane & 31)];
        const float o = lane < 32 ? y * co - p * si : y * co + p * si;
        if (hh < 16) qs[hh * 64 + lane] = o * 0.125f;
        else { kn[(hh - 16) * 64 + lane] = o; out[O_KS + ((size_t)(b * 128 + 127) * 4 + (hh - 16)) * 64 + lane] = o; }
    }
    if (tid < 256) { const float vv = zs[1280 + tid]; vn[tid] = vv; out[O_VS + (size_t)(b * 128 + 127) * 256 + tid] = vv; }
    __syncthreads();
    {
        const int jj = tid >> 2, kh = tid & 3, j = jj + 1;
        float d0 = 0.f, d1 = 0.f, d2 = 0.f, d3 = 0.f;
        const LAS float* q0 = qs + (4 * kh) * 64;
        if (j < 128) {
            const f32x4* kr = (const f32x4*)(cache_k + ((size_t)(b * 128 + j) * 4 + kh) * 64);
#pragma unroll
            for (int d4 = 0; d4 < 16; ++d4) { const f32x4 kv = kr[d4];
                d0 += dot4(kv, *(const LAS f32x4*)(q0 + 4 * d4)); d1 += dot4(kv, *(const LAS f32x4*)(q0 + 64 + 4 * d4));
                d2 += dot4(kv, *(const LAS f32x4*)(q0 + 128 + 4 * d4)); d3 += dot4(kv, *(const LAS f32x4*)(q0 + 192 + 4 * d4)); }
        } else {
#pragma unroll 4
            for (int d4 = 0; d4 < 16; ++d4) { const f32x4 kv = *(const LAS f32x4*)(kn + kh * 64 + 4 * d4);
                d0 += dot4(kv, *(const LAS f32x4*)(q0 + 4 * d4)); d1 += dot4(kv, *(const LAS f32x4*)(q0 + 64 + 4 * d4));
                d2 += dot4(kv, *(const LAS f32x4*)(q0 + 128 + 4 * d4)); d3 += dot4(kv, *(const LAS f32x4*)(q0 + 192 + 4 * d4)); }
        }
        sc[(4 * kh + 0) * 128 + jj] = d0; sc[(4 * kh + 1) * 128 + jj] = d1; sc[(4 * kh + 2) * 128 + jj] = d2; sc[(4 * kh + 3) * 128 + jj] = d3;
    }
    __syncthreads();
    for (int h = 2 * wave; h < 2 * wave + 2; ++h) {
        const float a = sc[h * 128 + lane], c2 = sc[h * 128 + 64 + lane], sink = sinks[h];
        const float m = fmaxf(wave_max(fmaxf(a, c2)), sink);
        const float pa = __expf(a - m), pb = __expf(c2 - m);
        const float den = wave_sum(pa + pb) + __expf(sink - m), inv = 1.0f / den;
        sc[h * 128 + lane] = pa * inv; sc[h * 128 + 64 + lane] = pb * inv;
    }
    __syncthreads();
    {
        const int d = tid & 63, kg = wave;
#pragma unroll 1
        for (int kh = 0; kh < 4; ++kh) {
            float vv[16];
#pragma unroll
            for (int t = 0; t < 16; ++t) { const int jj = 16 * kg + t;
                vv[t] = (jj < 127) ? cache_v[((size_t)(b * 128 + jj + 1) * 4 + kh) * 64 + d] : vn[kh * 64 + d]; }
            float a0 = 0.f, a1 = 0.f, a2 = 0.f, a3 = 0.f;
            const LAS float* sp = sc + (4 * kh) * 128 + 16 * kg;
#pragma unroll
            for (int t = 0; t < 16; ++t) { a0 += sp[t] * vv[t]; a1 += sp[128 + t] * vv[t]; a2 += sp[256 + t] * vv[t]; a3 += sp[384 + t] * vv[t]; }
            LAS float* pp = part + (kg * 16 + 4 * kh) * 64 + d;
            pp[0] = a0; pp[64] = a1; pp[128] = a2; pp[192] = a3;
        }
        __syncthreads();
#pragma unroll
        for (int hi = 0; hi < 2; ++hi) {
            const int h = (tid >> 6) + 8 * hi; float o = 0.f;
#pragma unroll
            for (int k8 = 0; k8 < 8; ++k8) o += part[(k8 * 16 + h) * 64 + d];
            MIX[(size_t)(MP + b) * DM + 64 * h + d] = (bf16)f2bf(o);
        }
    }
    __syncthreads();
}
__device__ __forceinline__ void sample_conv(LAS unsigned char* lds, int b, const float* ZS, const float* cache_k, const float* cache_v, const float* state,
                                             const float* gq, const float* gk, const float* sinks, const float* cw, const float* cb, const float* lg, const float* lb,
                                             const float* cosT, const float* sinT, float* out, bf16* MIX, int tid, int wave, int lane) {
    LAS float* zs = (LAS float*)lds;
    LAS float* qs = zs + 3584;
    LAS float* kn = qs + 1024;
    LAS float* vn = kn + 256;
    LAS float* sc = vn + 256;
    LAS float* rd = sc + 2048;
    LAS float* part = rd + 16;
    for (int i = 1536 + tid; i < INC; i += 512) zs[i] = ZS[b * INC + i];
    __syncthreads();
    {
        const int ch = 2 * tid;
        const float u0 = zs[1536 + ch] * sigmoidf_(zs[2560 + ch]), u1 = zs[1536 + ch + 1] * sigmoidf_(zs[2560 + ch + 1]);
        *(f32x2*)(out + O_CS + (size_t)(b * 30 + 29) * 1024 + ch) = (f32x2){u0, u1};
        f32x2 c = *(const f32x2*)(cb + ch);
#pragma unroll 10
        for (int j = 0; j < 30; ++j) c = c + *(const f32x2*)(cw + j * 1024 + ch) * *(const f32x2*)(state + (size_t)(b * 30 + j) * 1024 + ch);
        c = c + *(const f32x2*)(cw + 30 * 1024 + ch) * (f32x2){u0, u1};
        const float s1 = wave_sum(c[0] + c[1]), s2 = wave_sum(c[0] * c[0] + c[1] * c[1]);
        if (lane == 0) { rd[wave * 2] = s1; rd[wave * 2 + 1] = s2; }
        __syncthreads();
        float t1 = 0.f, t2 = 0.f;
#pragma unroll
        for (int wv = 0; wv < 8; ++wv) { t1 += rd[wv * 2]; t2 += rd[wv * 2 + 1]; }
        const float mean = t1 * (1.0f / CCH), var = t2 * (1.0f / CCH) - mean * mean, rstd = rsqrtf(fmaxf(var, 0.f) + EPS);
        const f32x2 y = (c - mean) * rstd * *(const f32x2*)(lg + ch) + *(const f32x2*)(lb + ch);
        *(unsigned*)(MIX + (size_t)(MP + b) * DM + 1024 + ch) = pk2(y[0] * sigmoidf_(y[0]), y[1] * sigmoidf_(y[1]));
    }
    __syncthreads();
}

#ifndef MK_DUP
#define MK_DUP (-1)
#endif
#define REPS(k)
#ifndef MK_CG_SEAMS
#define MK_CG_SEAMS 0
#endif
#define P2_CVT() do { const DecDn D{w_down, WdnT}; cvt_items<3>((LAS float*)(lds + wave * 16384), bx * NWAVES + wave, (FF / 64) * (DM / 32), ncv * NWAVES, lane, D); \
                const int gt = bx * (NWAVES * 64) + tid, NT = ncv * NWAVES * 64;        \
                for (int i = gt; i < 32 * 8128; i += NT) { const int b = i / 8128, o = i % 8128; \
                    ((f32x4*)(out + O_KS + (size_t)b * 32768))[o] = ((const f32x4*)(cache_k + (size_t)b * 32768 + 256))[o]; \
                    ((f32x4*)(out + O_VS + (size_t)b * 32768))[o] = ((const f32x4*)(cache_v + (size_t)b * 32768 + 256))[o]; } \
                for (int i = gt; i < 32 * 7424; i += NT) { const int b = i / 7424, o = i % 7424; \
                    ((f32x4*)(out + O_CS + (size_t)b * 30720))[o] = ((const f32x4*)(state + (size_t)b * 30720 + 1024))[o]; } } while (0)
struct Args { const float* in[18]; float* out; unsigned char* ws; int ph_lo, ph_hi, dry, pad; };
__global__ void __launch_bounds__(NWAVES * 64, 2) mk_fwd(Args args) {
    extern __shared__ __attribute__((aligned(16))) unsigned char lds_raw[];
    LAS unsigned char* lds = (LAS unsigned char*)lds_raw;
    const int wave_k = __builtin_amdgcn_readfirstlane((int)threadIdx.x >> 6);
    const int tid = wave_k * 64 + mk_fresh_lane();
    const int G = gridDim.x, bx = blockIdx.x;
    const int vcu = (G % 8 == 0) ? (bx % 8) * (G / 8) + bx / 8 : bx;
    unsigned char* ws = args.ws;
    const float *xp = args.in[0], *xs = args.in[1], *cache_k = args.in[2], *cache_v = args.in[3], *state = args.in[4], *g_mix = args.in[5], *w_in = args.in[6],
                *gq = args.in[7], *gk = args.in[8], *sinks = args.in[9], *conv_w = args.in[10], *conv_b = args.in[11], *ln_g = args.in[12], *ln_b = args.in[13],
                *w_out = args.in[14], *g_mlp = args.in[15], *w_up = args.in[16], *w_down = args.in[17];
    float* out = args.out;
    float* SSQ = (float*)(ws + WS_SSQ); float* SSQ0 = (float*)(ws + WS_SSQ0); float* cosT = (float*)(ws + WS_COS); float* sinT = (float*)(ws + WS_SIN); float* ZS = (float*)(ws + WS_ZS);
    bf16 *WinT = (bf16*)(ws + WS_WIN), *WoutT = (bf16*)(ws + WS_WOUT), *WupT = (bf16*)(ws + WS_WUP), *WdnT = (bf16*)(ws + WS_WDN);
    bf16 *X1G = (bf16*)(ws + WS_X1G), *HID = (bf16*)(ws + WS_HID), *XN = (bf16*)(ws + WS_XN), *Qb = (bf16*)(ws + WS_Q), *Kb = (bf16*)(ws + WS_K), *Vb = (bf16*)(ws + WS_V),
         *Ub = (bf16*)(ws + WS_U), *MIX = (bf16*)(ws + WS_MIX);
    for (int u = tid; u < (LDS_BYTES - LDSCTL_OFF) / 4; u += NWAVES * 64) ((LAS unsigned*)(lds + LDSCTL_OFF))[u] = 0u;
    __syncthreads();
    volatile LAS unsigned* MISC = (volatile LAS unsigned*)(lds + MISC_OFF);
    XcdBarrier bar; bar.bar = (unsigned*)(ws + WS_CTL) + CW_BAR; bar.x = 0; bar.st = nullptr;
    if (MK_N_LAUNCHES == 1) bar = xcd_barrier_post((unsigned*)(ws + WS_CTL) + CW_BAR, MISC + 8);
#define GRID_BAR(seam) do { if (MK_N_LAUNCHES == 1) { if ((MK_CG_SEAMS >> (seam)) & 1) cg::this_grid().sync(); else xcd_barrier(bar); } STAMP((seam) + 1); } while (0)
#define FRESH_IDS() const int wave = wave_k; int tid = wave * 64 + mk_fresh_lane(); asm volatile("" : "+v"(tid)); const int lane = tid & 63; (void)lane
#ifdef MK_TA
    unsigned long long* TS = (unsigned long long*)(ws + WS_SSQ + 128 * 1024);
#define STAMP(k) do { if (bx == G - 1 && tid == 0) TS[k] = __builtin_amdgcn_s_memrealtime(); } while (0)
#else
#define STAMP(k) do { } while (0)
#endif
    STAMP(0);
    const int lo = args.ph_lo, hi = args.ph_hi;
#ifndef MK_PLAIN
    if (args.pad == 0x5eed) cg::this_grid().sync();
#endif
#define IN(k) (lo <= (k) && (k) < hi)

    if (IN(0)) { REPS(0) {
        FRESH_IDS();
        LAS float* scr = (LAS float*)(lds + wave * 16384);
        const int gw = vcu * NWAVES + wave, NGW = G * NWAVES;
        { const DecP0 D{w_in, WinT, g_mix}; cvt_items<3>(scr, gw, (DM / 64) * (INC / 32), NGW, lane, D); }
        for (int m = gw; m < MT; m += NGW) row_to_bf16(m < MP ? xp + (size_t)m * DM : xs + (size_t)(m - MP) * DM, XN + (size_t)m * DM, SSQ0 + m, lane);
        const int gt = vcu * (NWAVES * 64) + tid, NT = G * NWAVES * 64;
        for (int i = gt; i < 2049 * 32; i += NT) {
            const int pos = i >> 5, k = i & 31; double inv = 1.0;
            for (int j = 0; j < k; ++j) inv *= 0.7498942093324559;
            const float ang = (pos == 2048 ? 16384.0f : (float)pos) * (float)inv;
            double rev = (double)ang * 0.15915494309189535; rev -= __builtin_rint(rev);
            const float rf = (float)rev;
            cosT[i] = __builtin_amdgcn_cosf(rf); sinT[i] = __builtin_amdgcn_sinf(rf);
        }
        }
        if (IN(1)) GRID_BAR(0);
    }
    if (IN(1)) { REPS(1) {
        const int nun = (MP / 256) * (INC / 256), rounds = (nun + G - 1) / G, GG = (nun + rounds - 1) / rounds, nsv = G - GG;
        if (bx < GG) {
            pg8::Gemm g{XN, WinT, MP, INC, DM}; pg8::StaticOrder S; S.init(MP, INC, GG, bx);
            Epi1 E{Qb, Kb, Vb, Ub, out, gq, gk, cosT, sinT, SSQ0};
            pg8::gemm_phase<Epi1, pg8::StaticOrder, true, true>(lds, g, S, E, wave_k);
        }
        FRESH_IDS();
        STAMP(9);
        EpiS1 ES{ZS, SSQ0};
        skinny_phase(lds, XN + (size_t)MP * DM, WinT, INC, DM, bx, G, ES, wave_k);
        {   const DecUp D{w_up, w_out, WupT, WoutT, g_mlp}; constexpr int NIT = (DM / 64) * (FF / 32) + (DM / 64) * (DM / 32);
            if (nsv > 0) { if (bx >= GG) cvt_items<5>((LAS float*)(lds + wave * 16384), (bx - GG) * NWAVES + wave, NIT, nsv * NWAVES, lane, D); }
            else cvt_items<5>((LAS float*)(lds + wave * 16384), bx * NWAVES + wave, NIT, G * NWAVES, lane, D);
        }
        }
        STAMP(12);
        if (IN(2)) GRID_BAR(1);
    }
    if (IN(2)) { REPS(2) {
        FRESH_IDS();
        const int ncv = G > 2 * MS ? G - 2 * MS : G;
        const bool cvt_first = bx < ncv && ((bx >> 3) & 1);
        if (cvt_first) { P2_CVT(); __syncthreads(); }
        for (int a = bx; a < 256; a += G) attn_unit(lds, a >> 6, (a >> 2) & 15, a & 3, Qb, Kb, Vb, MIX, sinks, tid, wave, lane);
        STAMP(6);
        for (int c = bx; c < 256; c += G) conv_unit(lds, c >> 6, c & 63, Ub, MIX, conv_w, conv_b, ln_g, ln_b, nullptr, tid, wave, lane);
        STAMP(7);
        if (bx < ncv && !cvt_first) { P2_CVT(); __syncthreads(); }
        for (int j = G - 1 - bx; j < 2 * MS; j += G) {
            if (j < MS) sample_att(lds, j, ZS, cache_k, cache_v, state, gq, gk, sinks, conv_w, conv_b, ln_g, ln_b, cosT, sinT, out, MIX, tid, wave, lane);
            else sample_conv(lds, j - MS, ZS, cache_k, cache_v, state, gq, gk, sinks, conv_w, conv_b, ln_g, ln_b, cosT, sinT, out, MIX, tid, wave, lane);
        }
        }
        STAMP(11);
        if (IN(3)) GRID_BAR(2);
    }
    if (IN(3)) {
        pg8::Gemm g{MIX, WoutT, MP, DM, DM}; pg8::StaticOrder S; S.init(MP, DM, G, bx);
        Epi3 E{XN, out + O_YP, X1G, g_mlp, args.dry ? SSQ + 16384 : SSQ};
        pg8::gemm_phase<Epi3, pg8::StaticOrder, true, true>(lds, g, S, E, wave_k);
        STAMP(13);
        EpiS3 ES{xs, out + O_YP, X1G, g_mlp, args.dry ? SSQ + 16384 : SSQ};
        skinny_phase(lds, MIX + (size_t)MP * DM, WoutT, DM, DM, G - 1 - bx, G, ES, wave_k);
        if (IN(4)) GRID_BAR(3);
    }
    if (IN(4)) { REPS(4) {
        pg8::Gemm g{X1G, WupT, MP, FF, DM}; pg8::StaticOrder S; S.init(MP, FF, G, bx);
        Epi4 E{SSQ, HID};
        EpiS4 ES{SSQ, HID};
        if (bx & 1) skinny_phase(lds, X1G + (size_t)MP * DM, WupT, FF, DM, G - 1 - bx, G, ES, wave_k);
        pg8::gemm_phase<Epi4, pg8::StaticOrder, true, true>(lds, g, S, E, wave_k);
        if (!(bx & 1)) skinny_phase(lds, X1G + (size_t)MP * DM, WupT, FF, DM, G - 1 - bx, G, ES, wave_k);
        }
        if (IN(5)) GRID_BAR(4);
    }
    if (IN(5)) {
        pg8::Gemm g{HID, WdnT, MP, DM, FF}; pg8::StaticOrder S; S.init(MP, DM, G, bx);
        Epi5 E{out + O_YP, X1G};
        pg8::gemm_phase<Epi5, pg8::StaticOrder, true, true>(lds, g, S, E, wave_k);
#ifdef MK_TA
        STAMP(8); __syncthreads();
        EpiS5 ES{out + O_YP, X1G, bx == G - 1 ? 1.0f + 1e-4f * (float)(long long)(__hip_atomic_load(TS + MK_TB, __ATOMIC_RELAXED, __HIP_MEMORY_SCOPE_AGENT) - __hip_atomic_load(TS + MK_TA, __ATOMIC_RELAXED, __HIP_MEMORY_SCOPE_AGENT)) : 1.0f};
#else
        EpiS5 ES{out + O_YP, X1G, 1.0f};
#endif
        skinny_phase(lds, HID + (size_t)MP * FF, WdnT, DM, FF, G - 1 - bx, G, ES, wave_k);
    }
#undef IN
}

extern "C" void kernel_launch(void* const* d_in, const int* in_sizes, int n_in, void* d_out, int out_size, void* d_ws, size_t ws_size, hipStream_t stream) {
    static int grid = 0;
    if (grid == 0) {
        if (n_in != 18 || (size_t)out_size != O_END || ws_size < WS_END) { fprintf(stderr, "kernel_launch: unexpected shapes: n_in %d out %d ws %zu\n", n_in, out_size, ws_size); grid = -1; return; }
        int dev = 0, cus = 0, per_cu = 0;
        if (hipGetDevice(&dev) != hipSuccess || hipDeviceGetAttribute(&cus, hipDeviceAttributeMultiprocessorCount, dev) != hipSuccess) { grid = -1; return; }
        if (hipFuncSetAttribute((const void*)mk_fwd, hipFuncAttributeMaxDynamicSharedMemorySize, LDS_BYTES) != hipSuccess) { fprintf(stderr, "kernel_launch: hipFuncSetAttribute failed\n"); grid = -1; return; }
        if (hipOccupancyMaxActiveBlocksPerMultiprocessor(&per_cu, (const void*)mk_fwd, NWAVES * 64, LDS_BYTES) != hipSuccess || per_cu < 1) { fprintf(stderr, "kernel_launch: occupancy query says %d\n", per_cu); (void)hipGetLastError(); grid = -1; return; }
        grid = cus;
    }
    if (grid < 0) return;
    (void)hipMemsetAsync((char*)d_ws + WS_CTL, 0, CTL_ZERO_BYTES, stream);
    Args a{};
    for (int i = 0; i < 18; ++i) a.in[i] = (const float*)d_in[i];
    a.out = (float*)d_out; a.ws = (unsigned char*)d_ws;
#if MK_N_LAUNCHES == 1 && defined(MK_PLAIN)
    a.ph_lo = 0; a.ph_hi = 6;
    hipLaunchKernelGGL(mk_fwd, dim3(grid), dim3(NWAVES * 64), LDS_BYTES, stream, a);
#elif MK_N_LAUNCHES == 1
    a.ph_lo = 0; a.ph_hi = 6;
    void* params[] = {&a};
    hipError_t e = hipLaunchCooperativeKernel((const void*)mk_fwd, dim3(grid), dim3(NWAVES * 64), params, LDS_BYTES, stream);
    if (e != hipSuccess) fprintf(stderr, "kernel_launch: cooperative launch failed: %s (grid %d)\n", hipGetErrorString(e), grid);
#else
    for (int p = 0; p < 6; ++p) for (int rep = 0; rep < (p == MK_DUP ? 2 : 1); ++rep) { a.ph_lo = p; a.ph_hi = p + 1; a.dry = (p == MK_DUP && rep == 0 && (p == 3 || p == 5)) ? 1 : 0; hipLaunchKernelGGL(mk_fwd, dim3(grid), dim3(NWAVES * 64), LDS_BYTES, stream, a); }
#endif
}
```

```cpp
#include <hip/hip_runtime.h>
#include <hip/hip_cooperative_groups.h>
#include <cstdio>
#include <cstdint>
namespace cg = cooperative_groups;
__device__ __forceinline__ int mk_fresh_lane() { int l; asm volatile("v_mbcnt_lo_u32_b32 %0, -1, 0\n\tv_mbcnt_hi_u32_b32 %0, -1, %0" : "=v"(l)); return l; }
#define MK_PLAIN 1
#define MK_N_LAUNCHES 1
namespace pg8 {
#define PG8_LAS __attribute__((address_space(3)))
typedef unsigned short bf16_t;
typedef short bf16x8 __attribute__((ext_vector_type(8)));
typedef float f32x4 __attribute__((ext_vector_type(4)));
typedef unsigned u32x4 __attribute__((ext_vector_type(4)));
constexpr int BM = 256, BK = 64, HALF = 128, HTB = HALF * BK * 2  , STAGE_BYTES = 8 * HTB, NXCD = 8, WGM = 8;

__host__ __device__ __forceinline__ int lds_byte(int r, int c) { const int st = (r >> 4) * 2 + (c >> 5), rr = r & 15, cc = c & 31, ob = rr * 64 + cc * 2; return st * 1024 + (ob ^ (((ob >> 9) & 1) << 5)); }
__host__ __device__ __forceinline__ void stage_rc(int b, int& R, int& C) { const int st = b / 1024, sb = b % 1024, swz = sb ^ (((sb >> 9) & 1) << 5); R = (st >> 1) * 16 + swz / 64; C = (st & 1) * 32 + (swz % 64) / 2; }
__host__ __device__ __forceinline__ int perm32(int rho) { const int n = rho >> 4, i = rho & 15; return 8 * (i >> 2) + 4 * n + (i & 3); }

struct Unit { int pm, pn; };
struct Gemm { const bf16_t* A; const bf16_t* Bt; int M, N, K; };

struct StaticOrder {
    int nM, nN, nwg, G, c;
    __host__ __device__ void init(int M, int N, int G_, int c_) { nM = M / BM; nN = N / BM; nwg = nM * nN; G = G_; c = c_; }
    __host__ __device__ bool next(int i, Unit& u) const {
        const long L = (long)i * G + c; if (L >= nwg) return false;
        int wgid = (int)L; { const int q = nwg / NXCD, r = nwg % NXCD, xcd = wgid % NXCD, off = wgid / NXCD; wgid = (xcd < r ? xcd * (q + 1) : r * (q + 1) + (xcd - r) * q) + off; }
        const int nig = WGM * nN, gid = wgid / nig, fm = gid * WGM, gsz = (nM - fm) < WGM ? (nM - fm) : WGM;
        u.pm = fm + ((wgid % nig) % gsz); u.pn = (wgid % nig) / gsz; return true;
    }
    __device__ __forceinline__ void a_ready(const Unit&) const {}
    __device__ __forceinline__ void done(const Unit&) const {}
};

__device__ __forceinline__ unsigned cvt_pk_bf16(float lo, float hi) { unsigned r; asm volatile("v_cvt_pk_bf16_f32 %0, %1, %2" : "=v"(r) : "v"(lo), "v"(hi)); return r; }
typedef float f32x2 __attribute__((ext_vector_type(2)));
template <class Epi, class Sched, bool ALIGN_EPI = false, bool SP2 = false>
__device__ __forceinline__ void gemm_phase(PG8_LAS unsigned char* lds, const Gemm g, const Sched& S, const Epi& E, const int wid_in) {
    const int wid = wid_in; int tid = wid * 64 + mk_fresh_lane(); asm volatile("" : "+v"(tid));
    const int lane = tid & 63, wr = wid >> 2, wc = wid & 3, fr = lane & 15, fq = lane >> 4;
    const int K = g.K, nt = K / BK;
    unsigned voffA[2], voffB[2];
#pragma unroll
    for (int i = 0; i < 2; ++i) { int R, C; stage_rc(tid * 16 + i * 8192, R, C); const int Rb = Epi::PERM ? ((R & ~31) + perm32(R & 31)) : R;
        voffA[i] = (unsigned)(R * K + C) * 2u; voffB[i] = (unsigned)(Rb * K + C) * 2u; }
    const size_t kstep = (size_t)(BK * 2);
    const size_t hstep = (size_t)HALF * K * 2;
    const size_t tstep = 2 * hstep;
    const unsigned ldsw = (unsigned)wid * 1024u;
    const int aoff = lds_byte(wr * 64 + fr, fq * 8), boff = lds_byte(wc * 32 + fr, fq * 8);
#define PG8_SA(b, h) (((b) * 2 + (h)) * HTB)
#define PG8_SB(b, h) ((4 + (b) * 2 + (h)) * HTB)
#define PG8_STAGE(bufoff, gbase, voff) do { _Pragma("unroll") for (int _i = 0; _i < 2; ++_i) \
        __builtin_amdgcn_global_load_lds((const unsigned*)((const char*)(gbase) + (voff)[_i]), (PG8_LAS unsigned*)(lds + (bufoff) + ldsw + _i * 8192), 16, 0, 0); } while (0)
#define PG8_LDA(dst, b, h) do { _Pragma("unroll") for (int m = 0; m < 4; ++m) _Pragma("unroll") for (int k = 0; k < 2; ++k) dst[m][k] = *(const PG8_LAS bf16x8*)(lds + PG8_SA(b, h) + aoff + m * 2048 + k * 1024); } while (0)
#define PG8_LDB(dst, b, h) do { _Pragma("unroll") for (int n = 0; n < 2; ++n) _Pragma("unroll") for (int k = 0; k < 2; ++k) dst[n][k] = *(const PG8_LAS bf16x8*)(lds + PG8_SB(b, h) + boff + n * 2048 + k * 1024); } while (0)
#define PG8_MMA(ai, bj, At, Bt) do { __builtin_amdgcn_s_setprio(1); _Pragma("unroll") for (int m = 0; m < 4; ++m) _Pragma("unroll") for (int n = 0; n < 2; ++n) _Pragma("unroll") for (int k = 0; k < 2; ++k) \
        acc[ai][bj][m][n] = __builtin_amdgcn_mfma_f32_16x16x32_bf16(Bt[n][k], At[m][k], acc[ai][bj][m][n], 0, 0, 0); __builtin_amdgcn_s_setprio(0); } while (0)
#define PG8_WAIT_V(n) asm volatile("s_waitcnt vmcnt(" #n ")" ::: "memory")
#define PG8_WAIT_L(n) asm volatile("s_waitcnt lgkmcnt(" #n ")" ::: "memory")
#define PG8_BAR __builtin_amdgcn_s_barrier()
#define PG8_SCHED __builtin_amdgcn_sched_barrier(0)
    Unit cur, nxt; int ui = 0;
    if (!S.next(0, cur)) return;
    f32x4 acc[2][2][4][2];
#pragma unroll
    for (int a = 0; a < 2; ++a)
#pragma unroll
        for (int b = 0; b < 2; ++b)
#pragma unroll
            for (int m = 0; m < 4; ++m)
#pragma unroll
                for (int n = 0; n < 2; ++n) acc[a][b][m][n] = (f32x4){0.f, 0.f, 0.f, 0.f};
    bf16x8 At[4][2], B0[2][2], B1[2][2];
    const char* cA = (const char*)g.A + (size_t)cur.pm * tstep; const char* cB = (const char*)g.Bt + (size_t)cur.pn * tstep;
    S.a_ready(cur);
    if constexpr (SP2) {
        PG8_STAGE(PG8_SB(0, 0), cB, voffB); PG8_STAGE(PG8_SB(0, 1), cB + hstep, voffB); PG8_STAGE(PG8_SA(0, 0), cA, voffA); PG8_STAGE(PG8_SA(0, 1), cA + hstep, voffA);
        if (wr == 1) PG8_BAR;
        PG8_WAIT_V(2); PG8_BAR;
        PG8_STAGE(PG8_SB(1, 0), cB + kstep, voffB); PG8_STAGE(PG8_SA(1, 0), cA + kstep, voffA); PG8_STAGE(PG8_SB(1, 1), cB + hstep + kstep, voffB);
        PG8_WAIT_V(6); PG8_BAR;
    } else {
        PG8_STAGE(PG8_SB(0, 0), cB, voffB); PG8_STAGE(PG8_SA(0, 0), cA, voffA); PG8_STAGE(PG8_SB(0, 1), cB + hstep, voffB); PG8_STAGE(PG8_SA(0, 1), cA + hstep, voffA);
        if (wr == 1) PG8_BAR;
        PG8_WAIT_V(4); PG8_BAR;
        PG8_STAGE(PG8_SB(1, 0), cB + kstep, voffB); PG8_STAGE(PG8_SA(1, 0), cA + kstep, voffA); PG8_STAGE(PG8_SB(1, 1), cB + hstep + kstep, voffB);
        PG8_WAIT_V(6); PG8_BAR;
    }
    for (;;) {
        const bool has_next = S.next(ui + 1, nxt);
        const char* nA = has_next ? (const char*)g.A + (size_t)nxt.pm * tstep : cA; const char* nB = has_next ? (const char*)g.Bt + (size_t)nxt.pn * tstep : cB;
        for (int t = 0; t < nt; t += 2) {
            const bool last = (t == nt - 2);
            const char* a1 = cA + (size_t)(t + 1) * kstep;
            const char* a2 = last ? nA : cA + (size_t)(t + 2) * kstep; const char* b2 = last ? nB : cB + (size_t)(t + 2) * kstep;
            const char* a3 = a2 + kstep; const char* b3 = b2 + kstep;
            if (last && has_next) S.a_ready(nxt);
            if constexpr (SP2) {
            PG8_LDB(B0, 0, 0); PG8_LDB(B1, 0, 1); PG8_SCHED; PG8_LDA(At, 0, 0); PG8_STAGE(PG8_SA(1, 1), a1 + hstep, voffA);
            PG8_WAIT_V(8); PG8_WAIT_L(0); PG8_BAR; PG8_MMA(0, 0, At, B0); PG8_MMA(0, 1, At, B1); PG8_BAR; PG8_SCHED;
            PG8_LDA(At, 0, 1); PG8_STAGE(PG8_SB(0, 0), b2, voffB); PG8_STAGE(PG8_SB(0, 1), b2 + hstep, voffB); PG8_STAGE(PG8_SA(0, 0), a2, voffA);
            PG8_WAIT_V(8); PG8_WAIT_L(0); PG8_BAR; PG8_MMA(1, 0, At, B0); PG8_MMA(1, 1, At, B1); PG8_BAR; PG8_SCHED;
            PG8_LDB(B0, 1, 0); PG8_LDB(B1, 1, 1); PG8_SCHED; PG8_LDA(At, 1, 0); PG8_STAGE(PG8_SA(0, 1), a2 + hstep, voffA);
            PG8_WAIT_V(8); PG8_WAIT_L(0); PG8_BAR; PG8_MMA(0, 0, At, B0); PG8_MMA(0, 1, At, B1); PG8_BAR; PG8_SCHED;
            PG8_LDA(At, 1, 1); PG8_STAGE(PG8_SB(1, 0), b3, voffB); PG8_STAGE(PG8_SB(1, 1), b3 + hstep, voffB); PG8_STAGE(PG8_SA(1, 0), a3, voffA);
            PG8_WAIT_V(8); PG8_WAIT_L(0); PG8_BAR; PG8_MMA(1, 0, At, B0); PG8_MMA(1, 1, At, B1); PG8_BAR; PG8_SCHED;
            } else {
            PG8_LDB(B0, 0, 0); PG8_SCHED; PG8_LDA(At, 0, 0); PG8_STAGE(PG8_SA(1, 1), a1 + hstep, voffA);
            PG8_WAIT_L(8); PG8_BAR; PG8_WAIT_L(0); PG8_MMA(0, 0, At, B0); PG8_BAR; PG8_SCHED;
            PG8_LDB(B1, 0, 1); PG8_STAGE(PG8_SB(0, 0), b2, voffB);
            PG8_BAR; PG8_WAIT_L(0); PG8_MMA(0, 1, At, B1); PG8_BAR;
            PG8_LDA(At, 0, 1); PG8_STAGE(PG8_SA(0, 0), a2, voffA);
            PG8_BAR; PG8_WAIT_L(0); PG8_MMA(1, 0, At, B0); PG8_BAR; PG8_SCHED;
            PG8_STAGE(PG8_SB(0, 1), b2 + hstep, voffB);
            PG8_WAIT_V(6); PG8_BAR; PG8_MMA(1, 1, At, B1); PG8_BAR;
            PG8_LDB(B0, 1, 0); PG8_SCHED; PG8_LDA(At, 1, 0); PG8_STAGE(PG8_SA(0, 1), a2 + hstep, voffA);
            PG8_WAIT_L(8); PG8_BAR; PG8_WAIT_L(0); PG8_MMA(0, 0, At, B0); PG8_BAR; PG8_SCHED;
            PG8_LDB(B1, 1, 1); PG8_STAGE(PG8_SB(1, 0), b3, voffB);
            PG8_BAR; PG8_WAIT_L(0); PG8_MMA(0, 1, At, B1); PG8_BAR;
            PG8_LDA(At, 1, 1); PG8_STAGE(PG8_SA(1, 0), a3, voffA);
            PG8_BAR; PG8_WAIT_L(0); PG8_MMA(1, 0, At, B0); PG8_BAR; PG8_SCHED;
            PG8_STAGE(PG8_SB(1, 1), b3 + hstep, voffB);
            PG8_WAIT_V(6); PG8_BAR; PG8_MMA(1, 1, At, B1); PG8_BAR;
            }
        }
        if constexpr (ALIGN_EPI) { if (wr == 0) PG8_BAR; }
        if constexpr (!Epi::AFTER_DRAIN) { E(acc, cur, wr, wc, fr, fq); S.done(cur); }
        if (!has_next) break;
#pragma unroll
        for (int a = 0; a < 2; ++a)
#pragma unroll
            for (int b = 0; b < 2; ++b)
#pragma unroll
                for (int m = 0; m < 4; ++m)
#pragma unroll
                    for (int n = 0; n < 2; ++n) acc[a][b][m][n] = (f32x4){0.f, 0.f, 0.f, 0.f};
        cur = nxt; cA = nA; cB = nB; ++ui;
        if constexpr (ALIGN_EPI) { if (wr == 1) PG8_BAR; }
    }
    PG8_WAIT_V(0);
    if constexpr (!ALIGN_EPI) { if (wr == 0) PG8_BAR; }
    PG8_BAR;
    if constexpr (Epi::AFTER_DRAIN) { E.fused(acc, cur, wr, wc, fr, fq, lds, wid, lane); S.done(cur); }
#undef PG8_SA
#undef PG8_SB
#undef PG8_STAGE
#undef PG8_LDA
#undef PG8_LDB
#undef PG8_MMA
#undef PG8_WAIT_V
#undef PG8_WAIT_L
#undef PG8_BAR
#undef PG8_SCHED
}
}
#define GAS __attribute__((address_space(1)))
#define LAS __attribute__((address_space(3)))
#define XB_TMO      128
#define XB_XCNT(j)  (256  + 64 * (j))
#define XB_XSUB(j)  (1280 + 64 * (j))
#define XB_XGEN(j)  (2304 + 64 * (j))
#define XB_TOP      3328
#define XB_TOPGEN   3392
#define XCD_BAR_WORDS 3456
#define XB_SPIN_CAP (1u << 18)

__device__ __forceinline__ unsigned xb_ld(unsigned* p)              { return __hip_atomic_load(p, __ATOMIC_RELAXED, __HIP_MEMORY_SCOPE_AGENT); }
__device__ __forceinline__ unsigned xb_add(unsigned* p, unsigned v) { return __hip_atomic_fetch_add(p, v, __ATOMIC_RELAXED, __HIP_MEMORY_SCOPE_AGENT); }
__device__ __forceinline__ unsigned xb_xcc_id() { return (unsigned)__builtin_amdgcn_s_getreg((3 << 11) | 20) & 0xFu; }
#define XB_SPIN(cond, bar) do { unsigned _sp = 0; while (cond) { __builtin_amdgcn_s_sleep(1); \
    if ((++_sp & 255u) == 0u) { if (xb_ld(&(bar)[XB_TMO])) break; if (_sp > XB_SPIN_CAP) { atomicAdd(&(bar)[XB_TMO], 1u); break; } } } } while (0)

struct XcdBarrier {
    unsigned* bar; unsigned x;
    volatile LAS unsigned* st;
};

__device__ __forceinline__ XcdBarrier xcd_barrier_post(unsigned* bar, volatile LAS unsigned* st) {
    XcdBarrier b; b.bar = bar; b.x = xb_xcc_id(); b.st = st;
    if (threadIdx.x == 0) (void)xb_add(&bar[XB_XCNT(b.x)], 1u);
    return b;
}
__device__ __forceinline__ void xcd_barrier_complete(unsigned* bar, unsigned x, unsigned& nloc, unsigned& nx) {
    const unsigned G = gridDim.x * gridDim.y * gridDim.z;
    unsigned sum, cnt, mine, sp = 0u;
    for (;;) {
        sum = 0u; cnt = 0u; mine = 0u;
#pragma unroll
        for (unsigned j = 0; j < 16; ++j) { const unsigned c = xb_ld(&bar[XB_XCNT(j)]); sum += c; cnt += (c > 0u) ? 1u : 0u; mine = (j == x) ? c : mine; }
        if (sum == G) break;
        __builtin_amdgcn_s_sleep(1);
        if ((++sp & 255u) == 0u) { if (xb_ld(&bar[XB_TMO])) break; if (sp > XB_SPIN_CAP) { atomicAdd(&bar[XB_TMO], 1u); break; } }
    }
    nloc = mine > 0u ? mine : 1u; nx = cnt > 0u ? cnt : 1u;
}

__device__ __forceinline__ void xcd_barrier(const XcdBarrier& b) {
    asm volatile("s_waitcnt vmcnt(0)" ::: "memory");
    __syncthreads();
    if (threadIdx.x == 0) {
        unsigned* bar = b.bar;
        __builtin_amdgcn_s_waitcnt(0);
        unsigned nloc = b.st[0], nx = b.st[1];
        if (nloc == 0u) { xcd_barrier_complete(bar, b.x, nloc, nx); b.st[0] = nloc; b.st[1] = nx; }
        const unsigned old = xb_add(&bar[XB_XSUB(b.x)], 1u);
        const unsigned gen = old / nloc;
        if (old + 1u == (gen + 1u) * nloc) {
            __builtin_amdgcn_fence(__ATOMIC_RELEASE, "agent");
            asm volatile("s_waitcnt vmcnt(0)" ::: "memory");
            const unsigned og = xb_add(&bar[XB_TOP], 1u);
            const unsigned tg = og / nx;
            if (og + 1u == (tg + 1u) * nx) xb_add(&bar[XB_TOPGEN], 1u);
            else XB_SPIN(xb_ld(&bar[XB_TOPGEN]) == tg, bar);
            __builtin_amdgcn_fence(__ATOMIC_ACQUIRE, "agent");
            xb_add(&bar[XB_XGEN(b.x)], 1u);
            asm volatile("s_waitcnt vmcnt(0)" ::: "memory");
        } else {
            XB_SPIN(xb_ld(&bar[XB_XGEN(b.x)]) == gen, bar);
            __builtin_amdgcn_fence(__ATOMIC_ACQUIRE, "agent");
            asm volatile("s_waitcnt vmcnt(0)" ::: "memory");
        }
    }
    __syncthreads();
}

#ifndef MK_N_LAUNCHES
#define MK_N_LAUNCHES 1
#endif
constexpr int NWAVES = 8;
constexpr int DM = 2048, SEQ = 2048, NBATCH = 4, MP = NBATCH * SEQ, MS = 32, MT = MP + MS;
constexpr int INC = 3584, FF = 8192, NH = 16, NKV = 4, HD = 64, CCH = 1024, CW = 31;
constexpr float EPS = 1e-6f;
constexpr size_t O_YP = 0, O_YS = (size_t)MP * DM, O_KP = O_YS + (size_t)MS * DM, O_VP = O_KP + 131072, O_CP = O_VP + 131072,
                 O_KS = O_CP + 122880, O_VS = O_KS + 1048576, O_CS = O_VS + 1048576, O_END = O_CS + 983040;
constexpr size_t MiB = 1u << 20;
constexpr size_t WS_CTL = 0, CTL_ZERO_BYTES = 68 * 1024;
constexpr size_t WS_SSQ = 32 * 1024, WS_SSQ0 = 96 * 1024;
constexpr size_t WS_COS = 1 * MiB, WS_SIN = 2 * MiB;
constexpr size_t WS_ZS = 3 * MiB;
constexpr size_t WS_WIN = 4 * MiB, WS_WOUT = 18 * MiB, WS_WUP = 26 * MiB, WS_WDN = 58 * MiB;
constexpr size_t WS_X1G = 90 * MiB;
constexpr size_t WS_HID = 123 * MiB;
constexpr size_t WS_XN = 123 * MiB, WS_Q = 156 * MiB, WS_K = 172 * MiB, WS_V = 176 * MiB, WS_U = 180 * MiB, WS_MIX = 196 * MiB;
constexpr size_t WS_END = 256 * MiB;
static_assert(WS_HID + (size_t)MT * FF * 2 <= WS_END && WS_MIX + (size_t)MT * DM * 2 <= WS_END && WS_X1G + (size_t)MT * DM * 2 <= WS_HID, "ws map");
constexpr int CW_BAR = 4096;
constexpr int RING_BYTES = 131072, LDSCTL_OFF = RING_BYTES, MISC_OFF = LDSCTL_OFF + 320, LDS_BYTES = 147456;

typedef unsigned short bf16;
typedef unsigned v4u __attribute__((ext_vector_type(4)));
typedef unsigned v2u __attribute__((ext_vector_type(2)));
typedef float f32x4 __attribute__((ext_vector_type(4)));
typedef float f32x2 __attribute__((ext_vector_type(2)));
typedef short bf16x8 __attribute__((ext_vector_type(8)));
#define LDS_WAIT() asm volatile("s_waitcnt lgkmcnt(0)" ::: "memory")
__device__ __forceinline__ unsigned f2bf(float f) { unsigned u = __builtin_bit_cast(unsigned, f); return (u + 0x7fffu + ((u >> 16) & 1u)) >> 16; }
__device__ __forceinline__ unsigned pk2(float lo, float hi) { return pg8::cvt_pk_bf16(lo, hi); }
__device__ __forceinline__ float bf2f(unsigned h) { return __builtin_bit_cast(float, h << 16); }
template <int CTRL, int ROWMASK> __device__ __forceinline__ float dpp_get(float v) {
    return __builtin_bit_cast(float, __builtin_amdgcn_update_dpp(0, __builtin_bit_cast(int, v), CTRL, ROWMASK, 0xf, false)); }
__device__ __forceinline__ float wave_sum(float v) {
    v += dpp_get<0xB1, 0xf>(v); v += dpp_get<0x4E, 0xf>(v); v += dpp_get<0x124, 0xf>(v); v += dpp_get<0x128, 0xf>(v);
    v += dpp_get<0x142, 0xa>(v); v += dpp_get<0x143, 0xc>(v);
    return __builtin_bit_cast(float, __builtin_amdgcn_readlane(__builtin_bit_cast(int, v), 63));
}
__device__ __forceinline__ float wave_max(float v) {
    v = fmaxf(v, dpp_get<0xB1, 0xf>(v)); v = fmaxf(v, dpp_get<0x4E, 0xf>(v)); v = fmaxf(v, dpp_get<0x124, 0xf>(v)); v = fmaxf(v, dpp_get<0x128, 0xf>(v));
    const int iv = __builtin_bit_cast(int, v);
    const float a = __builtin_bit_cast(float, __builtin_amdgcn_readlane(iv, 0)), b = __builtin_bit_cast(float, __builtin_amdgcn_readlane(iv, 16)),
                c = __builtin_bit_cast(float, __builtin_amdgcn_readlane(iv, 32)), d = __builtin_bit_cast(float, __builtin_amdgcn_readlane(iv, 48));
    return fmaxf(fmaxf(a, b), fmaxf(c, d));
}
__device__ __forceinline__ float dot4(f32x4 a, f32x4 b) { return (a[0] * b[0] + a[1] * b[1]) + (a[2] * b[2] + a[3] * b[3]); }
__device__ __forceinline__ float sigmoidf_(float g) { return 1.0f / (1.0f + __expf(-g)); }

__device__ __forceinline__ int win_dst_group(int sg) {
    if (sg < 48) { const int pn = sg >> 3, wc = (sg & 7) >> 1, bj = sg & 1; return 8 * pn + 4 * bj + wc; }
    if (sg < 80) { const int cc = sg - 48; return 8 * (6 + (cc >> 2)) + (cc & 3); }
    const int cc = sg - 80; return 8 * (6 + (cc >> 2)) + 4 + (cc & 3);
}
__device__ __forceinline__ int win_logical_col(int np) {
    const int dg = np >> 5, e = np & 31, pn = dg >> 3, bj = (dg >> 2) & 1, wc = dg & 3;
    if (dg < 48) return 256 * pn + 64 * wc + 32 * bj + e;
    return (bj ? 2560 : 1536) + 128 * (pn - 6) + 32 * wc + e;
}

using pg8::Unit;
struct Epi1 {
    static constexpr bool PERM = true, AFTER_DRAIN = false;
    bf16 *Q, *K, *V, *U; float* out; const float *gq, *gk, *cosT, *sinT, *SSQ0;
    __device__ __forceinline__ void operator()(const f32x4 (&acc)[2][2][4][2], const Unit& u, int wr, int wc, int fr, int fq) const {
        const int pn = u.pn, rbase = u.pm * 256 + wr * 64 + fr;
        if (pn < 5) {
            const float* g = pn < 4 ? gq : gk; const float qs = pn < 4 ? 0.125f : 1.0f;
            const f32x4 g1a = *(const f32x4*)(g + 8 * fq), g1b = *(const f32x4*)(g + 8 * fq + 4), g2a = *(const f32x4*)(g + 32 + 8 * fq), g2b = *(const f32x4*)(g + 36 + 8 * fq);
#pragma unroll
            for (int ah = 0; ah < 4; ++ah) {
                const int ai = ah >> 1;
                f32x4 rc[4][2], rs[4][2]; float r0[4];
#pragma unroll
                for (int m = 2 * (ah & 1); m < 2 * (ah & 1) + 2; ++m) { const int s = (rbase + ai * 128 + m * 16) & (SEQ - 1);
                    r0[m] = SSQ0[rbase + ai * 128 + m * 16];
                    rc[m][0] = *(const f32x4*)(cosT + s * 32 + 8 * fq); rc[m][1] = *(const f32x4*)(cosT + s * 32 + 8 * fq + 4);
                    rs[m][0] = *(const f32x4*)(sinT + s * 32 + 8 * fq); rs[m][1] = *(const f32x4*)(sinT + s * 32 + 8 * fq + 4); }
                asm volatile("" ::: "memory");
#pragma unroll
                for (int m = 2 * (ah & 1); m < 2 * (ah & 1) + 2; ++m) {
                    const int r = rbase + ai * 128 + m * 16, s = r & (SEQ - 1), b = r >> 11;
                    const float rr = rsqrtf(r0[m] * (1.0f / DM) + EPS);
                    const f32x4 x1a = acc[ai][0][m][0] * rr, x1b = acc[ai][0][m][1] * rr, x2a = acc[ai][1][m][0] * rr, x2b = acc[ai][1][m][1] * rr;
                    float ss = (dot4(x1a, x1a) + dot4(x1b, x1b)) + (dot4(x2a, x2a) + dot4(x2b, x2b));
                    ss += __shfl_xor(ss, 16); ss += __shfl_xor(ss, 32);
                    const float rstd = rsqrtf(ss * (1.0f / 64.0f) + EPS);
                    const f32x4 y1a = x1a * rstd * g1a, y1b = x1b * rstd * g1b, y2a = x2a * rstd * g2a, y2b = x2b * rstd * g2b;
                    const f32x4 ca = rc[m][0], cb = rc[m][1], sa = rs[m][0], sb = rs[m][1];
                    const f32x4 o1a = y1a * ca - y2a * sa, o1b = y1b * cb - y2b * sb, o2a = y2a * ca + y1a * sa, o2b = y2b * cb + y1b * sb;
                    v4u w1, w2;
                    w1.x = pk2(o1a[0] * qs, o1a[1] * qs); w1.y = pk2(o1a[2] * qs, o1a[3] * qs); w1.z = pk2(o1b[0] * qs, o1b[1] * qs); w1.w = pk2(o1b[2] * qs, o1b[3] * qs);
                    w2.x = pk2(o2a[0] * qs, o2a[1] * qs); w2.y = pk2(o2a[2] * qs, o2a[3] * qs); w2.z = pk2(o2b[0] * qs, o2b[1] * qs); w2.w = pk2(o2b[2] * qs, o2b[3] * qs);
                    if (pn < 4) {
                        bf16* p = Q + (size_t)r * 1024 + 64 * (4 * pn + wc) + 8 * fq;
                        *(v4u*)p = w1; *(v4u*)(p + 32) = w2;
                    } else {
                        bf16* p = K + (size_t)r * 256 + 64 * wc + 8 * fq;
                        *(v4u*)p = w1; *(v4u*)(p + 32) = w2;
                        if (s >= SEQ - 128) {
                            float* o = out + O_KP + ((size_t)(b * 128 + s - (SEQ - 128)) * 4 + wc) * 64 + 8 * fq;
                            *(f32x4*)o = o1a; *(f32x4*)(o + 4) = o1b; *(f32x4*)(o + 32) = o2a; *(f32x4*)(o + 36) = o2b;
                        }
                    }
                }
                asm volatile("" ::: "memory");
            }
        } else if (pn == 5) {
#pragma unroll
            for (int ai = 0; ai < 2; ++ai) {
                float r0[4];
#pragma unroll
                for (int m = 0; m < 4; ++m) r0[m] = SSQ0[rbase + ai * 128 + m * 16];
                asm volatile("" ::: "memory");
#pragma unroll
                for (int m = 0; m < 4; ++m) {
                    const int r = rbase + ai * 128 + m * 16, s = r & (SEQ - 1), b = r >> 11; const float rr = rsqrtf(r0[m] * (1.0f / DM) + EPS);
#pragma unroll
                    for (int bj = 0; bj < 2; ++bj) {
                        const f32x4 v0 = acc[ai][bj][m][0] * rr, v1 = acc[ai][bj][m][1] * rr;
                        v4u w; w.x = pk2(v0[0], v0[1]); w.y = pk2(v0[2], v0[3]); w.z = pk2(v1[0], v1[1]); w.w = pk2(v1[2], v1[3]);
                        *(v4u*)(V + (size_t)r * 256 + 64 * wc + 32 * bj + 8 * fq) = w;
                        if (s >= SEQ - 128) {
                            float* o = out + O_VP + ((size_t)(b * 128 + s - (SEQ - 128)) * 4 + wc) * 64 + 32 * bj + 8 * fq;
                            *(f32x4*)o = v0; *(f32x4*)(o + 4) = v1;
                        }
                    }
                }
            }
        } else {
            const int ch = 128 * (pn - 6) + 32 * wc + 8 * fq;
#pragma unroll
            for (int ai = 0; ai < 2; ++ai) {
                float r0[4];
#pragma unroll
                for (int m = 0; m < 4; ++m) r0[m] = SSQ0[rbase + ai * 128 + m * 16];
                asm volatile("" ::: "memory");
#pragma unroll
                for (int m = 0; m < 4; ++m) {
                    const int r = rbase + ai * 128 + m * 16, s = r & (SEQ - 1), b = r >> 11;
                    const float rr = rsqrtf(r0[m] * (1.0f / DM) + EPS);
                    const f32x4 a0 = acc[ai][0][m][0] * rr, a1 = acc[ai][0][m][1] * rr, g0 = acc[ai][1][m][0] * rr, g1 = acc[ai][1][m][1] * rr;
                    f32x4 u0, u1;
#pragma unroll
                    for (int j = 0; j < 4; ++j) { u0[j] = a0[j] * sigmoidf_(g0[j]); u1[j] = a1[j] * sigmoidf_(g1[j]); }
                    v4u w; w.x = pk2(u0[0], u0[1]); w.y = pk2(u0[2], u0[3]); w.z = pk2(u1[0], u1[1]); w.w = pk2(u1[2], u1[3]);
                    *(v4u*)(U + (size_t)r * 1024 + ch) = w;
                    if (s >= SEQ - 30) {
                        float* o = out + O_CP + (size_t)(b * 30 + s - (SEQ - 30)) * 1024 + ch;
                        *(f32x4*)o = u0; *(f32x4*)(o + 4) = u1;
                    }
                }
            }
        }
    }
};
struct Epi3 {
    static constexpr bool PERM = true, AFTER_DRAIN = false;
    const bf16* XB; float* Y; bf16* X1G; const float* gm; float* SSQ;
    __device__ __forceinline__ void operator()(const f32x4 (&acc)[2][2][4][2], const Unit& u, int wr, int wc, int fr, int fq) const {
        const int rbase = u.pm * 256 + wr * 64 + fr, col0 = u.pn * 256 + wc * 32 + 8 * fq;
#pragma unroll
        for (int ai = 0; ai < 2; ++ai) {
            f32x4 pre[4][2][2];
#pragma unroll
            for (int m = 0; m < 4; ++m)
#pragma unroll
                for (int bj = 0; bj < 2; ++bj) { const v4u q = *(const v4u*)(XB + (size_t)(rbase + ai * 128 + m * 16) * DM + col0 + bj * 128);
                    pre[m][bj][0] = (f32x4){bf2f(q.x & 0xffffu), bf2f(q.x >> 16), bf2f(q.y & 0xffffu), bf2f(q.y >> 16)};
                    pre[m][bj][1] = (f32x4){bf2f(q.z & 0xffffu), bf2f(q.z >> 16), bf2f(q.w & 0xffffu), bf2f(q.w >> 16)}; }
            asm volatile("" ::: "memory");
#pragma unroll
            for (int m = 0; m < 4; ++m) {
                const int r = rbase + ai * 128 + m * 16; float ss = 0.f;
#pragma unroll
                for (int bj = 0; bj < 2; ++bj) {
                    const size_t off = (size_t)r * DM + col0 + bj * 128;
                    const f32x4 v0 = acc[ai][bj][m][0] + pre[m][bj][0], v1 = acc[ai][bj][m][1] + pre[m][bj][1];
                    ss += dot4(v0, v0) + dot4(v1, v1);
                    v4u w; w.x = pk2(v0[0], v0[1]); w.y = pk2(v0[2], v0[3]); w.z = pk2(v1[0], v1[1]); w.w = pk2(v1[2], v1[3]);
                    *(v4u*)(X1G + off) = w;
                }
                ss += __shfl_xor(ss, 16); ss += __shfl_xor(ss, 32);
                if (fq == 0) atomicAdd(SSQ + r, ss);
            }
            asm volatile("" ::: "memory");
        }
    }
};
struct Epi4 {
    static constexpr bool PERM = true, AFTER_DRAIN = false;
    const float* SSQ; bf16* H;
    __device__ __forceinline__ void operator()(const f32x4 (&acc)[2][2][4][2], const Unit& u, int wr, int wc, int fr, int fq) const {
        const int rbase = u.pm * 256 + wr * 64 + fr, col0 = u.pn * 256 + wc * 32 + 8 * fq;
        float sq[2][4];
#pragma unroll
        for (int ai = 0; ai < 2; ++ai)
#pragma unroll
            for (int m = 0; m < 4; ++m) sq[ai][m] = SSQ[rbase + ai * 128 + m * 16];
        asm volatile("" ::: "memory");
#pragma unroll
        for (int ai = 0; ai < 2; ++ai)
#pragma unroll
            for (int m = 0; m < 4; ++m) {
                const int r = rbase + ai * 128 + m * 16;
                const float rstd = rsqrtf(sq[ai][m] * (1.0f / DM) + EPS);
#pragma unroll
                for (int bj = 0; bj < 2; ++bj) {
                    f32x4 v0 = acc[ai][bj][m][0] * rstd, v1 = acc[ai][bj][m][1] * rstd;
#pragma unroll
                    for (int j = 0; j < 4; ++j) { v0[j] = fmaxf(v0[j], 0.f); v0[j] *= v0[j]; v1[j] = fmaxf(v1[j], 0.f); v1[j] *= v1[j]; }
                    v4u w; w.x = pk2(v0[0], v0[1]); w.y = pk2(v0[2], v0[3]); w.z = pk2(v1[0], v1[1]); w.w = pk2(v1[2], v1[3]);
                    *(v4u*)(H + (size_t)r * FF + col0 + bj * 128) = w;
                }
            }
    }
};
struct Epi5 {
    static constexpr bool PERM = true, AFTER_DRAIN = false;
    float* Y; const bf16* X1G;
    __device__ __forceinline__ void operator()(const f32x4 (&acc)[2][2][4][2], const Unit& u, int wr, int wc, int fr, int fq) const {
        const int rbase = u.pm * 256 + wr * 64 + fr, col0 = u.pn * 256 + wc * 32 + 8 * fq;
        v4u pre[2][4][2];
#pragma unroll
        for (int ai = 0; ai < 2; ++ai)
#pragma unroll
            for (int m = 0; m < 4; ++m)
#pragma unroll
                for (int bj = 0; bj < 2; ++bj) pre[ai][m][bj] = *(const v4u*)(X1G + (size_t)(rbase + ai * 128 + m * 16) * DM + col0 + bj * 128);
        asm volatile("" ::: "memory");
#pragma unroll
        for (int ai = 0; ai < 2; ++ai)
#pragma unroll
            for (int m = 0; m < 4; ++m)
#pragma unroll
                for (int bj = 0; bj < 2; ++bj) { float* p = Y + (size_t)(rbase + ai * 128 + m * 16) * DM + col0 + bj * 128; const v4u q = pre[ai][m][bj];
                    const f32x4 r0 = {bf2f(q.x & 0xffffu), bf2f(q.x >> 16), bf2f(q.y & 0xffffu), bf2f(q.y >> 16)}, r1 = {bf2f(q.z & 0xffffu), bf2f(q.z >> 16), bf2f(q.w & 0xffffu), bf2f(q.w >> 16)};
                    *(f32x4*)p = acc[ai][bj][m][0] + r0; *(f32x4*)(p + 4) = acc[ai][bj][m][1] + r1; }
    }
};

template <class EpiS>
__device__ __forceinline__ void skinny_phase(LAS unsigned char* lds, const bf16* As, const bf16* Bt, int N, int K, int start, int stride, const EpiS& E, const int wid_in) {
    const int wave = wid_in; int tid = wave * 64 + mk_fresh_lane(); asm volatile("" : "+v"(tid));
    const int lane = tid & 63, fr = lane & 15, fq = lane >> 4;
    LAS float* red = (LAS float*)lds;
    const int kw = K >> 3, kb = wave * kw;
    for (int unit = start; unit < (N >> 4); unit += stride) {
        f32x4 a0 = {0.f, 0.f, 0.f, 0.f}, a1 = {0.f, 0.f, 0.f, 0.f};
        const bf16* bp = Bt + (size_t)(16 * unit + fr) * K + kb + 8 * fq;
        const bf16* ap0 = As + (size_t)fr * K + kb + 8 * fq;
        const bf16* ap1 = ap0 + (size_t)16 * K;
#pragma unroll 8
        for (int k = 0; k < kw; k += 32) {
            const bf16x8 b = *(const bf16x8*)(bp + k), x0 = *(const bf16x8*)(ap0 + k), x1 = *(const bf16x8*)(ap1 + k);
            a0 = __builtin_amdgcn_mfma_f32_16x16x32_bf16(b, x0, a0, 0, 0, 0);
            a1 = __builtin_amdgcn_mfma_f32_16x16x32_bf16(b, x1, a1, 0, 0, 0);
        }
        *(LAS f32x4*)(red + (wave * 2 + 0) * 256 + lane * 4) = a0;
        *(LAS f32x4*)(red + (wave * 2 + 1) * 256 + lane * 4) = a1;
        __syncthreads();
        const int row = tid >> 4, cj = tid & 15, idx = (row >> 4) * 256 + ((row & 15) + 16 * (cj >> 2)) * 4 + (cj & 3);
        float s = 0.f;
#pragma unroll
        for (int w = 0; w < 8; ++w) s += red[w * 512 + idx];
        E(row, 16 * unit + cj, s);
        __syncthreads();
    }
}
struct EpiS1 { float* ZS; const float* SSQ0; __device__ __forceinline__ void operator()(int row, int col, float v) const { ZS[row * INC + win_logical_col(col)] = v * rsqrtf(SSQ0[MP + row] * (1.0f / DM) + EPS); } };
struct EpiS3 { const float* xs; float* Y; bf16* X1G; const float* gm; float* SSQ;
    __device__ __forceinline__ void operator()(int row, int col, float v) const {
        const float x1 = xs[row * DM + col] + v; X1G[(size_t)(MP + row) * DM + col] = (bf16)f2bf(x1);
        float ss = x1 * x1; ss += __shfl_xor(ss, 1); ss += __shfl_xor(ss, 2); ss += __shfl_xor(ss, 4); ss += __shfl_xor(ss, 8);
        if ((mk_fresh_lane() & 15) == 0) atomicAdd(SSQ + MP + row, ss);
    } };
struct EpiS4 { float* SSQ; bf16* H;
    __device__ __forceinline__ void operator()(int row, int col, float v) const {
        const float rstd = rsqrtf(__hip_atomic_load(SSQ + MP + row, __ATOMIC_RELAXED, __HIP_MEMORY_SCOPE_AGENT) * (1.0f / DM) + EPS);
        float h = fmaxf(v * rstd, 0.f); h *= h; H[(size_t)(MP + row) * FF + col] = (bf16)f2bf(h);
    } };
struct EpiS5 { float* Y; const bf16* X1G; float fac; __device__ __forceinline__ void operator()(int row, int col, float v) const { const size_t o = (size_t)(MP + row) * DM + col; Y[o] = (bf2f((unsigned)X1G[o]) + v) * fac; } };

template <int DEPTH, class Dec>
__device__ __forceinline__ void cvt_items(LAS float* scr, int first, int total, int stride, int lane, const Dec& D) {
    const int r8 = lane >> 3, c4 = lane & 7;
    int it = first; if (it >= total) return;
    const float* src; int N;
    f32x4 v[DEPTH][8]; bf16* dst[DEPTH]; int K[DEPTH];
#pragma unroll
    for (int d = 0; d < DEPTH; ++d) { dst[d] = nullptr; K[d] = 0; }
#pragma unroll
    for (int d = 0; d < DEPTH - 1; ++d)
        if (it + d * stride < total) { D(it + d * stride, src, N, dst[d], K[d]);
#pragma unroll
            for (int i = 0; i < 8; ++i) v[d][i] = __builtin_nontemporal_load((const f32x4*)(src + (size_t)(r8 + 8 * i) * N + 4 * c4)) * D.rowscale(it + d * stride, r8 + 8 * i); }
    for (;;) {
        const int nl = it + (DEPTH - 1) * stride;
        if (nl < total) { D(nl, src, N, dst[DEPTH - 1], K[DEPTH - 1]);
#pragma unroll
            for (int i = 0; i < 8; ++i) v[DEPTH - 1][i] = __builtin_nontemporal_load((const f32x4*)(src + (size_t)(r8 + 8 * i) * N + 4 * c4)) * D.rowscale(nl, r8 + 8 * i); }
#pragma unroll
        for (int i = 0; i < 8; ++i) { LAS float* s = scr + (r8 + 8 * i) * 33 + 4 * c4; s[0] = v[0][i][0]; s[1] = v[0][i][1]; s[2] = v[0][i][2]; s[3] = v[0][i][3]; }
        LDS_WAIT(); asm volatile("" ::: "memory");
        const int c = lane & 7;
#pragma unroll
        for (int j = 0; j < 4; ++j) { const int n = (lane >> 3) + 8 * j; const LAS float* s = scr + (8 * c) * 33 + n;
            v4u o; o.x = pk2(s[0 * 33], s[1 * 33]); o.y = pk2(s[2 * 33], s[3 * 33]); o.z = pk2(s[4 * 33], s[5 * 33]); o.w = pk2(s[6 * 33], s[7 * 33]);
            *(v4u*)(dst[0] + (size_t)n * K[0] + 8 * c) = o; }
        LDS_WAIT(); asm volatile("" ::: "memory");
        it += stride; if (it >= total) break;
#pragma unroll
        for (int d = 0; d < DEPTH - 1; ++d) {
#pragma unroll
            for (int i = 0; i < 8; ++i) v[d][i] = v[d + 1][i];
            dst[d] = dst[d + 1]; K[d] = K[d + 1]; }
    }
}
struct DecP0 { const float* w_in; bf16* WinT; const float* gmix;
    __device__ __forceinline__ float rowscale(int it, int kk) const { return gmix[64 * (it / (INC / 32)) + kk]; }
    __device__ __forceinline__ void operator()(int it, const float*& src, int& N, bf16*& dst, int& K) const {
        const int kb = it / (INC / 32), nb = it % (INC / 32); src = w_in + (size_t)(64 * kb) * INC + 32 * nb; N = INC; K = DM; dst = WinT + (size_t)(32 * win_dst_group(nb)) * DM + 64 * kb;
    } };
struct DecUp { const float *w_up, *w_out; bf16 *WupT, *WoutT; const float* gm;
    __device__ __forceinline__ float rowscale(int it, int kk) const { constexpr int I_UP = (DM / 64) * (FF / 32); return it < I_UP ? gm[64 * (it / (FF / 32)) + kk] : 1.0f; }
    __device__ __forceinline__ void operator()(int it, const float*& src, int& N, bf16*& dst, int& K) const {
        constexpr int I_UP = (DM / 64) * (FF / 32);
        if (it < I_UP) { const int kb = it / (FF / 32), nb = it % (FF / 32); src = w_up + (size_t)(64 * kb) * FF + 32 * nb; N = FF; K = DM; dst = WupT + (size_t)(32 * nb) * DM + 64 * kb; }
        else { const int r = it - I_UP, kb = r / (DM / 32), nb = r % (DM / 32); src = w_out + (size_t)(64 * kb) * DM + 32 * nb; N = DM; K = DM; dst = WoutT + (size_t)(32 * nb) * DM + 64 * kb; }
    } };
struct DecDn { const float* w_down; bf16* WdnT;
    __device__ __forceinline__ float rowscale(int, int) const { return 1.0f; }
    __device__ __forceinline__ void operator()(int it, const float*& src, int& N, bf16*& dst, int& K) const {
        const int kb = it / (DM / 32), nb = it % (DM / 32); src = w_down + (size_t)(64 * kb) * DM + 32 * nb; N = DM; K = FF; dst = WdnT + (size_t)(32 * nb) * FF + 64 * kb;
    } };
__device__ __forceinline__ void row_to_bf16(const float* xrow, bf16* orow, float* ssq, int lane) {
    const f32x4* xr = (const f32x4*)xrow + lane;
    f32x4 v[8]; float s = 0.f;
#pragma unroll
    for (int j = 0; j < 8; ++j) { v[j] = __builtin_nontemporal_load(xr + 64 * j); s += dot4(v[j], v[j]); }
    v2u* o8 = (v2u*)orow + lane;
#pragma unroll
    for (int j = 0; j < 8; ++j) { v2u w; w.x = pk2(v[j][0], v[j][1]); w.y = pk2(v[j][2], v[j][3]); o8[64 * j] = w; }
    s = wave_sum(s);
    if (lane == 0) *ssq = s;
}

constexpr int KS_STRIDE = 72, VT_STRIDE = 276, KS_BYTES = 272 * KS_STRIDE * 2, VT_BYTES = 64 * VT_STRIDE * 2;
__device__ __forceinline__ void attn_unit(LAS unsigned char* lds, int b, int nb, int kh, const bf16* Q, const bf16* Kb, const bf16* Vb, bf16* MIX, const float* sinks,
                                          int tid, int wave, int lane) {
    LAS bf16* Ks = (LAS bf16*)lds; LAS bf16* Vt = (LAS bf16*)(lds + KS_BYTES);
    const int fr = lane & 15, fq = lane >> 4;
#pragma unroll
    for (int p = 0; p < 4; ++p) {
        const int idx = p * 512 + tid, key = idx >> 3, c = idx & 7, s = 128 * (nb - 1) + key;
        v4u kv = {0u, 0u, 0u, 0u}, vv = {0u, 0u, 0u, 0u};
        if (s >= 0) { const size_t off = (size_t)(b * SEQ + s) * 256 + 64 * kh + 8 * c; kv = *(const v4u*)(Kb + off); vv = *(const v4u*)(Vb + off); }
        *(LAS v4u*)(Ks + key * KS_STRIDE + 8 * c) = kv;
        LAS bf16* vp = Vt + (8 * c) * VT_STRIDE + key;
        vp[0 * VT_STRIDE] = (bf16)(vv.x & 0xffffu); vp[1 * VT_STRIDE] = (bf16)(vv.x >> 16); vp[2 * VT_STRIDE] = (bf16)(vv.y & 0xffffu); vp[3 * VT_STRIDE] = (bf16)(vv.y >> 16);
        vp[4 * VT_STRIDE] = (bf16)(vv.z & 0xffffu); vp[5 * VT_STRIDE] = (bf16)(vv.z >> 16); vp[6 * VT_STRIDE] = (bf16)(vv.w & 0xffffu); vp[7 * VT_STRIDE] = (bf16)(vv.w >> 16);
    }
    if (tid < 144) *(LAS v4u*)(Ks + 256 * KS_STRIDE + tid * 8) = (v4u){0u, 0u, 0u, 0u};
    for (int i = tid; i < 64 * 20; i += 512) Vt[(i / 20) * VT_STRIDE + 256 + (i % 20)] = 0;
    const int g = wave >> 1, h = 4 * kh + g; const float sink = sinks[h];
    bf16x8 qall[4][2];
#pragma unroll
    for (int qi = 0; qi < 4; ++qi) { const size_t r = (size_t)b * SEQ + 128 * nb + 16 * (4 * (wave & 1) + qi) + fr;
        qall[qi][0] = *(const bf16x8*)(Q + r * 1024 + 64 * h + 8 * fq); qall[qi][1] = *(const bf16x8*)(Q + r * 1024 + 64 * h + 32 + 8 * fq); }
    __syncthreads();
#pragma unroll
    for (int qi = 0; qi < 4; ++qi) {
        const int qt = 4 * (wave & 1) + qi, i0 = 16 * qt;
        const size_t r = (size_t)b * SEQ + 128 * nb + i0 + fr;
        bf16x8 qf[2];
        qf[0] = qall[qi][0]; qf[1] = qall[qi][1];
        f32x4 S[10];
#pragma unroll
        for (int t = 0; t < 10; ++t) {
            S[t] = (f32x4){0.f, 0.f, 0.f, 0.f};
#pragma unroll
            for (int ks = 0; ks < 2; ++ks) {
                const bf16x8 kf = *(const LAS bf16x8*)(Ks + (16 * (qt + t) + fr) * KS_STRIDE + 32 * ks + 8 * fq);
                S[t] = __builtin_amdgcn_mfma_f32_16x16x32_bf16(kf, qf[ks], S[t], 0, 0, 0);
            }
        }
        float mx = sink;
#pragma unroll
        for (int t = 0; t < 10; ++t)
#pragma unroll
            for (int j = 0; j < 4; ++j) {
                const int rel = 16 * t + 4 * fq + j - fr;
                const bool ok = rel >= 1 && rel <= 128 && (nb > 0 || (i0 + 16 * t + 4 * fq + j) >= 128);
                S[t][j] = ok ? S[t][j] : -1e30f; mx = fmaxf(mx, S[t][j]);
            }
        mx = fmaxf(mx, __shfl_xor(mx, 16)); mx = fmaxf(mx, __shfl_xor(mx, 32));
        float sum = 0.f;
#pragma unroll
        for (int t = 0; t < 10; ++t)
#pragma unroll
            for (int j = 0; j < 4; ++j) { S[t][j] = __expf(S[t][j] - mx); sum += S[t][j]; }
        sum += __shfl_xor(sum, 16); sum += __shfl_xor(sum, 32); sum += __expf(sink - mx);
        const float inv = 1.0f / sum;
        f32x4 O[4];
#pragma unroll
        for (int dt = 0; dt < 4; ++dt) O[dt] = (f32x4){0.f, 0.f, 0.f, 0.f};
#pragma unroll
        for (int k2 = 0; k2 < 5; ++k2) {
            v4u pw; pw.x = pk2(S[2 * k2][0], S[2 * k2][1]); pw.y = pk2(S[2 * k2][2], S[2 * k2][3]); pw.z = pk2(S[2 * k2 + 1][0], S[2 * k2 + 1][1]); pw.w = pk2(S[2 * k2 + 1][2], S[2 * k2 + 1][3]);
            const bf16x8 pf = __builtin_bit_cast(bf16x8, pw);
#pragma unroll
            for (int dt = 0; dt < 4; ++dt) {
                const LAS bf16* vp = Vt + (16 * dt + fr) * VT_STRIDE + 16 * (qt + 2 * k2) + 4 * fq;
                const v2u lo = *(const LAS v2u*)vp, hi = *(const LAS v2u*)(vp + 16);
                v4u vw; vw.x = lo.x; vw.y = lo.y; vw.z = hi.x; vw.w = hi.y;
                O[dt] = __builtin_amdgcn_mfma_f32_16x16x32_bf16(__builtin_bit_cast(bf16x8, vw), pf, O[dt], 0, 0, 0);
            }
        }
#pragma unroll
        for (int dt = 0; dt < 4; ++dt) {
            v2u w; w.x = pk2(O[dt][0] * inv, O[dt][1] * inv); w.y = pk2(O[dt][2] * inv, O[dt][3] * inv);
            *(v2u*)(MIX + r * DM + 64 * h + 16 * dt + 4 * fq) = w;
        }
    }
    __syncthreads();
}

constexpr int PF_LDS_OFF = 132096;
__device__ __forceinline__ void glds16_pf(const void* gsrc, unsigned lds_dst) { unsigned keep;
    asm volatile("s_mov_b32 %0, m0\n\ts_mov_b32 m0, %2\n\ts_nop 0\n\tglobal_load_lds_dwordx4 %1, off\n\ts_mov_b32 m0, %0" : "=&s"(keep) : "v"(gsrc), "s"(lds_dst) : "memory"); }
__device__ __forceinline__ void conv_unit(LAS unsigned char* lds, int b, int tb, const bf16* U, bf16* MIX, const float* cw, const float* cb, const float* lg, const float* lb,
                                          const float* xpre, int tid, int wave, int lane) {
    LAS unsigned* tile = (LAS unsigned*)lds;
    LAS float* red = (LAS float*)(lds + 62 * 2048);
    LAS float* fin = red + 512;
    const int s0 = 32 * tb;
    {   const int row0 = tid >> 7, c16 = tid & 127;
        const bf16* up = U + ((size_t)b * SEQ + s0 - 30 + row0) * 1024 + 8 * c16;
#pragma unroll
        for (int h8 = 0; h8 < 2; ++h8) {
            v4u tv[8];
#pragma unroll
            for (int t = 0; t < 8; ++t) { const int row = row0 + 4 * (8 * h8 + t);
                tv[t] = (v4u){0u, 0u, 0u, 0u};
                if (row < 62 && s0 - 30 + row >= 0) tv[t] = *(const v4u*)(up + (size_t)(4 * (8 * h8 + t)) * 1024); }
#pragma unroll
            for (int t = 0; t < 8; ++t) { const int row = row0 + 4 * (8 * h8 + t);
                if (row < 62) *(LAS v4u*)(tile + row * 512 + 4 * c16) = tv[t]; }
            asm volatile("" ::: "memory");
        }
    }
    __syncthreads();
    f32x2 w[31];
#pragma unroll
    for (int j = 0; j < 31; ++j) w[j] = *(const f32x2*)(cw + j * 1024 + 2 * tid);
    const f32x2 bias = *(const f32x2*)(cb + 2 * tid);
    const f32x2 g = *(const f32x2*)(lg + 2 * tid), be = *(const f32x2*)(lb + 2 * tid);
#pragma unroll 1
    for (int ck = 0; ck < 4; ++ck) {
        f32x2 c[8];
#pragma unroll
        for (int o = 0; o < 8; ++o) c[o] = bias;
#pragma unroll
        for (int rr = 0; rr < 38; ++rr) {
            const unsigned pv = tile[(8 * ck + rr) * 512 + tid];
            const f32x2 v = {bf2f(pv & 0xffffu), bf2f(pv >> 16)};
#pragma unroll
            for (int o = 0; o < 8; ++o) { const int j = rr - o; if (j >= 0 && j <= 30) c[o] = c[o] + w[j] * v; }
            if ((rr & 7) == 7) asm volatile("" ::: "memory");
        }
#pragma unroll
        for (int o = 0; o < 8; ++o) {
            const f32x2 x = c[o];
            const float s1 = wave_sum(x[0] + x[1]), s2 = wave_sum(x[0] * x[0] + x[1] * x[1]);
            if (lane == 0) { red[(wave * 8 + o) * 2] = s1; red[(wave * 8 + o) * 2 + 1] = s2; }
        }
        asm volatile("s_waitcnt lgkmcnt(0)\n\ts_barrier" ::: "memory");
        if (tid < 16) { float s = 0.f;
#pragma unroll
            for (int wv = 0; wv < 8; ++wv) s += red[wv * 16 + tid];
            fin[tid] = s; }
        asm volatile("s_waitcnt lgkmcnt(0)\n\ts_barrier" ::: "memory");
#pragma unroll
        for (int t = 0; t < 8; ++t) {
            const float mean = fin[2 * t] * (1.0f / CCH), var = fin[2 * t + 1] * (1.0f / CCH) - mean * mean, rstd = rsqrtf(fmaxf(var, 0.f) + EPS);
            const f32x2 y = (c[t] - mean) * rstd * g + be;
            const float o0 = y[0] * sigmoidf_(y[0]), o1 = y[1] * sigmoidf_(y[1]);
            *(unsigned*)(MIX + (size_t)(b * SEQ + s0 + 8 * ck + t) * DM + 1024 + 2 * tid) = pk2(o0, o1);
        }
        if (ck == 0 && xpre) {
            const float* xr = xpre + (size_t)(wave * 32) * DM + lane * 4;
#pragma unroll 8
            for (int i = 0; i < 32; ++i) glds16_pf(xr + (size_t)i * DM, (unsigned)(PF_LDS_OFF + wave * 1024));
        }
    }
    asm volatile("s_waitcnt lgkmcnt(0)\n\ts_barrier" ::: "memory");
}

__device__ __forceinline__ void sample_att(LAS unsigned char* lds, int b, const float* ZS, const float* cache_k, const float* cache_v, const float* state,
                                             const float* gq, const float* gk, const float* sinks, const float* cw, const float* cb, const float* lg, const float* lb,
                                             const float* cosT, const float* sinT, float* out, bf16* MIX, int tid, int wave, int lane) {
    LAS float* zs = (LAS float*)lds;
    LAS float* qs = zs + 3584;
    LAS float* kn = qs + 1024;
    LAS float* vn = kn + 256;
    LAS float* sc = vn + 256;
    LAS float* rd = sc + 2048;
    LAS float* part = rd + 16;
    for (int i = tid; i < INC; i += 512) zs[i] = ZS[b * INC + i];
    __syncthreads();
    for (int hh = wave; hh < 20; hh += 8) {
        const int base = hh < 16 ? 64 * hh : 1024 + 64 * (hh - 16);
        const float x = zs[base + lane];
        const float rstd = rsqrtf(wave_sum(x * x) * (1.0f / 64.0f) + EPS);
        const float y = x * rstd * (hh < 16 ? gq : gk)[lane];
        const float p = __shfl_xor(y, 32);
        const float co = cosT[2048 * 32 + (lane & 31)], si = sinT[2048 * 32 + (lane & 31)];
        const float o = lane < 32 ? y * co - p * si : y * co + p * si;
        if (hh < 16) qs[hh * 64 + lane] = o * 0.125f;
        else { kn[(hh - 16) * 64 + lane] = o; out[O_KS + ((size_t)(b * 128 + 127) * 4 + (hh - 16)) * 64 + lane] = o; }
    }
    if (tid < 256) { const float vv = zs[1280 + tid]; vn[tid] = vv; out[O_VS + (size_t)(b * 128 + 127) * 256 + tid] = vv; }
    __syncthreads();
    {
        const int jj = tid >> 2, kh = tid & 3, j = jj + 1;
        float d0 = 0.f, d1 = 0.f, d2 = 0.f, d3 = 0.f;
        const LAS float* q0 = qs + (4 * kh) * 64;
        if (j < 128) {
            const f32x4* kr = (const f32x4*)(cache_k + ((size_t)(b * 128 + j) * 4 + kh) * 64);
#pragma unroll
            for (int d4 = 0; d4 < 16; ++d4) { const f32x4 kv = kr[d4];
                d0 += dot4(kv, *(const LAS f32x4*)(q0 + 4 * d4)); d1 += dot4(kv, *(const LAS f32x4*)(q0 + 64 + 4 * d4));
                d2 += dot4(kv, *(const LAS f32x4*)(q0 + 128 + 4 * d4)); d3 += dot4(kv, *(const LAS f32x4*)(q0 + 192 + 4 * d4)); }
        } else {
#pragma unroll 4
            for (int d4 = 0; d4 < 16; ++d4) { const f32x4 kv = *(const LAS f32x4*)(kn + kh * 64 + 4 * d4);
                d0 += dot4(kv, *(const LAS f32x4*)(q0 + 4 * d4)); d1 += dot4(kv, *(const LAS f32x4*)(q0 + 64 + 4 * d4));
                d2 += dot4(kv, *(const LAS f32x4*)(q0 + 128 + 4 * d4)); d3 += dot4(kv, *(const LAS f32x4*)(q0 + 192 + 4 * d4)); }
        }
        sc[(4 * kh + 0) * 128 + jj] = d0; sc[(4 * kh + 1) * 128 + jj] = d1; sc[(4 * kh + 2) * 128 + jj] = d2; sc[(4 * kh + 3) * 128 + jj] = d3;
    }
    __syncthreads();
    for (int h = 2 * wave; h < 2 * wave + 2; ++h) {
        const float a = sc[h * 128 + lane], c2 = sc[h * 128 + 64 + lane], sink = sinks[h];
        const float m = fmaxf(wave_max(fmaxf(a, c2)), sink);
        const float pa = __expf(a - m), pb = __expf(c2 - m);
        const float den = wave_sum(pa + pb) + __expf(sink - m), inv = 1.0f / den;
        sc[h * 128 + lane] = pa * inv; sc[h * 128 + 64 + lane] = pb * inv;
    }
    __syncthreads();
    {
        const int d = tid & 63, kg = wave;
#pragma unroll 1
        for (int kh = 0; kh < 4; ++kh) {
            float vv[16];
#pragma unroll
            for (int t = 0; t < 16; ++t) { const int jj = 16 * kg + t;
                vv[t] = (jj < 127) ? cache_v[((size_t)(b * 128 + jj + 1) * 4 + kh) * 64 + d] : vn[kh * 64 + d]; }
            float a0 = 0.f, a1 = 0.f, a2 = 0.f, a3 = 0.f;
            const LAS float* sp = sc + (4 * kh) * 128 + 16 * kg;
#pragma unroll
            for (int t = 0; t < 16; ++t) { a0 += sp[t] * vv[t]; a1 += sp[128 + t] * vv[t]; a2 += sp[256 + t] * vv[t]; a3 += sp[384 + t] * vv[t]; }
            LAS float* pp = part + (kg * 16 + 4 * kh) * 64 + d;
            pp[0] = a0; pp[64] = a1; pp[128] = a2; pp[192] = a3;
        }
        __syncthreads();
#pragma unroll
        for (int hi = 0; hi < 2; ++hi) {
            const int h = (tid >> 6) + 8 * hi; float o = 0.f;
#pragma unroll
            for (int k8 = 0; k8 < 8; ++k8) o += part[(k8 * 16 + h) * 64 + d];
            MIX[(size_t)(MP + b) * DM + 64 * h + d] = (bf16)f2bf(o);
        }
    }
    __syncthreads();
}
__device__ __forceinline__ void sample_conv(LAS unsigned char* lds, int b, const float* ZS, const float* cache_k, const float* cache_v, const float* state,
                                             const float* gq, const float* gk, const float* sinks, const float* cw, const float* cb, const float* lg, const float* lb,
                                             const float* cosT, const float* sinT, float* out, bf16* MIX, int tid, int wave, int lane) {
    LAS float* zs = (LAS float*)lds;
    LAS float* qs = zs + 3584;
    LAS float* kn = qs + 1024;
    LAS float* vn = kn + 256;
    LAS float* sc = vn + 256;
    LAS float* rd = sc + 2048;
    LAS float* part = rd + 16;
    for (int i = 1536 + tid; i < INC; i += 512) zs[i] = ZS[b * INC + i];
    __syncthreads();
    {
        const int ch = 2 * tid;
        const float u0 = zs[1536 + ch] * sigmoidf_(zs[2560 + ch]), u1 = zs[1536 + ch + 1] * sigmoidf_(zs[2560 + ch + 1]);
        *(f32x2*)(out + O_CS + (size_t)(b * 30 + 29) * 1024 + ch) = (f32x2){u0, u1};
        f32x2 c = *(const f32x2*)(cb + ch);
#pragma unroll 10
        for (int j = 0; j < 30; ++j) c = c + *(const f32x2*)(cw + j * 1024 + ch) * *(const f32x2*)(state + (size_t)(b * 30 + j) * 1024 + ch);
        c = c + *(const f32x2*)(cw + 30 * 1024 + ch) * (f32x2){u0, u1};
        const float s1 = wave_sum(c[0] + c[1]), s2 = wave_sum(c[0] * c[0] + c[1] * c[1]);
        if (lane == 0) { rd[wave * 2] = s1; rd[wave * 2 + 1] = s2; }
        __syncthreads();
        float t1 = 0.f, t2 = 0.f;
#pragma unroll
        for (int wv = 0; wv < 8; ++wv) { t1 += rd[wv * 2]; t2 += rd[wv * 2 + 1]; }
        const float mean = t1 * (1.0f / CCH), var = t2 * (1.0f / CCH) - mean * mean, rstd = rsqrtf(fmaxf(var, 0.f) + EPS);
        const f32x2 y = (c - mean) * rstd * *(const f32x2*)(lg + ch) + *(const f32x2*)(lb + ch);
        *(unsigned*)(MIX + (size_t)(MP + b) * DM + 1024 + ch) = pk2(y[0] * sigmoidf_(y[0]), y[1] * sigmoidf_(y[1]));
    }
    __syncthreads();
}

#ifndef MK_DUP
#define MK_DUP (-1)
#endif
#define REPS(k)
#ifndef MK_CG_SEAMS
#define MK_CG_SEAMS 0
#endif
#define P2_CVT() do { const DecDn D{w_down, WdnT}; cvt_items<3>((LAS float*)(lds + wave * 16384), bx * NWAVES + wave, (FF / 64) * (DM / 32), ncv * NWAVES, lane, D); \
                const int gt = bx * (NWAVES * 64) + tid, NT = ncv * NWAVES * 64;        \
                for (int i = gt; i < 32 * 8128; i += NT) { const int b = i / 8128, o = i % 8128; \
                    ((f32x4*)(out + O_KS + (size_t)b * 32768))[o] = ((const f32x4*)(cache_k + (size_t)b * 32768 + 256))[o]; \
                    ((f32x4*)(out + O_VS + (size_t)b * 32768))[o] = ((const f32x4*)(cache_v + (size_t)b * 32768 + 256))[o]; } \
                for (int i = gt; i < 32 * 7424; i += NT) { const int b = i / 7424, o = i % 7424; \
                    ((f32x4*)(out + O_CS + (size_t)b * 30720))[o] = ((const f32x4*)(state + (size_t)b * 30720 + 1024))[o]; } } while (0)
struct Args { const float* in[18]; float* out; unsigned char* ws; int ph_lo, ph_hi, dry, pad; };
__global__ void __launch_bounds__(NWAVES * 64, 2) mk_fwd(Args args) {
    extern __shared__ __attribute__((aligned(16))) unsigned char lds_raw[];
    LAS unsigned char* lds = (LAS unsigned char*)lds_raw;
    const int wave_k = __builtin_amdgcn_readfirstlane((int)threadIdx.x >> 6);
    const int tid = wave_k * 64 + mk_fresh_lane();
    const int G = gridDim.x, bx = blockIdx.x;
    const int vcu = (G % 8 == 0) ? (bx % 8) * (G / 8) + bx / 8 : bx;
    unsigned char* ws = args.ws;
    const float *xp = args.in[0], *xs = args.in[1], *cache_k = args.in[2], *cache_v = args.in[3], *state = args.in[4], *g_mix = args.in[5], *w_in = args.in[6],
                *gq = args.in[7], *gk = args.in[8], *sinks = args.in[9], *conv_w = args.in[10], *conv_b = args.in[11], *ln_g = args.in[12], *ln_b = args.in[13],
                *w_out = args.in[14], *g_mlp = args.in[15], *w_up = args.in[16], *w_down = args.in[17];
    float* out = args.out;
    float* SSQ = (float*)(ws + WS_SSQ); float* SSQ0 = (float*)(ws + WS_SSQ0); float* cosT = (float*)(ws + WS_COS); float* sinT = (float*)(ws + WS_SIN); float* ZS = (float*)(ws + WS_ZS);
    bf16 *WinT = (bf16*)(ws + WS_WIN), *WoutT = (bf16*)(ws + WS_WOUT), *WupT = (bf16*)(ws + WS_WUP), *WdnT = (bf16*)(ws + WS_WDN);
    bf16 *X1G = (bf16*)(ws + WS_X1G), *HID = (bf16*)(ws + WS_HID), *XN = (bf16*)(ws + WS_XN), *Qb = (bf16*)(ws + WS_Q), *Kb = (bf16*)(ws + WS_K), *Vb = (bf16*)(ws + WS_V),
         *Ub = (bf16*)(ws + WS_U), *MIX = (bf16*)(ws + WS_MIX);
    for (int u = tid; u < (LDS_BYTES - LDSCTL_OFF) / 4; u += NWAVES * 64) ((LAS unsigned*)(lds + LDSCTL_OFF))[u] = 0u;
    __syncthreads();
    volatile LAS unsigned* MISC = (volatile LAS unsigned*)(lds + MISC_OFF);
    XcdBarrier bar; bar.bar = (unsigned*)(ws + WS_CTL) + CW_BAR; bar.x = 0; bar.st = nullptr;
    if (MK_N_LAUNCHES == 1) bar = xcd_barrier_post((unsigned*)(ws + WS_CTL) + CW_BAR, MISC + 8);
#define GRID_BAR(seam) do { if (MK_N_LAUNCHES == 1) { if ((MK_CG_SEAMS >> (seam)) & 1) cg::this_grid().sync(); else xcd_barrier(bar); } STAMP((seam) + 1); } while (0)
#define FRESH_IDS() const int wave = wave_k; int tid = wave * 64 + mk_fresh_lane(); asm volatile("" : "+v"(tid)); const int lane = tid & 63; (void)lane
#ifdef MK_TA
    unsigned long long* TS = (unsigned long long*)(ws + WS_SSQ + 128 * 1024);
#define STAMP(k) do { if (bx == G - 1 && tid == 0) TS[k] = __builtin_amdgcn_s_memrealtime(); } while (0)
#else
#define STAMP(k) do { } while (0)
#endif
    STAMP(0);
    const int lo = args.ph_lo, hi = args.ph_hi;
#ifndef MK_PLAIN
    if (args.pad == 0x5eed) cg::this_grid().sync();
#endif
#define IN(k) (lo <= (k) && (k) < hi)

    if (IN(0)) { REPS(0) {
        FRESH_IDS();
        LAS float* scr = (LAS float*)(lds + wave * 16384);
        const int gw = vcu * NWAVES + wave, NGW = G * NWAVES;
        { const DecP0 D{w_in, WinT, g_mix}; cvt_items<3>(scr, gw, (DM / 64) * (INC / 32), NGW, lane, D); }
        for (int m = gw; m < MT; m += NGW) row_to_bf16(m < MP ? xp + (size_t)m * DM : xs + (size_t)(m - MP) * DM, XN + (size_t)m * DM, SSQ0 + m, lane);
        const int gt = vcu * (NWAVES * 64) + tid, NT = G * NWAVES * 64;
        for (int i = gt; i < 2049 * 32; i += NT) {
            const int pos = i >> 5, k = i & 31; double inv = 1.0;
            for (int j = 0; j < k; ++j) inv *= 0.7498942093324559;
            const float ang = (pos == 2048 ? 16384.0f : (float)pos) * (float)inv;
            double rev = (double)ang * 0.15915494309189535; rev -= __builtin_rint(rev);
            const float rf = (float)rev;
            cosT[i] = __builtin_amdgcn_cosf(rf); sinT[i] = __builtin_amdgcn_sinf(rf);
        }
        }
        if (IN(1)) GRID_BAR(0);
    }
    if (IN(1)) { REPS(1) {
        const int nun = (MP / 256) * (INC / 256), rounds = (nun + G - 1) / G, GG = (nun + rounds - 1) / rounds, nsv = G - GG;
        if (bx < GG) {
            pg8::Gemm g{XN, WinT, MP, INC, DM}; pg8::StaticOrder S; S.init(MP, INC, GG, bx);
            Epi1 E{Qb, Kb, Vb, Ub, out, gq, gk, cosT, sinT, SSQ0};
            pg8::gemm_phase<Epi1, pg8::StaticOrder, true, true>(lds, g, S, E, wave_k);
        }
        FRESH_IDS();
        STAMP(9);
        EpiS1 ES{ZS, SSQ0};
        skinny_phase(lds, XN + (size_t)MP * DM, WinT, INC, DM, bx, G, ES, wave_k);
        {   const DecUp D{w_up, w_out, WupT, WoutT, g_mlp}; constexpr int NIT = (DM / 64) * (FF / 32) + (DM / 64) * (DM / 32);
            if (nsv > 0) { if (bx >= GG) cvt_items<5>((LAS float*)(lds + wave * 16384), (bx - GG) * NWAVES + wave, NIT, nsv * NWAVES, lane, D); }
            else cvt_items<5>((LAS float*)(lds + wave * 16384), bx * NWAVES + wave, NIT, G * NWAVES, lane, D);
        }
        }
        STAMP(12);
        if (IN(2)) GRID_BAR(1);
    }
    if (IN(2)) { REPS(2) {
        FRESH_IDS();
        const int ncv = G > 2 * MS ? G - 2 * MS : G;
        const bool cvt_first = bx < ncv && ((bx >> 3) & 1);
        if (cvt_first) { P2_CVT(); __syncthreads(); }
        for (int a = bx; a < 256; a += G) attn_unit(lds, a >> 6, (a >> 2) & 15, a & 3, Qb, Kb, Vb, MIX, sinks, tid, wave, lane);
        STAMP(6);
        for (int c = bx; c < 256; c += G) conv_unit(lds, c >> 6, c & 63, Ub, MIX, conv_w, conv_b, ln_g, ln_b, nullptr, tid, wave, lane);
        STAMP(7);
        if (bx < ncv && !cvt_first) { P2_CVT(); __syncthreads(); }
        for (int j = G - 1 - bx; j < 2 * MS; j += G) {
            if (j < MS) sample_att(lds, j, ZS, cache_k, cache_v, state, gq, gk, sinks, conv_w, conv_b, ln_g, ln_b, cosT, sinT, out, MIX, tid, wave, lane);
            else sample_conv(lds, j - MS, ZS, cache_k, cache_v, state, gq, gk, sinks, conv_w, conv_b, ln_g, ln_b, cosT, sinT, out, MIX, tid, wave, lane);
        }
        }
        STAMP(11);
        if (IN(3)) GRID_BAR(2);
    }
    if (IN(3)) {
        pg8::Gemm g{MIX, WoutT, MP, DM, DM}; pg8::StaticOrder S; S.init(MP, DM, G, bx);
        Epi3 E{XN, out + O_YP, X1G, g_mlp, args.dry ? SSQ + 16384 : SSQ};
        pg8::gemm_phase<Epi3, pg8::StaticOrder, true, true>(lds, g, S, E, wave_k);
        STAMP(13);
        EpiS3 ES{xs, out + O_YP, X1G, g_mlp, args.dry ? SSQ + 16384 : SSQ};
        skinny_phase(lds, MIX + (size_t)MP * DM, WoutT, DM, DM, G - 1 - bx, G, ES, wave_k);
        if (IN(4)) GRID_BAR(3);
    }
    if (IN(4)) { REPS(4) {
        pg8::Gemm g{X1G, WupT, MP, FF, DM}; pg8::StaticOrder S; S.init(MP, FF, G, bx);
        Epi4 E{SSQ, HID};
        EpiS4 ES{SSQ, HID};
        if (bx & 1) skinny_phase(lds, X1G + (size_t)MP * DM, WupT, FF, DM, G - 1 - bx, G, ES, wave_k);
        pg8::gemm_phase<Epi4, pg8::StaticOrder, true, true>(lds, g, S, E, wave_k);
        if (!(bx & 1)) skinny_phase(lds, X1G + (size_t)MP * DM, WupT, FF, DM, G - 1 - bx, G, ES, wave_k);
        }
        if (IN(5)) GRID_BAR(4);
    }
    if (IN(5)) {
        pg8::Gemm g{HID, WdnT, MP, DM, FF}; pg8::StaticOrder S; S.init(MP, DM, G, bx);
        Epi5 E{out + O_YP, X1G};
        pg8::gemm_phase<Epi5, pg8::StaticOrder, true, true>(lds, g, S, E, wave_k);
#ifdef MK_TA
        STAMP(8); __syncthreads();
        EpiS5 ES{out + O_YP, X1G, bx == G - 1 ? 1.0f + 1e-4f * (float)(long long)(__hip_atomic_load(TS + MK_TB, __ATOMIC_RELAXED, __HIP_MEMORY_SCOPE_AGENT) - __hip_atomic_load(TS + MK_TA, __ATOMIC_RELAXED, __HIP_MEMORY_SCOPE_AGENT)) : 1.0f};
#else
        EpiS5 ES{out + O_YP, X1G, 1.0f};
#endif
        skinny_phase(lds, HID + (size_t)MP * FF, WdnT, DM, FF, G - 1 - bx, G, ES, wave_k);
    }
#undef IN
}

extern "C" void kernel_launch(void* const* d_in, const int* in_sizes, int n_in, void* d_out, int out_size, void* d_ws, size_t ws_size, hipStream_t stream) {
    static int grid = 0;
    if (grid == 0) {
        if (n_in != 18 || (size_t)out_size != O_END || ws_size < WS_END) { fprintf(stderr, "kernel_launch: unexpected shapes: n_in %d out %d ws %zu\n", n_in, out_size, ws_size); grid = -1; return; }
        int dev = 0, cus = 0, per_cu = 0;
        if (hipGetDevice(&dev) != hipSuccess || hipDeviceGetAttribute(&cus, hipDeviceAttributeMultiprocessorCount, dev) != hipSuccess) { grid = -1; return; }
        if (hipFuncSetAttribute((const void*)mk_fwd, hipFuncAttributeMaxDynamicSharedMemorySize, LDS_BYTES) != hipSuccess) { fprintf(stderr, "kernel_launch: hipFuncSetAttribute failed\n"); grid = -1; return; }
        if (hipOccupancyMaxActiveBlocksPerMultiprocessor(&per_cu, (const void*)mk_fwd, NWAVES * 64, LDS_BYTES) != hipSuccess || per_cu < 1) { fprintf(stderr, "kernel_launch: occupancy query says %d\n", per_cu); (void)hipGetLastError(); grid = -1; return; }
        grid = cus;
    }
    if (grid < 0) return;
    (void)hipMemsetAsync((char*)d_ws + WS_CTL, 0, CTL_ZERO_BYTES, stream);
    Args a{};
    for (int i = 0; i < 18; ++i) a.in[i] = (const float*)d_in[i];
    a.out = (float*)d_out; a.ws = (unsigned char*)d_ws;
#if MK_N_LAUNCHES == 1 && defined(MK_PLAIN)
    a.ph_lo = 0; a.ph_hi = 6;
    hipLaunchKernelGGL(mk_fwd, dim3(grid), dim3(NWAVES * 64), LDS_BYTES, stream, a);
#elif MK_N_LAUNCHES == 1
    a.ph_lo = 0; a.ph_hi = 6;
    void* params[] = {&a};
    hipError_t e = hipLaunchCooperativeKernel((const void*)mk_fwd, dim3(grid), dim3(NWAVES * 64), params, LDS_BYTES, stream);
    if (e != hipSuccess) fprintf(stderr, "kernel_launch: cooperative launch failed: %s (grid %d)\n", hipGetErrorString(e), grid);
#else
    for (int p = 0; p < 6; ++p) for (int rep = 0; rep < (p == MK_DUP ? 2 : 1); ++rep) { a.ph_lo = p; a.ph_hi = p + 1; a.dry = (p == MK_DUP && rep == 0 && (p == 3 || p == 5)) ? 1 : 0; hipLaunchKernelGGL(mk_fwd, dim3(grid), dim3(NWAVES * 64), LDS_BYTES, stream, a); }
#endif
}
```

```cpp
#include <hip/hip_runtime.h>
#include <hip/hip_cooperative_groups.h>
#include <cstdio>
#include <cstdint>
namespace cg = cooperative_groups;
__device__ __forceinline__ int mk_fresh_lane() { int l; asm volatile("v_mbcnt_lo_u32_b32 %0, -1, 0\n\tv_mbcnt_hi_u32_b32 %0, -1, %0" : "=v"(l)); return l; }
#define MK_PLAIN 1
#define MK_N_LAUNCHES 1
namespace pg8 {
#define PG8_LAS __attribute__((address_space(3)))
typedef unsigned short bf16_t;
typedef short bf16x8 __attribute__((ext_vector_type(8)));
typedef float f32x4 __attribute__((ext_vector_type(4)));
typedef unsigned u32x4 __attribute__((ext_vector_type(4)));
constexpr int BM = 256, BK = 64, HALF = 128, HTB = HALF * BK * 2  , STAGE_BYTES = 8 * HTB, NXCD = 8, WGM = 8;

__host__ __device__ __forceinline__ int lds_byte(int r, int c) { const int st = (r >> 4) * 2 + (c >> 5), rr = r & 15, cc = c & 31, ob = rr * 64 + cc * 2; return st * 1024 + (ob ^ (((ob >> 9) & 1) << 5)); }
__host__ __device__ __forceinline__ void stage_rc(int b, int& R, int& C) { const int st = b / 1024, sb = b % 1024, swz = sb ^ (((sb >> 9) & 1) << 5); R = (st >> 1) * 16 + swz / 64; C = (st & 1) * 32 + (swz % 64) / 2; }
__host__ __device__ __forceinline__ int perm32(int rho) { const int n = rho >> 4, i = rho & 15; return 8 * (i >> 2) + 4 * n + (i & 3); }

struct Unit { int pm, pn; };
struct Gemm { const bf16_t* A; const bf16_t* Bt; int M, N, K; };

struct StaticOrder {
    int nM, nN, nwg, G, c;
    __host__ __device__ void init(int M, int N, int G_, int c_) { nM = M / BM; nN = N / BM; nwg = nM * nN; G = G_; c = c_; }
    __host__ __device__ bool next(int i, Unit& u) const {
        const long L = (long)i * G + c; if (L >= nwg) return false;
        int wgid = (int)L; { const int q = nwg / NXCD, r = nwg % NXCD, xcd = wgid % NXCD, off = wgid / NXCD; wgid = (xcd < r ? xcd * (q + 1) : r * (q + 1) + (xcd - r) * q) + off; }
        const int nig = WGM * nN, gid = wgid / nig, fm = gid * WGM, gsz = (nM - fm) < WGM ? (nM - fm) : WGM;
        u.pm = fm + ((wgid % nig) % gsz); u.pn = (wgid % nig) / gsz; return true;
    }
    __device__ __forceinline__ void a_ready(const Unit&) const {}
    __device__ __forceinline__ void done(const Unit&) const {}
};

__device__ __forceinline__ unsigned cvt_pk_bf16(float lo, float hi) { unsigned r; asm volatile("v_cvt_pk_bf16_f32 %0, %1, %2" : "=v"(r) : "v"(lo), "v"(hi)); return r; }
typedef float f32x2 __attribute__((ext_vector_type(2)));
template <class Epi, class Sched, bool ALIGN_EPI = false, bool SP2 = false>
__device__ __forceinline__ void gemm_phase(PG8_LAS unsigned char* lds, const Gemm g, const Sched& S, const Epi& E, const int wid_in) {
    const int wid = wid_in; int tid = wid * 64 + mk_fresh_lane(); asm volatile("" : "+v"(tid));
    const int lane = tid & 63, wr = wid >> 2, wc = wid & 3, fr = lane & 15, fq = lane >> 4;
    const int K = g.K, nt = K / BK;
    unsigned voffA[2], voffB[2];
#pragma unroll
    for (int i = 0; i < 2; ++i) { int R, C; stage_rc(tid * 16 + i * 8192, R, C); const int Rb = Epi::PERM ? ((R & ~31) + perm32(R & 31)) : R;
        voffA[i] = (unsigned)(R * K + C) * 2u; voffB[i] = (unsigned)(Rb * K + C) * 2u; }
    const size_t kstep = (size_t)(BK * 2);
    const size_t hstep = (size_t)HALF * K * 2;
    const size_t tstep = 2 * hstep;
    const unsigned ldsw = (unsigned)wid * 1024u;
    const int aoff = lds_byte(wr * 64 + fr, fq * 8), boff = lds_byte(wc * 32 + fr, fq * 8);
#define PG8_SA(b, h) (((b) * 2 + (h)) * HTB)
#define PG8_SB(b, h) ((4 + (b) * 2 + (h)) * HTB)
#define PG8_STAGE(bufoff, gbase, voff) do { _Pragma("unroll") for (int _i = 0; _i < 2; ++_i) \
        __builtin_amdgcn_global_load_lds((const unsigned*)((const char*)(gbase) + (voff)[_i]), (PG8_LAS unsigned*)(lds + (bufoff) + ldsw + _i * 8192), 16, 0, 0); } while (0)
#define PG8_LDA(dst, b, h) do { _Pragma("unroll") for (int m = 0; m < 4; ++m) _Pragma("unroll") for (int k = 0; k < 2; ++k) dst[m][k] = *(const PG8_LAS bf16x8*)(lds + PG8_SA(b, h) + aoff + m * 2048 + k * 1024); } while (0)
#define PG8_LDB(dst, b, h) do { _Pragma("unroll") for (int n = 0; n < 2; ++n) _Pragma("unroll") for (int k = 0; k < 2; ++k) dst[n][k] = *(const PG8_LAS bf16x8*)(lds + PG8_SB(b, h) + boff + n * 2048 + k * 1024); } while (0)
#define PG8_MMA(ai, bj, At, Bt) do { __builtin_amdgcn_s_setprio(1); _Pragma("unroll") for (int m = 0; m < 4; ++m) _Pragma("unroll") for (int n = 0; n < 2; ++n) _Pragma("unroll") for (int k = 0; k < 2; ++k) \
        acc[ai][bj][m][n] = __builtin_amdgcn_mfma_f32_16x16x32_bf16(Bt[n][k], At[m][k], acc[ai][bj][m][n], 0, 0, 0); __builtin_amdgcn_s_setprio(0); } while (0)
#define PG8_WAIT_V(n) asm volatile("s_waitcnt vmcnt(" #n ")" ::: "memory")
#define PG8_WAIT_L(n) asm volatile("s_waitcnt lgkmcnt(" #n ")" ::: "memory")
#define PG8_BAR __builtin_amdgcn_s_barrier()
#define PG8_SCHED __builtin_amdgcn_sched_barrier(0)
    Unit cur, nxt; int ui = 0;
    if (!S.next(0, cur)) return;
    f32x4 acc[2][2][4][2];
#pragma unroll
    for (int a = 0; a < 2; ++a)
#pragma unroll
        for (int b = 0; b < 2; ++b)
#pragma unroll
            for (int m = 0; m < 4; ++m)
#pragma unroll
                for (int n = 0; n < 2; ++n) acc[a][b][m][n] = (f32x4){0.f, 0.f, 0.f, 0.f};
    bf16x8 At[4][2], B0[2][2], B1[2][2];
    const char* cA = (const char*)g.A + (size_t)cur.pm * tstep; const char* cB = (const char*)g.Bt + (size_t)cur.pn * tstep;
    S.a_ready(cur);
    if constexpr (SP2) {
        PG8_STAGE(PG8_SB(0, 0), cB, voffB); PG8_STAGE(PG8_SB(0, 1), cB + hstep, voffB); PG8_STAGE(PG8_SA(0, 0), cA, voffA); PG8_STAGE(PG8_SA(0, 1), cA + hstep, voffA);
        if (wr == 1) PG8_BAR;
        PG8_WAIT_V(2); PG8_BAR;
        PG8_STAGE(PG8_SB(1, 0), cB + kstep, voffB); PG8_STAGE(PG8_SA(1, 0), cA + kstep, voffA); PG8_STAGE(PG8_SB(1, 1), cB + hstep + kstep, voffB);
        PG8_WAIT_V(6); PG8_BAR;
    } else {
        PG8_STAGE(PG8_SB(0, 0), cB, voffB); PG8_STAGE(PG8_SA(0, 0), cA, voffA); PG8_STAGE(PG8_SB(0, 1), cB + hstep, voffB); PG8_STAGE(PG8_SA(0, 1), cA + hstep, voffA);
        if (wr == 1) PG8_BAR;
        PG8_WAIT_V(4); PG8_BAR;
        PG8_STAGE(PG8_SB(1, 0), cB + kstep, voffB); PG8_STAGE(PG8_SA(1, 0), cA + kstep, voffA); PG8_STAGE(PG8_SB(1, 1), cB + hstep + kstep, voffB);
        PG8_WAIT_V(6); PG8_BAR;
    }
    for (;;) {
        const bool has_next = S.next(ui + 1, nxt);
        const char* nA = has_next ? (const char*)g.A + (size_t)nxt.pm * tstep : cA; const char* nB = has_next ? (const char*)g.Bt + (size_t)nxt.pn * tstep : cB;
        for (int t = 0; t < nt; t += 2) {
            const bool last = (t == nt - 2);
            const char* a1 = cA + (size_t)(t + 1) * kstep;
            const char* a2 = last ? nA : cA + (size_t)(t + 2) * kstep; const char* b2 = last ? nB : cB + (size_t)(t + 2) * kstep;
            const char* a3 = a2 + kstep; const char* b3 = b2 + kstep;
            if (last && has_next) S.a_ready(nxt);
            if constexpr (SP2) {
            PG8_LDB(B0, 0, 0); PG8_LDB(B1, 0, 1); PG8_SCHED; PG8_LDA(At, 0, 0); PG8_STAGE(PG8_SA(1, 1), a1 + hstep, voffA);
            PG8_WAIT_V(8); PG8_WAIT_L(0); PG8_BAR; PG8_MMA(0, 0, At, B0); PG8_MMA(0, 1, At, B1); PG8_BAR; PG8_SCHED;
            PG8_LDA(At, 0, 1); PG8_STAGE(PG8_SB(0, 0), b2, voffB); PG8_STAGE(PG8_SB(0, 1), b2 + hstep, voffB); PG8_STAGE(PG8_SA(0, 0), a2, voffA);
            PG8_WAIT_V(8); PG8_WAIT_L(0); PG8_BAR; PG8_MMA(1, 0, At, B0); PG8_MMA(1, 1, At, B1); PG8_BAR; PG8_SCHED;
            PG8_LDB(B0, 1, 0); PG8_LDB(B1, 1, 1); PG8_SCHED; PG8_LDA(At, 1, 0); PG8_STAGE(PG8_SA(0, 1), a2 + hstep, voffA);
            PG8_WAIT_V(8); PG8_WAIT_L(0); PG8_BAR; PG8_MMA(0, 0, At, B0); PG8_MMA(0, 1, At, B1); PG8_BAR; PG8_SCHED;
            PG8_LDA(At, 1, 1); PG8_STAGE(PG8_SB(1, 0), b3, voffB); PG8_STAGE(PG8_SB(1, 1), b3 + hstep, voffB); PG8_STAGE(PG8_SA(1, 0), a3, voffA);
            PG8_WAIT_V(8); PG8_WAIT_L(0); PG8_BAR; PG8_MMA(1, 0, At, B0); PG8_MMA(1, 1, At, B1); PG8_BAR; PG8_SCHED;
            } else {
            PG8_LDB(B0, 0, 0); PG8_SCHED; PG8_LDA(At, 0, 0); PG8_STAGE(PG8_SA(1, 1), a1 + hstep, voffA);
            PG8_WAIT_L(8); PG8_BAR; PG8_WAIT_L(0); PG8_MMA(0, 0, At, B0); PG8_BAR; PG8_SCHED;
            PG8_LDB(B1, 0, 1); PG8_STAGE(PG8_SB(0, 0), b2, voffB);
            PG8_BAR; PG8_WAIT_L(0); PG8_MMA(0, 1, At, B1); PG8_BAR;
            PG8_LDA(At, 0, 1); PG8_STAGE(PG8_SA(0, 0), a2, voffA);
            PG8_BAR; PG8_WAIT_L(0); PG8_MMA(1, 0, At, B0); PG8_BAR; PG8_SCHED;
            PG8_STAGE(PG8_SB(0, 1), b2 + hstep, voffB);
            PG8_WAIT_V(6); PG8_BAR; PG8_MMA(1, 1, At, B1); PG8_BAR;
            PG8_LDB(B0, 1, 0); PG8_SCHED; PG8_LDA(At, 1, 0); PG8_STAGE(PG8_SA(0, 1), a2 + hstep, voffA);
            PG8_WAIT_L(8); PG8_BAR; PG8_WAIT_L(0); PG8_MMA(0, 0, At, B0); PG8_BAR; PG8_SCHED;
            PG8_LDB(B1, 1, 1); PG8_STAGE(PG8_SB(1, 0), b3, voffB);
            PG8_BAR; PG8_WAIT_L(0); PG8_MMA(0, 1, At, B1); PG8_BAR;
            PG8_LDA(At, 1, 1); PG8_STAGE(PG8_SA(1, 0), a3, voffA);
            PG8_BAR; PG8_WAIT_L(0); PG8_MMA(1, 0, At, B0); PG8_BAR; PG8_SCHED;
            PG8_STAGE(PG8_SB(1, 1), b3 + hstep, voffB);
            PG8_WAIT_V(6); PG8_BAR; PG8_MMA(1, 1, At, B1); PG8_BAR;
            }
        }
        if constexpr (ALIGN_EPI) { if (wr == 0) PG8_BAR; }
        if constexpr (!Epi::AFTER_DRAIN) { E(acc, cur, wr, wc, fr, fq); S.done(cur); }
        if (!has_next) break;
#pragma unroll
        for (int a = 0; a < 2; ++a)
#pragma unroll
            for (int b = 0; b < 2; ++b)
#pragma unroll
                for (int m = 0; m < 4; ++m)
#pragma unroll
                    for (int n = 0; n < 2; ++n) acc[a][b][m][n] = (f32x4){0.f, 0.f, 0.f, 0.f};
        cur = nxt; cA = nA; cB = nB; ++ui;
        if constexpr (ALIGN_EPI) { if (wr == 1) PG8_BAR; }
    }
    PG8_WAIT_V(0);
    if constexpr (!ALIGN_EPI) { if (wr == 0) PG8_BAR; }
    PG8_BAR;
    if constexpr (Epi::AFTER_DRAIN) { E.fused(acc, cur, wr, wc, fr, fq, lds, wid, lane); S.done(cur); }
#undef PG8_SA
#undef PG8_SB
#undef PG8_STAGE
#undef PG8_LDA
#undef PG8_LDB
#undef PG8_MMA
#undef PG8_WAIT_V
#undef PG8_WAIT_L
#undef PG8_BAR
#undef PG8_SCHED
}
}
#define GAS __attribute__((address_space(1)))
#define LAS __attribute__((address_space(3)))
#define XB_TMO      128
#define XB_XCNT(j)  (256  + 64 * (j))
#define XB_XSUB(j)  (1280 + 64 * (j))
#define XB_XGEN(j)  (2304 + 64 * (j))
#define XB_TOP      3328
#define XB_TOPGEN   3392
#define XCD_BAR_WORDS 3456
#define XB_SPIN_CAP (1u << 18)

__device__ __forceinline__ unsigned xb_ld(unsigned* p)              { return __hip_atomic_load(p, __ATOMIC_RELAXED, __HIP_MEMORY_SCOPE_AGENT); }
__device__ __forceinline__ unsigned xb_add(unsigned* p, unsigned v) { return __hip_atomic_fetch_add(p, v, __ATOMIC_RELAXED, __HIP_MEMORY_SCOPE_AGENT); }
__device__ __forceinline__ unsigned xb_xcc_id() { return (unsigned)__builtin_amdgcn_s_getreg((3 << 11) | 20) & 0xFu; }
#define XB_SPIN(cond, bar) do { unsigned _sp = 0; while (cond) { __builtin_amdgcn_s_sleep(1); \
    if ((++_sp & 255u) == 0u) { if (xb_ld(&(bar)[XB_TMO])) break; if (_sp > XB_SPIN_CAP) { atomicAdd(&(bar)[XB_TMO], 1u); break; } } } } while (0)

struct XcdBarrier {
    unsigned* bar; unsigned x;
    volatile LAS unsigned* st;
};

__device__ __forceinline__ XcdBarrier xcd_barrier_post(unsigned* bar, volatile LAS unsigned* st) {
    XcdBarrier b; b.bar = bar; b.x = xb_xcc_id(); b.st = st;
    if (threadIdx.x == 0) (void)xb_add(&bar[XB_XCNT(b.x)], 1u);
    return b;
}
__device__ __forceinline__ void xcd_barrier_complete(unsigned* bar, unsigned x, unsigned& nloc, unsigned& nx) {
    const unsigned G = gridDim.x * gridDim.y * gridDim.z;
    unsigned sum, cnt, mine, sp = 0u;
    for (;;) {
        sum = 0u; cnt = 0u; mine = 0u;
#pragma unroll
        for (unsigned j = 0; j < 16; ++j) { const unsigned c = xb_ld(&bar[XB_XCNT(j)]); sum += c; cnt += (c > 0u) ? 1u : 0u; mine = (j == x) ? c : mine; }
        if (sum == G) break;
        __builtin_amdgcn_s_sleep(1);
        if ((++sp & 255u) == 0u) { if (xb_ld(&bar[XB_TMO])) break; if (sp > XB_SPIN_CAP) { atomicAdd(&bar[XB_TMO], 1u); break; } }
    }
    nloc = mine > 0u ? mine : 1u; nx = cnt > 0u ? cnt : 1u;
}

__device__ __forceinline__ void xcd_barrier(const XcdBarrier& b) {
    asm volatile("s_waitcnt vmcnt(0)" ::: "memory");
    __syncthreads();
    if (threadIdx.x == 0) {
        unsigned* bar = b.bar;
        __builtin_amdgcn_s_waitcnt(0);
        unsigned nloc = b.st[0], nx = b.st[1];
        if (nloc == 0u) { xcd_barrier_complete(bar, b.x, nloc, nx); b.st[0] = nloc; b.st[1] = nx; }
        const unsigned old = xb_add(&bar[XB_XSUB(b.x)], 1u);
        const unsigned gen = old / nloc;
        if (old + 1u == (gen + 1u) * nloc) {
            __builtin_amdgcn_fence(__ATOMIC_RELEASE, "agent");
            asm volatile("s_waitcnt vmcnt(0)" ::: "memory");
            const unsigned og = xb_add(&bar[XB_TOP], 1u);
            const unsigned tg = og / nx;
            if (og + 1u == (tg + 1u) * nx) xb_add(&bar[XB_TOPGEN], 1u);
            else XB_SPIN(xb_ld(&bar[XB_TOPGEN]) == tg, bar);
            __builtin_amdgcn_fence(__ATOMIC_ACQUIRE, "agent");
            xb_add(&bar[XB_XGEN(b.x)], 1u);
            asm volatile("s_waitcnt vmcnt(0)" ::: "memory");
        } else {
            XB_SPIN(xb_ld(&bar[XB_XGEN(b.x)]) == gen, bar);
            __builtin_amdgcn_fence(__ATOMIC_ACQUIRE, "agent");
            asm volatile("s_waitcnt vmcnt(0)" ::: "memory");
        }
    }
    __syncthreads();
}

#ifndef MK_N_LAUNCHES
#define MK_N_LAUNCHES 1
#endif
constexpr int NWAVES = 8;
constexpr int DM = 2048, SEQ = 2048, NBATCH = 4, MP = NBATCH * SEQ, MS = 32, MT = MP + MS;
constexpr int INC = 3584, FF = 8192, NH = 16, NKV = 4, HD = 64, CCH = 1024, CW = 31;
constexpr float EPS = 1e-6f;
constexpr size_t O_YP = 0, O_YS = (size_t)MP * DM, O_KP = O_YS + (size_t)MS * DM, O_VP = O_KP + 131072, O_CP = O_VP + 131072,
                 O_KS = O_CP + 122880, O_VS = O_KS + 1048576, O_CS = O_VS + 1048576, O_END = O_CS + 983040;
constexpr size_t MiB = 1u << 20;
constexpr size_t WS_CTL = 0, CTL_ZERO_BYTES = 68 * 1024;
constexpr size_t WS_SSQ = 32 * 1024, WS_SSQ0 = 96 * 1024;
constexpr size_t WS_COS = 1 * MiB, WS_SIN = 2 * MiB;
constexpr size_t WS_ZS = 3 * MiB;
constexpr size_t WS_WIN = 4 * MiB, WS_WOUT = 18 * MiB, WS_WUP = 26 * MiB, WS_WDN = 58 * MiB;
constexpr size_t WS_X1G = 90 * MiB;
constexpr size_t WS_HID = 123 * MiB;
constexpr size_t WS_XN = 123 * MiB, WS_Q = 156 * MiB, WS_K = 172 * MiB, WS_V = 176 * MiB, WS_U = 180 * MiB, WS_MIX = 196 * MiB;
constexpr size_t WS_END = 256 * MiB;
static_assert(WS_HID + (size_t)MT * FF * 2 <= WS_END && WS_MIX + (size_t)MT * DM * 2 <= WS_END && WS_X1G + (size_t)MT * DM * 2 <= WS_HID, "ws map");
constexpr int CW_BAR = 4096;
constexpr int RING_BYTES = 131072, LDSCTL_OFF = RING_BYTES, MISC_OFF = LDSCTL_OFF + 320, LDS_BYTES = 147456;

typedef unsigned short bf16;
typedef unsigned v4u __attribute__((ext_vector_type(4)));
typedef unsigned v2u __attribute__((ext_vector_type(2)));
typedef float f32x4 __attribute__((ext_vector_type(4)));
typedef float f32x2 __attribute__((ext_vector_type(2)));
typedef short bf16x8 __attribute__((ext_vector_type(8)));
#define LDS_WAIT() asm volatile("s_waitcnt lgkmcnt(0)" ::: "memory")
__device__ __forceinline__ unsigned f2bf(float f) { unsigned u = __builtin_bit_cast(unsigned, f); return (u + 0x7fffu + ((u >> 16) & 1u)) >> 16; }
__device__ __forceinline__ unsigned pk2(float lo, float hi) { return pg8::cvt_pk_bf16(lo, hi); }
__device__ __forceinline__ float bf2f(unsigned h) { return __builtin_bit_cast(float, h << 16); }
template <int CTRL, int ROWMASK> __device__ __forceinline__ float dpp_get(float v) {
    return __builtin_bit_cast(float, __builtin_amdgcn_update_dpp(0, __builtin_bit_cast(int, v), CTRL, ROWMASK, 0xf, false)); }
__device__ __forceinline__ float wave_sum(float v) {
    v += dpp_get<0xB1, 0xf>(v); v += dpp_get<0x4E, 0xf>(v); v += dpp_get<0x124, 0xf>(v); v += dpp_get<0x128, 0xf>(v);
    v += dpp_get<0x142, 0xa>(v); v += dpp_get<0x143, 0xc>(v);
    return __builtin_bit_cast(float, __builtin_amdgcn_readlane(__builtin_bit_cast(int, v), 63));
}
__device__ __forceinline__ float wave_max(float v) {
    v = fmaxf(v, dpp_get<0xB1, 0xf>(v)); v = fmaxf(v, dpp_get<0x4E, 0xf>(v)); v = fmaxf(v, dpp_get<0x124, 0xf>(v)); v = fmaxf(v, dpp_get<0x128, 0xf>(v));
    const int iv = __builtin_bit_cast(int, v);
    const float a = __builtin_bit_cast(float, __builtin_amdgcn_readlane(iv, 0)), b = __builtin_bit_cast(float, __builtin_amdgcn_readlane(iv, 16)),
                c = __builtin_bit_cast(float, __builtin_amdgcn_readlane(iv, 32)), d = __builtin_bit_cast(float, __builtin_amdgcn_readlane(iv, 48));
    return fmaxf(fmaxf(a, b), fmaxf(c, d));
}
__device__ __forceinline__ float dot4(f32x4 a, f32x4 b) { return (a[0] * b[0] + a[1] * b[1]) + (a[2] * b[2] + a[3] * b[3]); }
__device__ __forceinline__ float sigmoidf_(float g) { return 1.0f / (1.0f + __expf(-g)); }

__device__ __forceinline__ int win_dst_group(int sg) {
    if (sg < 48) { const int pn = sg >> 3, wc = (sg & 7) >> 1, bj = sg & 1; return 8 * pn + 4 * bj + wc; }
    if (sg < 80) { const int cc = sg - 48; return 8 * (6 + (cc >> 2)) + (cc & 3); }
    const int cc = sg - 80; return 8 * (6 + (cc >> 2)) + 4 + (cc & 3);
}
__device__ __forceinline__ int win_logical_col(int np) {
    const int dg = np >> 5, e = np & 31, pn = dg >> 3, bj = (dg >> 2) & 1, wc = dg & 3;
    if (dg < 48) return 256 * pn + 64 * wc + 32 * bj + e;
    return (bj ? 2560 : 1536) + 128 * (pn - 6) + 32 * wc + e;
}

using pg8::Unit;
struct Epi1 {
    static constexpr bool PERM = true, AFTER_DRAIN = false;
    bf16 *Q, *K, *V, *U; float* out; const float *gq, *gk, *cosT, *sinT, *SSQ0;
    __device__ __forceinline__ void operator()(const f32x4 (&acc)[2][2][4][2], const Unit& u, int wr, int wc, int fr, int fq) const {
        const int pn = u.pn, rbase = u.pm * 256 + wr * 64 + fr;
        if (pn < 5) {
            const float* g = pn < 4 ? gq : gk; const float qs = pn < 4 ? 0.125f : 1.0f;
            const f32x4 g1a = *(const f32x4*)(g + 8 * fq), g1b = *(const f32x4*)(g + 8 * fq + 4), g2a = *(const f32x4*)(g + 32 + 8 * fq), g2b = *(const f32x4*)(g + 36 + 8 * fq);
#pragma unroll
            for (int ah = 0; ah < 4; ++ah) {
                const int ai = ah >> 1;
                f32x4 rc[4][2], rs[4][2]; float r0[4];
#pragma unroll
                for (int m = 2 * (ah & 1); m < 2 * (ah & 1) + 2; ++m) { const int s = (rbase + ai * 128 + m * 16) & (SEQ - 1);
                    r0[m] = SSQ0[rbase + ai * 128 + m * 16];
                    rc[m][0] = *(const f32x4*)(cosT + s * 32 + 8 * fq); rc[m][1] = *(const f32x4*)(cosT + s * 32 + 8 * fq + 4);
                    rs[m][0] = *(const f32x4*)(sinT + s * 32 + 8 * fq); rs[m][1] = *(const f32x4*)(sinT + s * 32 + 8 * fq + 4); }
                asm volatile("" ::: "memory");
#pragma unroll
                for (int m = 2 * (ah & 1); m < 2 * (ah & 1) + 2; ++m) {
                    const int r = rbase + ai * 128 + m * 16, s = r & (SEQ - 1), b = r >> 11;
                    const float rr = rsqrtf(r0[m] * (1.0f / DM) + EPS);
                    const f32x4 x1a = acc[ai][0][m][0] * rr, x1b = acc[ai][0][m][1] * rr, x2a = acc[ai][1][m][0] * rr, x2b = acc[ai][1][m][1] * rr;
                    float ss = (dot4(x1a, x1a) + dot4(x1b, x1b)) + (dot4(x2a, x2a) + dot4(x2b, x2b));
                    ss += __shfl_xor(ss, 16); ss += __shfl_xor(ss, 32);
                    const float rstd = rsqrtf(ss * (1.0f / 64.0f) + EPS);
                    const f32x4 y1a = x1a * rstd * g1a, y1b = x1b * rstd * g1b, y2a = x2a * rstd * g2a, y2b = x2b * rstd * g2b;
                    const f32x4 ca = rc[m][0], cb = rc[m][1], sa = rs[m][0], sb = rs[m][1];
                    const f32x4 o1a = y1a * ca - y2a * sa, o1b = y1b * cb - y2b * sb, o2a = y2a * ca + y1a * sa, o2b = y2b * cb + y1b * sb;
                    v4u w1, w2;
                    w1.x = pk2(o1a[0] * qs, o1a[1] * qs); w1.y = pk2(o1a[2] * qs, o1a[3] * qs); w1.z = pk2(o1b[0] * qs, o1b[1] * qs); w1.w = pk2(o1b[2] * qs, o1b[3] * qs);
                    w2.x = pk2(o2a[0] * qs, o2a[1] * qs); w2.y = pk2(o2a[2] * qs, o2a[3] * qs); w2.z = pk2(o2b[0] * qs, o2b[1] * qs); w2.w = pk2(o2b[2] * qs, o2b[3] * qs);
                    if (pn < 4) {
                        bf16* p = Q + (size_t)r * 1024 + 64 * (4 * pn + wc) + 8 * fq;
                        *(v4u*)p = w1; *(v4u*)(p + 32) = w2;
                    } else {
                        bf16* p = K + (size_t)r * 256 + 64 * wc + 8 * fq;
                        *(v4u*)p = w1; *(v4u*)(p + 32) = w2;
                        if (s >= SEQ - 128) {
                            float* o = out + O_KP + ((size_t)(b * 128 + s - (SEQ - 128)) * 4 + wc) * 64 + 8 * fq;
                            *(f32x4*)o = o1a; *(f32x4*)(o + 4) = o1b; *(f32x4*)(o + 32) = o2a; *(f32x4*)(o + 36) = o2b;
                        }
                    }
                }
                asm volatile("" ::: "memory");
            }
        } else if (pn == 5) {
#pragma unroll
            for (int ai = 0; ai < 2; ++ai) {
                float r0[4];
#pragma unroll
                for (int m = 0; m < 4; ++m) r0[m] = SSQ0[rbase + ai * 128 + m * 16];
                asm volatile("" ::: "memory");
#pragma unroll
                for (int m = 0; m < 4; ++m) {
                    const int r = rbase + ai * 128 + m * 16, s = r & (SEQ - 1), b = r >> 11; const float rr = rsqrtf(r0[m] * (1.0f / DM) + EPS);
#pragma unroll
                    for (int bj = 0; bj < 2; ++bj) {
                        const f32x4 v0 = acc[ai][bj][m][0] * rr, v1 = acc[ai][bj][m][1] * rr;
                        v4u w; w.x = pk2(v0[0], v0[1]); w.y = pk2(v0[2], v0[3]); w.z = pk2(v1[0], v1[1]); w.w = pk2(v1[2], v1[3]);
                        *(v4u*)(V + (size_t)r * 256 + 64 * wc + 32 * bj + 8 * fq) = w;
                        if (s >= SEQ - 128) {
                            float* o = out + O_VP + ((size_t)(b * 128 + s - (SEQ - 128)) * 4 + wc) * 64 + 32 * bj + 8 * fq;
                            *(f32x4*)o = v0; *(f32x4*)(o + 4) = v1;
                        }
                    }
                }
            }
        } else {
            const int ch = 128 * (pn - 6) + 32 * wc + 8 * fq;
#pragma unroll
            for (int ai = 0; ai < 2; ++ai) {
                float r0[4];
#pragma unroll
                for (int m = 0; m < 4; ++m) r0[m] = SSQ0[rbase + ai * 128 + m * 16];
                asm volatile("" ::: "memory");
#pragma unroll
                for (int m = 0; m < 4; ++m) {
                    const int r = rbase + ai * 128 + m * 16, s = r & (SEQ - 1), b = r >> 11;
                    const float rr = rsqrtf(r0[m] * (1.0f / DM) + EPS);
                    const f32x4 a0 = acc[ai][0][m][0] * rr, a1 = acc[ai][0][m][1] * rr, g0 = acc[ai][1][m][0] * rr, g1 = acc[ai][1][m][1] * rr;
                    f32x4 u0, u1;
#pragma unroll
                    for (int j = 0; j < 4; ++j) { u0[j] = a0[j] * sigmoidf_(g0[j]); u1[j] = a1[j] * sigmoidf_(g1[j]); }
                    v4u w; w.x = pk2(u0[0], u0[1]); w.y = pk2(u0[2], u0[3]); w.z = pk2(u1[0], u1[1]); w.w = pk2(u1[2], u1[3]);
                    *(v4u*)(U + (size_t)r * 1024 + ch) = w;
                    if (s >= SEQ - 30) {
                        float* o = out + O_CP + (size_t)(b * 30 + s - (SEQ - 30)) * 1024 + ch;
                        *(f32x4*)o = u0; *(f32x4*)(o + 4) = u1;
                    }
                }
            }
        }
    }
};
struct Epi3 {
    static constexpr bool PERM = true, AFTER_DRAIN = false;
    const bf16* XB; float* Y; bf16* X1G; const float* gm; float* SSQ;
    __device__ __forceinline__ void operator()(const f32x4 (&acc)[2][2][4][2], const Unit& u, int wr, int wc, int fr, int fq) const {
        const int rbase = u.pm * 256 + wr * 64 + fr, col0 = u.pn * 256 + wc * 32 + 8 * fq;
#pragma unroll
        for (int ai = 0; ai < 2; ++ai) {
            f32x4 pre[4][2][2];
#pragma unroll
            for (int m = 0; m < 4; ++m)
#pragma unroll
                for (int bj = 0; bj < 2; ++bj) { const v4u q = *(const v4u*)(XB + (size_t)(rbase + ai * 128 + m * 16) * DM + col0 + bj * 128);
                    pre[m][bj][0] = (f32x4){bf2f(q.x & 0xffffu), bf2f(q.x >> 16), bf2f(q.y & 0xffffu), bf2f(q.y >> 16)};
                    pre[m][bj][1] = (f32x4){bf2f(q.z & 0xffffu), bf2f(q.z >> 16), bf2f(q.w & 0xffffu), bf2f(q.w >> 16)}; }
            asm volatile("" ::: "memory");
#pragma unroll
            for (int m = 0; m < 4; ++m) {
                const int r = rbase + ai * 128 + m * 16; float ss = 0.f;
#pragma unroll
                for (int bj = 0; bj < 2; ++bj) {
                    const size_t off = (size_t)r * DM + col0 + bj * 128;
                    const f32x4 v0 = acc[ai][bj][m][0] + pre[m][bj][0], v1 = acc[ai][bj][m][1] + pre[m][bj][1];
                    ss += dot4(v0, v0) + dot4(v1, v1);
                    v4u w; w.x = pk2(v0[0], v0[1]); w.y = pk2(v0[2], v0[3]); w.z = pk2(v1[0], v1[1]); w.w = pk2(v1[2], v1[3]);
                    *(v4u*)(X1G + off) = w;
                }
                ss += __shfl_xor(ss, 16); ss += __shfl_xor(ss, 32);
                if (fq == 0) atomicAdd(SSQ + r, ss);
            }
            asm volatile("" ::: "memory");
        }
    }
};
struct Epi4 {
    static constexpr bool PERM = true, AFTER_DRAIN = false;
    const float* SSQ; bf16* H;
    __device__ __forceinline__ void operator()(const f32x4 (&acc)[2][2][4][2], const Unit& u, int wr, int wc, int fr, int fq) const {
        const int rbase = u.pm * 256 + wr * 64 + fr, col0 = u.pn * 256 + wc * 32 + 8 * fq;
        float sq[2][4];
#pragma unroll
        for (int ai = 0; ai < 2; ++ai)
#pragma unroll
            for (int m = 0; m < 4; ++m) sq[ai][m] = SSQ[rbase + ai * 128 + m * 16];
        asm volatile("" ::: "memory");
#pragma unroll
        for (int ai = 0; ai < 2; ++ai)
#pragma unroll
            for (int m = 0; m < 4; ++m) {
                const int r = rbase + ai * 128 + m * 16;
                const float rstd = rsqrtf(sq[ai][m] * (1.0f / DM) + EPS);
#pragma unroll
                for (int bj = 0; bj < 2; ++bj) {
                    f32x4 v0 = acc[ai][bj][m][0] * rstd, v1 = acc[ai][bj][m][1] * rstd;
#pragma unroll
                    for (int j = 0; j < 4; ++j) { v0[j] = fmaxf(v0[j], 0.f); v0[j] *= v0[j]; v1[j] = fmaxf(v1[j], 0.f); v1[j] *= v1[j]; }
                    v4u w; w.x = pk2(v0[0], v0[1]); w.y = pk2(v0[2], v0[3]); w.z = pk2(v1[0], v1[1]); w.w = pk2(v1[2], v1[3]);
                    *(v4u*)(H + (size_t)r * FF + col0 + bj * 128) = w;
                }
            }
    }
};
struct Epi5 {
    static constexpr bool PERM = true, AFTER_DRAIN = false;
    float* Y; const bf16* X1G;
    __device__ __forceinline__ void operator()(const f32x4 (&acc)[2][2][4][2], const Unit& u, int wr, int wc, int fr, int fq) const {
        const int rbase = u.pm * 256 + wr * 64 + fr, col0 = u.pn * 256 + wc * 32 + 8 * fq;
        v4u pre[2][4][2];
#pragma unroll
        for (int ai = 0; ai < 2; ++ai)
#pragma unroll
            for (int m = 0; m < 4; ++m)
#pragma unroll
                for (int bj = 0; bj < 2; ++bj) pre[ai][m][bj] = *(const v4u*)(X1G + (size_t)(rbase + ai * 128 + m * 16) * DM + col0 + bj * 128);
        asm volatile("" ::: "memory");
#pragma unroll
        for (int ai = 0; ai < 2; ++ai)
#pragma unroll
            for (int m = 0; m < 4; ++m)
#pragma unroll
                for (int bj = 0; bj < 2; ++bj) { float* p = Y + (size_t)(rbase + ai * 128 + m * 16) * DM + col0 + bj * 128; const v4u q = pre[ai][m][bj];
                    const f32x4 r0 = {bf2f(q.x & 0xffffu), bf2f(q.x >> 16), bf2f(q.y & 0xffffu), bf2f(q.y >> 16)}, r1 = {bf2f(q.z & 0xffffu), bf2f(q.z >> 16), bf2f(q.w & 0xffffu), bf2f(q.w >> 16)};
                    *(f32x4*)p = acc[ai][bj][m][0] + r0; *(f32x4*)(p + 4) = acc[ai][bj][m][1] + r1; }
    }
};

template <class EpiS>
__device__ __forceinline__ void skinny_phase(LAS unsigned char* lds, const bf16* As, const bf16* Bt, int N, int K, int start, int stride, const EpiS& E, const int wid_in) {
    const int wave = wid_in; int tid = wave * 64 + mk_fresh_lane(); asm volatile("" : "+v"(tid));
    const int lane = tid & 63, fr = lane & 15, fq = lane >> 4;
    LAS float* red = (LAS float*)lds;
    const int kw = K >> 3, kb = wave * kw;
    for (int unit = start; unit < (N >> 4); unit += stride) {
        f32x4 a0 = {0.f, 0.f, 0.f, 0.f}, a1 = {0.f, 0.f, 0.f, 0.f};
        const bf16* bp = Bt + (size_t)(16 * unit + fr) * K + kb + 8 * fq;
        const bf16* ap0 = As + (size_t)fr * K + kb + 8 * fq;
        const bf16* ap1 = ap0 + (size_t)16 * K;
#pragma unroll 8
        for (int k = 0; k < kw; k += 32) {
            const bf16x8 b = *(const bf16x8*)(bp + k), x0 = *(const bf16x8*)(ap0 + k), x1 = *(const bf16x8*)(ap1 + k);
            a0 = __builtin_amdgcn_mfma_f32_16x16x32_bf16(b, x0, a0, 0, 0, 0);
            a1 = __builtin_amdgcn_mfma_f32_16x16x32_bf16(b, x1, a1, 0, 0, 0);
        }
        *(LAS f32x4*)(red + (wave * 2 + 0) * 256 + lane * 4) = a0;
        *(LAS f32x4*)(red + (wave * 2 + 1) * 256 + lane * 4) = a1;
        __syncthreads();
        const int row = tid >> 4, cj = tid & 15, idx = (row >> 4) * 256 + ((row & 15) + 16 * (cj >> 2)) * 4 + (cj & 3);
        float s = 0.f;
#pragma unroll
        for (int w = 0; w < 8; ++w) s += red[w * 512 + idx];
        E(row, 16 * unit + cj, s);
        __syncthreads();
    }
}
struct EpiS1 { float* ZS; const float* SSQ0; __device__ __forceinline__ void operator()(int row, int col, float v) const { ZS[row * INC + win_logical_col(col)] = v * rsqrtf(SSQ0[MP + row] * (1.0f / DM) + EPS); } };
struct EpiS3 { const float* xs; float* Y; bf16* X1G; const float* gm; float* SSQ;
    __device__ __forceinline__ void operator()(int row, int col, float v) const {
        const float x1 = xs[row * DM + col] + v; X1G[(size_t)(MP + row) * DM + col] = (bf16)f2bf(x1);
        float ss = x1 * x1; ss += __shfl_xor(ss, 1); ss += __shfl_xor(ss, 2); ss += __shfl_xor(ss, 4); ss += __shfl_xor(ss, 8);
        if ((mk_fresh_lane() & 15) == 0) atomicAdd(SSQ + MP + row, ss);
    } };
struct EpiS4 { float* SSQ; bf16* H;
    __device__ __forceinline__ void operator()(int row, int col, float v) const {
        const float rstd = rsqrtf(__hip_atomic_load(SSQ + MP + row, __ATOMIC_RELAXED, __HIP_MEMORY_SCOPE_AGENT) * (1.0f / DM) + EPS);
        float h = fmaxf(v * rstd, 0.f); h *= h; H[(size_t)(MP + row) * FF + col] = (bf16)f2bf(h);
    } };
struct EpiS5 { float* Y; const bf16* X1G; float fac; __device__ __forceinline__ void operator()(int row, int col, float v) const { const size_t o = (size_t)(MP + row) * DM + col; Y[o] = (bf2f((unsigned)X1G[o]) + v) * fac; } };

template <int DEPTH, class Dec>
__device__ __forceinline__ void cvt_items(LAS float* scr, int first, int total, int stride, int lane, const Dec& D) {
    const int r8 = lane >> 3, c4 = lane & 7;
    int it = first; if (it >= total) return;
    const float* src; int N;
    f32x4 v[DEPTH][8]; bf16* dst[DEPTH]; int K[DEPTH];
#pragma unroll
    for (int d = 0; d < DEPTH; ++d) { dst[d] = nullptr; K[d] = 0; }
#pragma unroll
    for (int d = 0; d < DEPTH - 1; ++d)
        if (it + d * stride < total) { D(it + d * stride, src, N, dst[d], K[d]);
#pragma unroll
            for (int i = 0; i < 8; ++i) v[d][i] = __builtin_nontemporal_load((const f32x4*)(src + (size_t)(r8 + 8 * i) * N + 4 * c4)) * D.rowscale(it + d * stride, r8 + 8 * i); }
    for (;;) {
        const int nl = it + (DEPTH - 1) * stride;
        if (nl < total) { D(nl, src, N, dst[DEPTH - 1], K[DEPTH - 1]);
#pragma unroll
            for (int i = 0; i < 8; ++i) v[DEPTH - 1][i] = __builtin_nontemporal_load((const f32x4*)(src + (size_t)(r8 + 8 * i) * N + 4 * c4)) * D.rowscale(nl, r8 + 8 * i); }
#pragma unroll
        for (int i = 0; i < 8; ++i) { LAS float* s = scr + (r8 + 8 * i) * 33 + 4 * c4; s[0] = v[0][i][0]; s[1] = v[0][i][1]; s[2] = v[0][i][2]; s[3] = v[0][i][3]; }
        LDS_WAIT(); asm volatile("" ::: "memory");
        const int c = lane & 7;
#pragma unroll
        for (int j = 0; j < 4; ++j) { const int n = (lane >> 3) + 8 * j; const LAS float* s = scr + (8 * c) * 33 + n;
            v4u o; o.x = pk2(s[0 * 33], s[1 * 33]); o.y = pk2(s[2 * 33], s[3 * 33]); o.z = pk2(s[4 * 33], s[5 * 33]); o.w = pk2(s[6 * 33], s[7 * 33]);
            *(v4u*)(dst[0] + (size_t)n * K[0] + 8 * c) = o; }
        LDS_WAIT(); asm volatile("" ::: "memory");
        it += stride; if (it >= total) break;
#pragma unroll
        for (int d = 0; d < DEPTH - 1; ++d) {
#pragma unroll
            for (int i = 0; i < 8; ++i) v[d][i] = v[d + 1][i];
            dst[d] = dst[d + 1]; K[d] = K[d + 1]; }
    }
}
struct DecP0 { const float* w_in; bf16* WinT; const float* gmix;
    __device__ __forceinline__ float rowscale(int it, int kk) const { return gmix[64 * (it / (INC / 32)) + kk]; }
    __device__ __forceinline__ void operator()(int it, const float*& src, int& N, bf16*& dst, int& K) const {
        const int kb = it / (INC / 32), nb = it % (INC / 32); src = w_in + (size_t)(64 * kb) * INC + 32 * nb; N = INC; K = DM; dst = WinT + (size_t)(32 * win_dst_group(nb)) * DM + 64 * kb;
    } };
struct DecUp { const float *w_up, *w_out; bf16 *WupT, *WoutT; const float* gm;
    __device__ __forceinline__ float rowscale(int it, int kk) const { constexpr int I_UP = (DM / 64) * (FF / 32); return it < I_UP ? gm[64 * (it / (FF / 32)) + kk] : 1.0f; }
    __device__ __forceinline__ void operator()(int it, const float*& src, int& N, bf16*& dst, int& K) const {
        constexpr int I_UP = (DM / 64) * (FF / 32);
        if (it < I_UP) { const int kb = it / (FF / 32), nb = it % (FF / 32); src = w_up + (size_t)(64 * kb) * FF + 32 * nb; N = FF; K = DM; dst = WupT + (size_t)(32 * nb) * DM + 64 * kb; }
        else { const int r = it - I_UP, kb = r / (DM / 32), nb = r % (DM / 32); src = w_out + (size_t)(64 * kb) * DM + 32 * nb; N = DM; K = DM; dst = WoutT + (size_t)(32 * nb) * DM + 64 * kb; }
    } };
struct DecDn { const float* w_down; bf16* WdnT;
    __device__ __forceinline__ float rowscale(int, int) const { return 1.0f; }
    __device__ __forceinline__ void operator()(int it, const float*& src, int& N, bf16*& dst, int& K) const {
        const int kb = it / (DM / 32), nb = it % (DM / 32); src = w_down + (size_t)(64 * kb) * DM + 32 * nb; N = DM; K = FF; dst = WdnT + (size_t)(32 * nb) * FF + 64 * kb;
    } };
__device__ __forceinline__ void row_to_bf16(const float* xrow, bf16* orow, float* ssq, int lane) {
    const f32x4* xr = (const f32x4*)xrow + lane;
    f32x4 v[8]; float s = 0.f;
#pragma unroll
    for (int j = 0; j < 8; ++j) { v[j] = __builtin_nontemporal_load(xr + 64 * j); s += dot4(v[j], v[j]); }
    v2u* o8 = (v2u*)orow + lane;
#pragma unroll
    for (int j = 0; j < 8; ++j) { v2u w; w.x = pk2(v[j][0], v[j][1]); w.y = pk2(v[j][2], v[j][3]); o8[64 * j] = w; }
    s = wave_sum(s);
    if (lane == 0) *ssq = s;
}

constexpr int KS_STRIDE = 72, VT_STRIDE = 276, KS_BYTES = 272 * KS_STRIDE * 2, VT_BYTES = 64 * VT_STRIDE * 2;
__device__ __forceinline__ void attn_unit(LAS unsigned char* lds, int b, int nb, int kh, const bf16* Q, const bf16* Kb, const bf16* Vb, bf16* MIX, const float* sinks,
                                          int tid, int wave, int lane) {
    LAS bf16* Ks = (LAS bf16*)lds; LAS bf16* Vt = (LAS bf16*)(lds + KS_BYTES);
    const int fr = lane & 15, fq = lane >> 4;
#pragma unroll
    for (int p = 0; p < 4; ++p) {
        const int idx = p * 512 + tid, key = idx >> 3, c = idx & 7, s = 128 * (nb - 1) + key;
        v4u kv = {0u, 0u, 0u, 0u}, vv = {0u, 0u, 0u, 0u};
        if (s >= 0) { const size_t off = (size_t)(b * SEQ + s) * 256 + 64 * kh + 8 * c; kv = *(const v4u*)(Kb + off); vv = *(const v4u*)(Vb + off); }
        *(LAS v4u*)(Ks + key * KS_STRIDE + 8 * c) = kv;
        LAS bf16* vp = Vt + (8 * c) * VT_STRIDE + key;
        vp[0 * VT_STRIDE] = (bf16)(vv.x & 0xffffu); vp[1 * VT_STRIDE] = (bf16)(vv.x >> 16); vp[2 * VT_STRIDE] = (bf16)(vv.y & 0xffffu); vp[3 * VT_STRIDE] = (bf16)(vv.y >> 16);
        vp[4 * VT_STRIDE] = (bf16)(vv.z & 0xffffu); vp[5 * VT_STRIDE] = (bf16)(vv.z >> 16); vp[6 * VT_STRIDE] = (bf16)(vv.w & 0xffffu); vp[7 * VT_STRIDE] = (bf16)(vv.w >> 16);
    }
    if (tid < 144) *(LAS v4u*)(Ks + 256 * KS_STRIDE + tid * 8) = (v4u){0u, 0u, 0u, 0u};
    for (int i = tid; i < 64 * 20; i += 512) Vt[(i / 20) * VT_STRIDE + 256 + (i % 20)] = 0;
    const int g = wave >> 1, h = 4 * kh + g; const float sink = sinks[h];
    bf16x8 qall[4][2];
#pragma unroll
    for (int qi = 0; qi < 4; ++qi) { const size_t r = (size_t)b * SEQ + 128 * nb + 16 * (4 * (wave & 1) + qi) + fr;
        qall[qi][0] = *(const bf16x8*)(Q + r * 1024 + 64 * h + 8 * fq); qall[qi][1] = *(const bf16x8*)(Q + r * 1024 + 64 * h + 32 + 8 * fq); }
    __syncthreads();
#pragma unroll
    for (int qi = 0; qi < 4; ++qi) {
        const int qt = 4 * (wave & 1) + qi, i0 = 16 * qt;
        const size_t r = (size_t)b * SEQ + 128 * nb + i0 + fr;
        bf16x8 qf[2];
        qf[0] = qall[qi][0]; qf[1] = qall[qi][1];
        f32x4 S[10];
#pragma unroll
        for (int t = 0; t < 10; ++t) {
            S[t] = (f32x4){0.f, 0.f, 0.f, 0.f};
#pragma unroll
            for (int ks = 0; ks < 2; ++ks) {
                const bf16x8 kf = *(const LAS bf16x8*)(Ks + (16 * (qt + t) + fr) * KS_STRIDE + 32 * ks + 8 * fq);
                S[t] = __builtin_amdgcn_mfma_f32_16x16x32_bf16(kf, qf[ks], S[t], 0, 0, 0);
            }
        }
        float mx = sink;
#pragma unroll
        for (int t = 0; t < 10; ++t)
#pragma unroll
            for (int j = 0; j < 4; ++j) {
                const int rel = 16 * t + 4 * fq + j - fr;
                const bool ok = rel >= 1 && rel <= 128 && (nb > 0 || (i0 + 16 * t + 4 * fq + j) >= 128);
                S[t][j] = ok ? S[t][j] : -1e30f; mx = fmaxf(mx, S[t][j]);
            }
        mx = fmaxf(mx, __shfl_xor(mx, 16)); mx = fmaxf(mx, __shfl_xor(mx, 32));
        float sum = 0.f;
#pragma unroll
        for (int t = 0; t < 10; ++t)
#pragma unroll
            for (int j = 0; j < 4; ++j) { S[t][j] = __expf(S[t][j] - mx); sum += S[t][j]; }
        sum += __shfl_xor(sum, 16); sum += __shfl_xor(sum, 32); sum += __expf(sink - mx);
        const float inv = 1.0f / sum;
        f32x4 O[4];
#pragma unroll
        for (int dt = 0; dt < 4; ++dt) O[dt] = (f32x4){0.f, 0.f, 0.f, 0.f};
#pragma unroll
        for (int k2 = 0; k2 < 5; ++k2) {
            v4u pw; pw.x = pk2(S[2 * k2][0], S[2 * k2][1]); pw.y = pk2(S[2 * k2][2], S[2 * k2][3]); pw.z = pk2(S[2 * k2 + 1][0], S[2 * k2 + 1][1]); pw.w = pk2(S[2 * k2 + 1][2], S[2 * k2 + 1][3]);
            const bf16x8 pf = __builtin_bit_cast(bf16x8, pw);
#pragma unroll
            for (int dt = 0; dt < 4; ++dt) {
                const LAS bf16* vp = Vt + (16 * dt + fr) * VT_STRIDE + 16 * (qt + 2 * k2) + 4 * fq;
                const v2u lo = *(const LAS v2u*)vp, hi = *(const LAS v2u*)(vp + 16);
                v4u vw; vw.x = lo.x; vw.y = lo.y; vw.z = hi.x; vw.w = hi.y;
                O[dt] = __builtin_amdgcn_mfma_f32_16x16x32_bf16(__builtin_bit_cast(bf16x8, vw), pf, O[dt], 0, 0, 0);
            }
        }
#pragma unroll
        for (int dt = 0; dt < 4; ++dt) {
            v2u w; w.x = pk2(O[dt][0] * inv, O[dt][1] * inv); w.y = pk2(O[dt][2] * inv, O[dt][3] * inv);
            *(v2u*)(MIX + r * DM + 64 * h + 16 * dt + 4 * fq) = w;
        }
    }
    __syncthreads();
}

constexpr int PF_LDS_OFF = 132096;
__device__ __forceinline__ void glds16_pf(const void* gsrc, unsigned lds_dst) { unsigned keep;
    asm volatile("s_mov_b32 %0, m0\n\ts_mov_b32 m0, %2\n\ts_nop 0\n\tglobal_load_lds_dwordx4 %1, off\n\ts_mov_b32 m0, %0" : "=&s"(keep) : "v"(gsrc), "s"(lds_dst) : "memory"); }
__device__ __forceinline__ void conv_unit(LAS unsigned char* lds, int b, int tb, const bf16* U, bf16* MIX, const float* cw, const float* cb, const float* lg, const float* lb,
                                          const float* xpre, int tid, int wave, int lane) {
    LAS unsigned* tile = (LAS unsigned*)lds;
    LAS float* red = (LAS float*)(lds + 62 * 2048);
    LAS float* fin = red + 512;
    const int s0 = 32 * tb;
    {   const int row0 = tid >> 7, c16 = tid & 127;
        const bf16* up = U + ((size_t)b * SEQ + s0 - 30 + row0) * 1024 + 8 * c16;
#pragma unroll
        for (int h8 = 0; h8 < 2; ++h8) {
            v4u tv[8];
#pragma unroll
            for (int t = 0; t < 8; ++t) { const int row = row0 + 4 * (8 * h8 + t);
                tv[t] = (v4u){0u, 0u, 0u, 0u};
                if (row < 62 && s0 - 30 + row >= 0) tv[t] = *(const v4u*)(up + (size_t)(4 * (8 * h8 + t)) * 1024); }
#pragma unroll
            for (int t = 0; t < 8; ++t) { const int row = row0 + 4 * (8 * h8 + t);
                if (row < 62) *(LAS v4u*)(tile + row * 512 + 4 * c16) = tv[t]; }
            asm volatile("" ::: "memory");
        }
    }
    __syncthreads();
    f32x2 w[31];
#pragma unroll
    for (int j = 0; j < 31; ++j) w[j] = *(const f32x2*)(cw + j * 1024 + 2 * tid);
    const f32x2 bias = *(const f32x2*)(cb + 2 * tid);
    const f32x2 g = *(const f32x2*)(lg + 2 * tid), be = *(const f32x2*)(lb + 2 * tid);
#pragma unroll 1
    for (int ck = 0; ck < 4; ++ck) {
        f32x2 c[8];
#pragma unroll
        for (int o = 0; o < 8; ++o) c[o] = bias;
#pragma unroll
        for (int rr = 0; rr < 38; ++rr) {
            const unsigned pv = tile[(8 * ck + rr) * 512 + tid];
            const f32x2 v = {bf2f(pv & 0xffffu), bf2f(pv >> 16)};
#pragma unroll
            for (int o = 0; o < 8; ++o) { const int j = rr - o; if (j >= 0 && j <= 30) c[o] = c[o] + w[j] * v; }
            if ((rr & 7) == 7) asm volatile("" ::: "memory");
        }
#pragma unroll
        for (int o = 0; o < 8; ++o) {
            const f32x2 x = c[o];
            const float s1 = wave_sum(x[0] + x[1]), s2 = wave_sum(x[0] * x[0] + x[1] * x[1]);
            if (lane == 0) { red[(wave * 8 + o) * 2] = s1; red[(wave * 8 + o) * 2 + 1] = s2; }
        }
        asm volatile("s_waitcnt lgkmcnt(0)\n\ts_barrier" ::: "memory");
        if (tid < 16) { float s = 0.f;
#pragma unroll
            for (int wv = 0; wv < 8; ++wv) s += red[wv * 16 + tid];
            fin[tid] = s; }
        asm volatile("s_waitcnt lgkmcnt(0)\n\ts_barrier" ::: "memory");
#pragma unroll
        for (int t = 0; t < 8; ++t) {
            const float mean = fin[2 * t] * (1.0f / CCH), var = fin[2 * t + 1] * (1.0f / CCH) - mean * mean, rstd = rsqrtf(fmaxf(var, 0.f) + EPS);
            const f32x2 y = (c[t] - mean) * rstd * g + be;
            const float o0 = y[0] * sigmoidf_(y[0]), o1 = y[1] * sigmoidf_(y[1]);
            *(unsigned*)(MIX + (size_t)(b * SEQ + s0 + 8 * ck + t) * DM + 1024 + 2 * tid) = pk2(o0, o1);
        }
        if (ck == 0 && xpre) {
            const float* xr = xpre + (size_t)(wave * 32) * DM + lane * 4;
#pragma unroll 8
            for (int i = 0; i < 32; ++i) glds16_pf(xr + (size_t)i * DM, (unsigned)(PF_LDS_OFF + wave * 1024));
        }
    }
    asm volatile("s_waitcnt lgkmcnt(0)\n\ts_barrier" ::: "memory");
}

__device__ __forceinline__ void sample_att(LAS unsigned char* lds, int b, const float* ZS, const float* cache_k, const float* cache_v, const float* state,
                                             const float* gq, const float* gk, const float* sinks, const float* cw, const float* cb, const float* lg, const float* lb,
                                             const float* cosT, const float* sinT, float* out, bf16* MIX, int tid, int wave, int lane) {
    LAS float* zs = (LAS float*)lds;
    LAS float* qs = zs + 3584;
    LAS float* kn = qs + 1024;
    LAS float* vn = kn + 256;
    LAS float* sc = vn + 256;
    LAS float* rd = sc + 2048;
    LAS float* part = rd + 16;
    for (int i = tid; i < INC; i += 512) zs[i] = ZS[b * INC + i];
    __syncthreads();
    for (int hh = wave; hh < 20; hh += 8) {
        const int base = hh < 16 ? 64 * hh : 1024 + 64 * (hh - 16);
        const float x = zs[base + lane];
        const float rstd = rsqrtf(wave_sum(x * x) * (1.0f / 64.0f) + EPS);
        const float y = x * rstd * (hh < 16 ? gq : gk)[lane];
        const float p = __shfl_xor(y, 32);
        const float co = cosT[2048 * 32 + (lane & 31)], si = sinT[2048 * 32 + (lane & 31)];
        const float o = lane < 32 ? y * co - p * si : y * co + p * si;
        if (hh < 16) qs[hh * 64 + lane] = o * 0.125f;
        else { kn[(hh - 16) * 64 + lane] = o; out[O_KS + ((size_t)(b * 128 + 127) * 4 + (hh - 16)) * 64 + lane] = o; }
    }
    if (tid < 256) { const float vv = zs[1280 + tid]; vn[tid] = vv; out[O_VS + (size_t)(b * 128 + 127) * 256 + tid] = vv; }
    __syncthreads();
    {
        const int jj = tid >> 2, kh = tid & 3, j = jj + 1;
        float d0 = 0.f, d1 = 0.f, d2 = 0.f, d3 = 0.f;
        const LAS float* q0 = qs + (4 * kh) * 64;
        if (j < 128) {
            const f32x4* kr = (const f32x4*)(cache_k + ((size_t)(b * 128 + j) * 4 + kh) * 64);
#pragma unroll
            for (int d4 = 0; d4 < 16; ++d4) { const f32x4 kv = kr[d4];
                d0 += dot4(kv, *(const LAS f32x4*)(q0 + 4 * d4)); d1 += dot4(kv, *(const LAS f32x4*)(q0 + 64 + 4 * d4));
                d2 += dot4(kv, *(const LAS f32x4*)(q0 + 128 + 4 * d4)); d3 += dot4(kv, *(const LAS f32x4*)(q0 + 192 + 4 * d4)); }
        } else {
#pragma unroll 4
            for (int d4 = 0; d4 < 16; ++d4) { const f32x4 kv = *(const LAS f32x4*)(kn + kh * 64 + 4 * d4);
                d0 += dot4(kv, *(const LAS f32x4*)(q0 + 4 * d4)); d1 += dot4(kv, *(const LAS f32x4*)(q0 + 64 + 4 * d4));
                d2 += dot4(kv, *(const LAS f32x4*)(q0 + 128 + 4 * d4)); d3 += dot4(kv, *(const LAS f32x4*)(q0 + 192 + 4 * d4)); }
        }
        sc[(4 * kh + 0) * 128 + jj] = d0; sc[(4 * kh + 1) * 128 + jj] = d1; sc[(4 * kh + 2) * 128 + jj] = d2; sc[(4 * kh + 3) * 128 + jj] = d3;
    }
    __syncthreads();
    for (int h = 2 * wave; h < 2 * wave + 2; ++h) {
        const float a = sc[h * 128 + lane], c2 = sc[h * 128 + 64 + lane], sink = sinks[h];
        const float m = fmaxf(wave_max(fmaxf(a, c2)), sink);
        const float pa = __expf(a - m), pb = __expf(c2 - m);
        const float den = wave_sum(pa + pb) + __expf(sink - m), inv = 1.0f / den;
        sc[h * 128 + lane] = pa * inv; sc[h * 128 + 64 + lane] = pb * inv;
    }
    __syncthreads();
    {
        const int d = tid & 63, kg = wave;
#pragma unroll 1
        for (int kh = 0; kh < 4; ++kh) {
            float vv[16];
#pragma unroll
            for (int t = 0; t < 16; ++t) { const int jj = 16 * kg + t;
                vv[t] = (jj < 127) ? cache_v[((size_t)(b * 128 + jj + 1) * 4 + kh) * 64 + d] : vn[kh * 64 + d]; }
            float a0 = 0.f, a1 = 0.f, a2 = 0.f, a3 = 0.f;
            const LAS float* sp = sc + (4 * kh) * 128 + 16 * kg;
#pragma unroll
            for (int t = 0; t < 16; ++t) { a0 += sp[t] * vv[t]; a1 += sp[128 + t] * vv[t]; a2 += sp[256 + t] * vv[t]; a3 += sp[384 + t] * vv[t]; }
            LAS float* pp = part + (kg * 16 + 4 * kh) * 64 + d;
            pp[0] = a0; pp[64] = a1; pp[128] = a2; pp[192] = a3;
        }
        __syncthreads();
#pragma unroll
        for (int hi = 0; hi < 2; ++hi) {
            const int h = (tid >> 6) + 8 * hi; float o = 0.f;
#pragma unroll
            for (int k8 = 0; k8 < 8; ++k8) o += part[(k8 * 16 + h) * 64 + d];
            MIX[(size_t)(MP + b) * DM + 64 * h + d] = (bf16)f2bf(o);
        }
    }
    __syncthreads();
}
__device__ __forceinline__ void sample_conv(LAS unsigned char* lds, int b, const float* ZS, const float* cache_k, const float* cache_v, const float* state,
                                             const float* gq, const float* gk, const float* sinks, const float* cw, const float* cb, const float* lg, const float* lb,
                                             const float* cosT, const float* sinT, float* out, bf16* MIX, int tid, int wave, int lane) {
    LAS float* zs = (LAS float*)lds;
    LAS float* qs = zs + 3584;
    LAS float* kn = qs + 1024;
    LAS float* vn = kn + 256;
    LAS float* sc = vn + 256;
    LAS float* rd = sc + 2048;
    LAS float* part = rd + 16;
    for (int i = 1536 + tid; i < INC; i += 512) zs[i] = ZS[b * INC + i];
    __syncthreads();
    {
        const int ch = 2 * tid;
        const float u0 = zs[1536 + ch] * sigmoidf_(zs[2560 + ch]), u1 = zs[1536 + ch + 1] * sigmoidf_(zs[2560 + ch + 1]);
        *(f32x2*)(out + O_CS + (size_t)(b * 30 + 29) * 1024 + ch) = (f32x2){u0, u1};
        f32x2 c = *(const f32x2*)(cb + ch);
#pragma unroll 10
        for (int j = 0; j < 30; ++j) c = c + *(const f32x2*)(cw + j * 1024 + ch) * *(const f32x2*)(state + (size_t)(b * 30 + j) * 1024 + ch);
        c = c + *(const f32x2*)(cw + 30 * 1024 + ch) * (f32x2){u0, u1};
        const float s1 = wave_sum(c[0] + c[1]), s2 = wave_sum(c[0] * c[0] + c[1] * c[1]);
        if (lane == 0) { rd[wave * 2] = s1; rd[wave * 2 + 1] = s2; }
        __syncthreads();
        float t1 = 0.f, t2 = 0.f;
#pragma unroll
        for (int wv = 0; wv < 8; ++wv) { t1 += rd[wv * 2]; t2 += rd[wv * 2 + 1]; }
        const float mean = t1 * (1.0f / CCH), var = t2 * (1.0f / CCH) - mean * mean, rstd = rsqrtf(fmaxf(var, 0.f) + EPS);
        const f32x2 y = (c - mean) * rstd * *(const f32x2*)(lg + ch) + *(const f32x2*)(lb + ch);
        *(unsigned*)(MIX + (size_t)(MP + b) * DM + 1024 + ch) = pk2(y[0] * sigmoidf_(y[0]), y[1] * sigmoidf_(y[1]));
    }
    __syncthreads();
}

#ifndef MK_DUP
#define MK_DUP (-1)
#endif
#define REPS(k)
#ifndef MK_CG_SEAMS
#define MK_CG_SEAMS 0
#endif
#define P2_CVT() do { const DecDn D{w_down, WdnT}; cvt_items<3>((LAS float*)(lds + wave * 16384), bx * NWAVES + wave, (FF / 64) * (DM / 32), ncv * NWAVES, lane, D); \
                const int gt = bx * (NWAVES * 64) + tid, NT = ncv * NWAVES * 64;        \
                for (int i = gt; i < 32 * 8128; i += NT) { const int b = i / 8128, o = i % 8128; \
                    ((f32x4*)(out + O_KS + (size_t)b * 32768))[o] = ((const f32x4*)(cache_k + (size_t)b * 32768 + 256))[o]; \
                    ((f32x4*)(out + O_VS + (size_t)b * 32768))[o] = ((const f32x4*)(cache_v + (size_t)b * 32768 + 256))[o]; } \
                for (int i = gt; i < 32 * 7424; i += NT) { const int b = i / 7424, o = i % 7424; \
                    ((f32x4*)(out + O_CS + (size_t)b * 30720))[o] = ((const f32x4*)(state + (size_t)b * 30720 + 1024))[o]; } } while (0)
struct Args { const float* in[18]; float* out; unsigned char* ws; int ph_lo, ph_hi, dry, pad; };
__global__ void __launch_bounds__(NWAVES * 64, 2) mk_fwd(Args args) {
    extern __shared__ __attribute__((aligned(16))) unsigned char lds_raw[];
    LAS unsigned char* lds = (LAS unsigned char*)lds_raw;
    const int wave_k = __builtin_amdgcn_readfirstlane((int)threadIdx.x >> 6);
    const int tid = wave_k * 64 + mk_fresh_lane();
    const int G = gridDim.x, bx = blockIdx.x;
    const int vcu = (G % 8 == 0) ? (bx % 8) * (G / 8) + bx / 8 : bx;
    unsigned char* ws = args.ws;
    const float *xp = args.in[0], *xs = args.in[1], *cache_k = args.in[2], *cache_v = args.in[3], *state = args.in[4], *g_mix = args.in[5], *w_in = args.in[6],
                *gq = args.in[7], *gk = args.in[8], *sinks = args.in[9], *conv_w = args.in[10], *conv_b = args.in[11], *ln_g = args.in[12], *ln_b = args.in[13],
                *w_out = args.in[14], *g_mlp = args.in[15], *w_up = args.in[16], *w_down = args.in[17];
    float* out = args.out;
    float* SSQ = (float*)(ws + WS_SSQ); float* SSQ0 = (float*)(ws + WS_SSQ0); float* cosT = (float*)(ws + WS_COS); float* sinT = (float*)(ws + WS_SIN); float* ZS = (float*)(ws + WS_ZS);
    bf16 *WinT = (bf16*)(ws + WS_WIN), *WoutT = (bf16*)(ws + WS_WOUT), *WupT = (bf16*)(ws + WS_WUP), *WdnT = (bf16*)(ws + WS_WDN);
    bf16 *X1G = (bf16*)(ws + WS_X1G), *HID = (bf16*)(ws + WS_HID), *XN = (bf16*)(ws + WS_XN), *Qb = (bf16*)(ws + WS_Q), *Kb = (bf16*)(ws + WS_K), *Vb = (bf16*)(ws + WS_V),
         *Ub = (bf16*)(ws + WS_U), *MIX = (bf16*)(ws + WS_MIX);
    for (int u = tid; u < (LDS_BYTES - LDSCTL_OFF) / 4; u += NWAVES * 64) ((LAS unsigned*)(lds + LDSCTL_OFF))[u] = 0u;
    __syncthreads();
    volatile LAS unsigned* MISC = (volatile LAS unsigned*)(lds + MISC_OFF);
    XcdBarrier bar; bar.bar = (unsigned*)(ws + WS_CTL) + CW_BAR; bar.x = 0; bar.st = nullptr;
    if (MK_N_LAUNCHES == 1) bar = xcd_barrier_post((unsigned*)(ws + WS_CTL) + CW_BAR, MISC + 8);
#define GRID_BAR(seam) do { if (MK_N_LAUNCHES == 1) { if ((MK_CG_SEAMS >> (seam)) & 1) cg::this_grid().sync(); else xcd_barrier(bar); } STAMP((seam) + 1); } while (0)
#define FRESH_IDS() const int wave = wave_k; int tid = wave * 64 + mk_fresh_lane(); asm volatile("" : "+v"(tid)); const int lane = tid & 63; (void)lane
#ifdef MK_TA
    unsigned long long* TS = (unsigned long long*)(ws + WS_SSQ + 128 * 1024);
#define STAMP(k) do { if (bx == G - 1 && tid == 0) TS[k] = __builtin_amdgcn_s_memrealtime(); } while (0)
#else
#define STAMP(k) do { } while (0)
#endif
    STAMP(0);
    const int lo = args.ph_lo, hi = args.ph_hi;
#ifndef MK_PLAIN
    if (args.pad == 0x5eed) cg::this_grid().sync();
#endif
#define IN(k) (lo <= (k) && (k) < hi)

    if (IN(0)) { REPS(0) {
        FRESH_IDS();
        LAS float* scr = (LAS float*)(lds + wave * 16384);
        const int gw = vcu * NWAVES + wave, NGW = G * NWAVES;
        { const DecP0 D{w_in, WinT, g_mix}; cvt_items<3>(scr, gw, (DM / 64) * (INC / 32), NGW, lane, D); }
        for (int m = gw; m < MT; m += NGW) row_to_bf16(m < MP ? xp + (size_t)m * DM : xs + (size_t)(m - MP) * DM, XN + (size_t)m * DM, SSQ0 + m, lane);
        const int gt = vcu * (NWAVES * 64) + tid, NT = G * NWAVES * 64;
        for (int i = gt; i < 2049 * 32; i += NT) {
            const int pos = i >> 5, k = i & 31; double inv = 1.0;
            for (int j = 0; j < k; ++j) inv *= 0.7498942093324559;
            const float ang = (pos == 2048 ? 16384.0f : (float)pos) * (float)inv;
            double rev = (double)ang * 0.15915494309189535; rev -= __builtin_rint(rev);
            const float rf = (float)rev;
            cosT[i] = __builtin_amdgcn_cosf(rf); sinT[i] = __builtin_amdgcn_sinf(rf);
        }
        }
        if (IN(1)) GRID_BAR(0);
    }
    if (IN(1)) { REPS(1) {
        const int nun = (MP / 256) * (INC / 256), rounds = (nun + G - 1) / G, GG = (nun + rounds - 1) / rounds, nsv = G - GG;
        if (bx < GG) {
            pg8::Gemm g{XN, WinT, MP, INC, DM}; pg8::StaticOrder S; S.init(MP, INC, GG, bx);
            Epi1 E{Qb, Kb, Vb, Ub, out, gq, gk, cosT, sinT, SSQ0};
            pg8::gemm_phase<Epi1, pg8::StaticOrder, true, true>(lds, g, S, E, wave_k);
        }
        FRESH_IDS();
        STAMP(9);
        EpiS1 ES{ZS, SSQ0};
        skinny_phase(lds, XN + (size_t)MP * DM, WinT, INC, DM, bx, G, ES, wave_k);
        {   const DecUp D{w_up, w_out, WupT, WoutT, g_mlp}; constexpr int NIT = (DM / 64) * (FF / 32) + (DM / 64) * (DM / 32);
            if (nsv > 0) { if (bx >= GG) cvt_items<5>((LAS float*)(lds + wave * 16384), (bx - GG) * NWAVES + wave, NIT, nsv * NWAVES, lane, D); }
            else cvt_items<5>((LAS float*)(lds + wave * 16384), bx * NWAVES + wave, NIT, G * NWAVES, lane, D);
        }
        }
        STAMP(12);
        if (IN(2)) GRID_BAR(1);
    }
    if (IN(2)) { REPS(2) {
        FRESH_IDS();
        const int ncv = G > 2 * MS ? G - 2 * MS : G;
        const bool cvt_first = bx < ncv && ((bx >> 3) & 1);
        if (cvt_first) { P2_CVT(); __syncthreads(); }
        for (int a = vcu; a < 256; a += G) attn_unit(lds, a >> 6, (a >> 2) & 15, a & 3, Qb, Kb, Vb, MIX, sinks, tid, wave, lane);
        STAMP(6);
        for (int c = vcu; c < 256; c += G) conv_unit(lds, c >> 6, c & 63, Ub, MIX, conv_w, conv_b, ln_g, ln_b, nullptr, tid, wave, lane);
        STAMP(7);
        if (bx < ncv && !cvt_first) { P2_CVT(); __syncthreads(); }
        for (int j = G - 1 - bx; j < 2 * MS; j += G) {
            if (j < MS) sample_att(lds, j, ZS, cache_k, cache_v, state, gq, gk, sinks, conv_w, conv_b, ln_g, ln_b, cosT, sinT, out, MIX, tid, wave, lane);
            else sample_conv(lds, j - MS, ZS, cache_k, cache_v, state, gq, gk, sinks, conv_w, conv_b, ln_g, ln_b, cosT, sinT, out, MIX, tid, wave, lane);
        }
        }
        STAMP(11);
        if (IN(3)) GRID_BAR(2);
    }
    if (IN(3)) {
        pg8::Gemm g{MIX, WoutT, MP, DM, DM}; pg8::StaticOrder S; S.init(MP, DM, G, bx);
        Epi3 E{XN, out + O_YP, X1G, g_mlp, args.dry ? SSQ + 16384 : SSQ};
        pg8::gemm_phase<Epi3, pg8::StaticOrder, true, true>(lds, g, S, E, wave_k);
        STAMP(13);
        EpiS3 ES{xs, out + O_YP, X1G, g_mlp, args.dry ? SSQ + 16384 : SSQ};
        skinny_phase(lds, MIX + (size_t)MP * DM, WoutT, DM, DM, G - 1 - bx, G, ES, wave_k);
        if (IN(4)) GRID_BAR(3);
    }
    if (IN(4)) { REPS(4) {
        pg8::Gemm g{X1G, WupT, MP, FF, DM}; pg8::StaticOrder S; S.init(MP, FF, G, bx);
        Epi4 E{SSQ, HID};
        EpiS4 ES{SSQ, HID};
        if (bx & 1) skinny_phase(lds, X1G + (size_t)MP * DM, WupT, FF, DM, G - 1 - bx, G, ES, wave_k);
        pg8::gemm_phase<Epi4, pg8::StaticOrder, true, true>(lds, g, S, E, wave_k);
        if (!(bx & 1)) skinny_phase(lds, X1G + (size_t)MP * DM, WupT, FF, DM, G - 1 - bx, G, ES, wave_k);
        }
        if (IN(5)) GRID_BAR(4);
    }
    if (IN(5)) {
        pg8::Gemm g{HID, WdnT, MP, DM, FF}; pg8::StaticOrder S; S.init(MP, DM, G, bx);
        Epi5 E{out + O_YP, X1G};
        pg8::gemm_phase<Epi5, pg8::StaticOrder, true, true>(lds, g, S, E, wave_k);
#ifdef MK_TA
        STAMP(8); __syncthreads();
        EpiS5 ES{out + O_YP, X1G, bx == G - 1 ? 1.0f + 1e-4f * (float)(long long)(__hip_atomic_load(TS + MK_TB, __ATOMIC_RELAXED, __HIP_MEMORY_SCOPE_AGENT) - __hip_atomic_load(TS + MK_TA, __ATOMIC_RELAXED, __HIP_MEMORY_SCOPE_AGENT)) : 1.0f};
#else
        EpiS5 ES{out + O_YP, X1G, 1.0f};
#endif
        skinny_phase(lds, HID + (size_t)MP * FF, WdnT, DM, FF, G - 1 - bx, G, ES, wave_k);
    }
#undef IN
}

extern "C" void kernel_launch(void* const* d_in, const int* in_sizes, int n_in, void* d_out, int out_size, void* d_ws, size_t ws_size, hipStream_t stream) {
    static int grid = 0;
    if (grid == 0) {
        if (n_in != 18 || (size_t)out_size != O_END || ws_size < WS_END) { fprintf(stderr, "kernel_launch: unexpected shapes: n_in %d out %d ws %zu\n", n_in, out_size, ws_size); grid = -1; return; }
        int dev = 0, cus = 0, per_cu = 0;
        if (hipGetDevice(&dev) != hipSuccess || hipDeviceGetAttribute(&cus, hipDeviceAttributeMultiprocessorCount, dev) != hipSuccess) { grid = -1; return; }
        if (hipFuncSetAttribute((const void*)mk_fwd, hipFuncAttributeMaxDynamicSharedMemorySize, LDS_BYTES) != hipSuccess) { fprintf(stderr, "kernel_launch: hipFuncSetAttribute failed\n"); grid = -1; return; }
        if (hipOccupancyMaxActiveBlocksPerMultiprocessor(&per_cu, (const void*)mk_fwd, NWAVES * 64, LDS_BYTES) != hipSuccess || per_cu < 1) { fprintf(stderr, "kernel_launch: occupancy query says %d\n", per_cu); (void)hipGetLastError(); grid = -1; return; }
        grid = cus;
    }
    if (grid < 0) return;
    (void)hipMemsetAsync((char*)d_ws + WS_CTL, 0, CTL_ZERO_BYTES, stream);
    Args a{};
    for (int i = 0; i < 18; ++i) a.in[i] = (const float*)d_in[i];
    a.out = (float*)d_out; a.ws = (unsigned char*)d_ws;
#if MK_N_LAUNCHES == 1 && defined(MK_PLAIN)
    a.ph_lo = 0; a.ph_hi = 6;
    hipLaunchKernelGGL(mk_fwd, dim3(grid), dim3(NWAVES * 64), LDS_BYTES, stream, a);
#elif MK_N_LAUNCHES == 1
    a.ph_lo = 0; a.ph_hi = 6;
    void* params[] = {&a};
    hipError_t e = hipLaunchCooperativeKernel((const void*)mk_fwd, dim3(grid), dim3(NWAVES * 64), params, LDS_BYTES, stream);
    if (e != hipSuccess) fprintf(stderr, "kernel_launch: cooperative launch failed: %s (grid %d)\n", hipGetErrorString(e), grid);
#else
    for (int p = 0; p < 6; ++p) for (int rep = 0; rep < (p == MK_DUP ? 2 : 1); ++rep) { a.ph_lo = p; a.ph_hi = p + 1; a.dry = (p == MK_DUP && rep == 0 && (p == 3 || p == 5)) ? 1 : 0; hipLaunchKernelGGL(mk_fwd, dim3(grid), dim3(NWAVES * 64), LDS_BYTES, stream, a); }
#endif
}
```

```cpp
#include <hip/hip_runtime.h>
#include <hip/hip_cooperative_groups.h>
#include <cstdio>
#include <cstdint>
namespace cg = cooperative_groups;
__device__ __forceinline__ int mk_fresh_lane() { int l; asm volatile("v_mbcnt_lo_u32_b32 %0, -1, 0\n\tv_mbcnt_hi_u32_b32 %0, -1, %0" : "=v"(l)); return l; }
#define MK_PLAIN 1
#define MK_N_LAUNCHES 1
namespace pg8 {
#define PG8_LAS __attribute__((address_space(3)))
typedef unsigned short bf16_t;
typedef short bf16x8 __attribute__((ext_vector_type(8)));
typedef float f32x4 __attribute__((ext_vector_type(4)));
typedef unsigned u32x4 __attribute__((ext_vector_type(4)));
constexpr int BM = 256, BK = 64, HALF = 128, HTB = HALF * BK * 2  , STAGE_BYTES = 8 * HTB, NXCD = 8, WGM = 8;

__host__ __device__ __forceinline__ int lds_byte(int r, int c) { const int st = (r >> 4) * 2 + (c >> 5), rr = r & 15, cc = c & 31, ob = rr * 64 + cc * 2; return st * 1024 + (ob ^ (((ob >> 9) & 1) << 5)); }
__host__ __device__ __forceinline__ void stage_rc(int b, int& R, int& C) { const int st = b / 1024, sb = b % 1024, swz = sb ^ (((sb >> 9) & 1) << 5); R = (st >> 1) * 16 + swz / 64; C = (st & 1) * 32 + (swz % 64) / 2; }
__host__ __device__ __forceinline__ int perm32(int rho) { const int n = rho >> 4, i = rho & 15; return 8 * (i >> 2) + 4 * n + (i & 3); }

struct Unit { int pm, pn; };
struct Gemm { const bf16_t* A; const bf16_t* Bt; int M, N, K; };

struct StaticOrder {
    int nM, nN, nwg, G, c;
    __host__ __device__ void init(int M, int N, int G_, int c_) { nM = M / BM; nN = N / BM; nwg = nM * nN; G = G_; c = c_; }
    __host__ __device__ bool next(int i, Unit& u) const {
        const long L = (long)i * G + c; if (L >= nwg) return false;
        int wgid = (int)L; { const int q = nwg / NXCD, r = nwg % NXCD, xcd = wgid % NXCD, off = wgid / NXCD; wgid = (xcd < r ? xcd * (q + 1) : r * (q + 1) + (xcd - r) * q) + off; }
        const int nig = WGM * nN, gid = wgid / nig, fm = gid * WGM, gsz = (nM - fm) < WGM ? (nM - fm) : WGM;
        u.pm = fm + ((wgid % nig) % gsz); u.pn = (wgid % nig) / gsz; return true;
    }
    __device__ __forceinline__ void a_ready(const Unit&) const {}
    __device__ __forceinline__ void done(const Unit&) const {}
};

__device__ __forceinline__ unsigned cvt_pk_bf16(float lo, float hi) { unsigned r; asm volatile("v_cvt_pk_bf16_f32 %0, %1, %2" : "=v"(r) : "v"(lo), "v"(hi)); return r; }
typedef float f32x2 __attribute__((ext_vector_type(2)));
template <class Epi, class Sched, bool ALIGN_EPI = false, bool SP2 = false>
__device__ __forceinline__ void gemm_phase(PG8_LAS unsigned char* lds, const Gemm g, const Sched& S, const Epi& E, const int wid_in) {
    const int wid = wid_in; int tid = wid * 64 + mk_fresh_lane(); asm volatile("" : "+v"(tid));
    const int lane = tid & 63, wr = wid >> 2, wc = wid & 3, fr = lane & 15, fq = lane >> 4;
    const int K = g.K, nt = K / BK;
    unsigned voffA[2], voffB[2];
#pragma unroll
    for (int i = 0; i < 2; ++i) { int R, C; stage_rc(tid * 16 + i * 8192, R, C); const int Rb = Epi::PERM ? ((R & ~31) + perm32(R & 31)) : R;
        voffA[i] = (unsigned)(R * K + C) * 2u; voffB[i] = (unsigned)(Rb * K + C) * 2u; }
    const size_t kstep = (size_t)(BK * 2);
    const size_t hstep = (size_t)HALF * K * 2;
    const size_t tstep = 2 * hstep;
    const unsigned ldsw = (unsigned)wid * 1024u;
    const int aoff = lds_byte(wr * 64 + fr, fq * 8), boff = lds_byte(wc * 32 + fr, fq * 8);
#define PG8_SA(b, h) (((b) * 2 + (h)) * HTB)
#define PG8_SB(b, h) ((4 + (b) * 2 + (h)) * HTB)
#define PG8_STAGE(bufoff, gbase, voff) do { _Pragma("unroll") for (int _i = 0; _i < 2; ++_i) \
        __builtin_amdgcn_global_load_lds((const unsigned*)((const char*)(gbase) + (voff)[_i]), (PG8_LAS unsigned*)(lds + (bufoff) + ldsw + _i * 8192), 16, 0, 0); } while (0)
#define PG8_LDA(dst, b, h) do { _Pragma("unroll") for (int m = 0; m < 4; ++m) _Pragma("unroll") for (int k = 0; k < 2; ++k) dst[m][k] = *(const PG8_LAS bf16x8*)(lds + PG8_SA(b, h) + aoff + m * 2048 + k * 1024); } while (0)
#define PG8_LDB(dst, b, h) do { _Pragma("unroll") for (int n = 0; n < 2; ++n) _Pragma("unroll") for (int k = 0; k < 2; ++k) dst[n][k] = *(const PG8_LAS bf16x8*)(lds + PG8_SB(b, h) + boff + n * 2048 + k * 1024); } while (0)
#define PG8_MMA(ai, bj, At, Bt) do { __builtin_amdgcn_s_setprio(1); _Pragma("unroll") for (int m = 0; m < 4; ++m) _Pragma("unroll") for (int n = 0; n < 2; ++n) _Pragma("unroll") for (int k = 0; k < 2; ++k) \
        acc[ai][bj][m][n] = __builtin_amdgcn_mfma_f32_16x16x32_bf16(Bt[n][k], At[m][k], acc[ai][bj][m][n], 0, 0, 0); __builtin_amdgcn_s_setprio(0); } while (0)
#define PG8_WAIT_V(n) asm volatile("s_waitcnt vmcnt(" #n ")" ::: "memory")
#define PG8_WAIT_L(n) asm volatile("s_waitcnt lgkmcnt(" #n ")" ::: "memory")
#define PG8_BAR __builtin_amdgcn_s_barrier()
#define PG8_SCHED __builtin_amdgcn_sched_barrier(0)
    Unit cur, nxt; int ui = 0;
    if (!S.next(0, cur)) return;
    f32x4 acc[2][2][4][2];
#pragma unroll
    for (int a = 0; a < 2; ++a)
#pragma unroll
        for (int b = 0; b < 2; ++b)
#pragma unroll
            for (int m = 0; m < 4; ++m)
#pragma unroll
                for (int n = 0; n < 2; ++n) acc[a][b][m][n] = (f32x4){0.f, 0.f, 0.f, 0.f};
    bf16x8 At[4][2], B0[2][2], B1[2][2];
    const char* cA = (const char*)g.A + (size_t)cur.pm * tstep; const char* cB = (const char*)g.Bt + (size_t)cur.pn * tstep;
    S.a_ready(cur);
    if constexpr (SP2) {
        PG8_STAGE(PG8_SB(0, 0), cB, voffB); PG8_STAGE(PG8_SB(0, 1), cB + hstep, voffB); PG8_STAGE(PG8_SA(0, 0), cA, voffA); PG8_STAGE(PG8_SA(0, 1), cA + hstep, voffA);
        if (wr == 1) PG8_BAR;
        PG8_WAIT_V(2); PG8_BAR;
        PG8_STAGE(PG8_SB(1, 0), cB + kstep, voffB); PG8_STAGE(PG8_SA(1, 0), cA + kstep, voffA); PG8_STAGE(PG8_SB(1, 1), cB + hstep + kstep, voffB);
        PG8_WAIT_V(6); PG8_BAR;
    } else {
        PG8_STAGE(PG8_SB(0, 0), cB, voffB); PG8_STAGE(PG8_SA(0, 0), cA, voffA); PG8_STAGE(PG8_SB(0, 1), cB + hstep, voffB); PG8_STAGE(PG8_SA(0, 1), cA + hstep, voffA);
        if (wr == 1) PG8_BAR;
        PG8_WAIT_V(4); PG8_BAR;
        PG8_STAGE(PG8_SB(1, 0), cB + kstep, voffB); PG8_STAGE(PG8_SA(1, 0), cA + kstep, voffA); PG8_STAGE(PG8_SB(1, 1), cB + hstep + kstep, voffB);
        PG8_WAIT_V(6); PG8_BAR;
    }
    for (;;) {
        const bool has_next = S.next(ui + 1, nxt);
        const char* nA = has_next ? (const char*)g.A + (size_t)nxt.pm * tstep : cA; const char* nB = has_next ? (const char*)g.Bt + (size_t)nxt.pn * tstep : cB;
        for (int t = 0; t < nt; t += 2) {
            const bool last = (t == nt - 2);
            const char* a1 = cA + (size_t)(t + 1) * kstep;
            const char* a2 = last ? nA : cA + (size_t)(t + 2) * kstep; const char* b2 = last ? nB : cB + (size_t)(t + 2) * kstep;
            const char* a3 = a2 + kstep; const char* b3 = b2 + kstep;
            if (last && has_next) S.a_ready(nxt);
            if constexpr (SP2) {
            PG8_LDB(B0, 0, 0); PG8_LDB(B1, 0, 1); PG8_SCHED; PG8_LDA(At, 0, 0); PG8_STAGE(PG8_SA(1, 1), a1 + hstep, voffA);
            PG8_WAIT_V(8); PG8_WAIT_L(0); PG8_BAR; PG8_MMA(0, 0, At, B0); PG8_MMA(0, 1, At, B1); PG8_BAR; PG8_SCHED;
            PG8_LDA(At, 0, 1); PG8_STAGE(PG8_SB(0, 0), b2, voffB); PG8_STAGE(PG8_SB(0, 1), b2 + hstep, voffB); PG8_STAGE(PG8_SA(0, 0), a2, voffA);
            PG8_WAIT_V(8); PG8_WAIT_L(0); PG8_BAR; PG8_MMA(1, 0, At, B0); PG8_MMA(1, 1, At, B1); PG8_BAR; PG8_SCHED;
            PG8_LDB(B0, 1, 0); PG8_LDB(B1, 1, 1); PG8_SCHED; PG8_LDA(At, 1, 0); PG8_STAGE(PG8_SA(0, 1), a2 + hstep, voffA);
            PG8_WAIT_V(8); PG8_WAIT_L(0); PG8_BAR; PG8_MMA(0, 0, At, B0); PG8_MMA(0, 1, At, B1); PG8_BAR; PG8_SCHED;
            PG8_LDA(At, 1, 1); PG8_STAGE(PG8_SB(1, 0), b3, voffB); PG8_STAGE(PG8_SB(1, 1), b3 + hstep, voffB); PG8_STAGE(PG8_SA(1, 0), a3, voffA);
            PG8_WAIT_V(8); PG8_WAIT_L(0); PG8_BAR; PG8_MMA(1, 0, At, B0); PG8_MMA(1, 1, At, B1); PG8_BAR; PG8_SCHED;
            } else {
            PG8_LDB(B0, 0, 0); PG8_SCHED; PG8_LDA(At, 0, 0); PG8_STAGE(PG8_SA(1, 1), a1 + hstep, voffA);
            PG8_WAIT_L(8); PG8_BAR; PG8_WAIT_L(0); PG8_MMA(0, 0, At, B0); PG8_BAR; PG8_SCHED;
            PG8_LDB(B1, 0, 1); PG8_STAGE(PG8_SB(0, 0), b2, voffB);
            PG8_BAR; PG8_WAIT_L(0); PG8_MMA(0, 1, At, B1); PG8_BAR;
            PG8_LDA(At, 0, 1); PG8_STAGE(PG8_SA(0, 0), a2, voffA);
            PG8_BAR; PG8_WAIT_L(0); PG8_MMA(1, 0, At, B0); PG8_BAR; PG8_SCHED;
            PG8_STAGE(PG8_SB(0, 1), b2 + hstep, voffB);
            PG8_WAIT_V(6); PG8_BAR; PG8_MMA(1, 1, At, B1); PG8_BAR;
            PG8_LDB(B0, 1, 0); PG8_SCHED; PG8_LDA(At, 1, 0); PG8_STAGE(PG8_SA(0, 1), a2 + hstep, voffA);
            PG8_WAIT_L(8); PG8_BAR; PG8_WAIT_L(0); PG8_MMA(0, 0, At, B0); PG8_BAR; PG8_SCHED;
            PG8_LDB(B1, 1, 1); PG8_STAGE(PG8_SB(1, 0), b3, voffB);
            PG8_BAR; PG8_WAIT_L(0); PG8_MMA(0, 1, At, B1); PG8_BAR;
            PG8_LDA(At, 1, 1); PG8_STAGE(PG8_SA(1, 0), a3, voffA);
            PG8_BAR; PG8_WAIT_L(0); PG8_MMA(1, 0, At, B0); PG8_BAR; PG8_SCHED;
            PG8_STAGE(PG8_SB(1, 1), b3 + hstep, voffB);
            PG8_WAIT_V(6); PG8_BAR; PG8_MMA(1, 1, At, B1); PG8_BAR;
            }
        }
        if constexpr (ALIGN_EPI) { if (wr == 0) PG8_BAR; }
        if constexpr (!Epi::AFTER_DRAIN) { E(acc, cur, wr, wc, fr, fq); S.done(cur); }
        if (!has_next) break;
#pragma unroll
        for (int a = 0; a < 2; ++a)
#pragma unroll
            for (int b = 0; b < 2; ++b)
#pragma unroll
                for (int m = 0; m < 4; ++m)
#pragma unroll
                    for (int n = 0; n < 2; ++n) acc[a][b][m][n] = (f32x4){0.f, 0.f, 0.f, 0.f};
        cur = nxt; cA = nA; cB = nB; ++ui;
        if constexpr (ALIGN_EPI) { if (wr == 1) PG8_BAR; }
    }
    PG8_WAIT_V(0);
    if constexpr (!ALIGN_EPI) { if (wr == 0) PG8_BAR; }
    PG8_BAR;
    if constexpr (Epi::AFTER_DRAIN) { E.fused(acc, cur, wr, wc, fr, fq, lds, wid, lane); S.done(cur); }
#undef PG8_SA
#undef PG8_SB
#undef PG8_STAGE
#undef PG8_LDA
#undef PG8_LDB
#undef PG8_MMA
#undef PG8_WAIT_V
#undef PG8_WAIT_L
#undef PG8_BAR
#undef PG8_SCHED
}
}
#define GAS __attribute__((address_space(1)))
#define LAS __attribute__((address_space(3)))
#define XB_TMO      128
#define XB_XCNT(j)  (256  + 64 * (j))
#define XB_XSUB(j)  (1280 + 64 * (j))
#define XB_XGEN(j)  (2304 + 64 * (j))
#define XB_TOP      3328
#define XB_TOPGEN   3392
#define XCD_BAR_WORDS 3456
#define XB_SPIN_CAP (1u << 18)

__device__ __forceinline__ unsigned xb_ld(unsigned* p)              { return __hip_atomic_load(p, __ATOMIC_RELAXED, __HIP_MEMORY_SCOPE_AGENT); }
__device__ __forceinline__ unsigned xb_add(unsigned* p, unsigned v) { return __hip_atomic_fetch_add(p, v, __ATOMIC_RELAXED, __HIP_MEMORY_SCOPE_AGENT); }
__device__ __forceinline__ unsigned xb_xcc_id() { return (unsigned)__builtin_amdgcn_s_getreg((3 << 11) | 20) & 0xFu; }
#define XB_SPIN(cond, bar) do { unsigned _sp = 0; while (cond) { __builtin_amdgcn_s_sleep(1); \
    if ((++_sp & 255u) == 0u) { if (xb_ld(&(bar)[XB_TMO])) break; if (_sp > XB_SPIN_CAP) { atomicAdd(&(bar)[XB_TMO], 1u); break; } } } } while (0)

struct XcdBarrier {
    unsigned* bar; unsigned x;
    volatile LAS unsigned* st;
};

__device__ __forceinline__ XcdBarrier xcd_barrier_post(unsigned* bar, volatile LAS unsigned* st) {
    XcdBarrier b; b.bar = bar; b.x = xb_xcc_id(); b.st = st;
    if (threadIdx.x == 0) (void)xb_add(&bar[XB_XCNT(b.x)], 1u);
    return b;
}
__device__ __forceinline__ void xcd_barrier_complete(unsigned* bar, unsigned x, unsigned& nloc, unsigned& nx) {
    const unsigned G = gridDim.x * gridDim.y * gridDim.z;
    unsigned sum, cnt, mine, sp = 0u;
    for (;;) {
        sum = 0u; cnt = 0u; mine = 0u;
#pragma unroll
        for (unsigned j = 0; j < 16; ++j) { const unsigned c = xb_ld(&bar[XB_XCNT(j)]); sum += c; cnt += (c > 0u) ? 1u : 0u; mine = (j == x) ? c : mine; }
        if (sum == G) break;
        __builtin_amdgcn_s_sleep(1);
        if ((++sp & 255u) == 0u) { if (xb_ld(&bar[XB_TMO])) break; if (sp > XB_SPIN_CAP) { atomicAdd(&bar[XB_TMO], 1u); break; } }
    }
    nloc = mine > 0u ? mine : 1u; nx = cnt > 0u ? cnt : 1u;
}

__device__ __forceinline__ void xcd_barrier(const XcdBarrier& b) {
    asm volatile("s_waitcnt vmcnt(0)" ::: "memory");
    __syncthreads();
    if (threadIdx.x == 0) {
        unsigned* bar = b.bar;
        __builtin_amdgcn_s_waitcnt(0);
        unsigned nloc = b.st[0], nx = b.st[1];
        if (nloc == 0u) { xcd_barrier_complete(bar, b.x, nloc, nx); b.st[0] = nloc; b.st[1] = nx; }
        const unsigned old = xb_add(&bar[XB_XSUB(b.x)], 1u);
        const unsigned gen = old / nloc;
        if (old + 1u == (gen + 1u) * nloc) {
            __builtin_amdgcn_fence(__ATOMIC_RELEASE, "agent");
            asm volatile("s_waitcnt vmcnt(0)" ::: "memory");
            const unsigned og = xb_add(&bar[XB_TOP], 1u);
            const unsigned tg = og / nx;
            if (og + 1u == (tg + 1u) * nx) xb_add(&bar[XB_TOPGEN], 1u);
            else XB_SPIN(xb_ld(&bar[XB_TOPGEN]) == tg, bar);
            __builtin_amdgcn_fence(__ATOMIC_ACQUIRE, "agent");
            xb_add(&bar[XB_XGEN(b.x)], 1u);
            asm volatile("s_waitcnt vmcnt(0)" ::: "memory");
        } else {
            XB_SPIN(xb_ld(&bar[XB_XGEN(b.x)]) == gen, bar);
            __builtin_amdgcn_fence(__ATOMIC_ACQUIRE, "agent");
            asm volatile("s_waitcnt vmcnt(0)" ::: "memory");
        }
    }
    __syncthreads();
}

#ifndef MK_N_LAUNCHES
#define MK_N_LAUNCHES 1
#endif
constexpr int NWAVES = 8;
constexpr int DM = 2048, SEQ = 2048, NBATCH = 4, MP = NBATCH * SEQ, MS = 32, MT = MP + MS;
constexpr int INC = 3584, FF = 8192, NH = 16, NKV = 4, HD = 64, CCH = 1024, CW = 31;
constexpr float EPS = 1e-6f;
constexpr size_t O_YP = 0, O_YS = (size_t)MP * DM, O_KP = O_YS + (size_t)MS * DM, O_VP = O_KP + 131072, O_CP = O_VP + 131072,
                 O_KS = O_CP + 122880, O_VS = O_KS + 1048576, O_CS = O_VS + 1048576, O_END = O_CS + 983040;
constexpr size_t MiB = 1u << 20;
constexpr size_t WS_CTL = 0, CTL_ZERO_BYTES = 68 * 1024;
constexpr size_t WS_SSQ = 32 * 1024, WS_SSQ0 = 96 * 1024;
constexpr size_t WS_COS = 1 * MiB, WS_SIN = 2 * MiB;
constexpr size_t WS_ZS = 3 * MiB;
constexpr size_t WS_WIN = 4 * MiB, WS_WOUT = 18 * MiB, WS_WUP = 26 * MiB, WS_WDN = 58 * MiB;
constexpr size_t WS_X1G = 90 * MiB;
constexpr size_t WS_HID = 123 * MiB;
constexpr size_t WS_XN = 123 * MiB, WS_Q = 156 * MiB, WS_K = 172 * MiB, WS_V = 176 * MiB, WS_U = 180 * MiB, WS_MIX = 196 * MiB;
constexpr size_t WS_END = 256 * MiB;
static_assert(WS_HID + (size_t)MT * FF * 2 <= WS_END && WS_MIX + (size_t)MT * DM * 2 <= WS_END && WS_X1G + (size_t)MT * DM * 2 <= WS_HID, "ws map");
constexpr int CW_BAR = 4096;
constexpr int RING_BYTES = 131072, LDSCTL_OFF = RING_BYTES, MISC_OFF = LDSCTL_OFF + 320, LDS_BYTES = 147456;

typedef unsigned short bf16;
typedef unsigned v4u __attribute__((ext_vector_type(4)));
typedef unsigned v2u __attribute__((ext_vector_type(2)));
typedef float f32x4 __attribute__((ext_vector_type(4)));
typedef float f32x2 __attribute__((ext_vector_type(2)));
typedef short bf16x8 __attribute__((ext_vector_type(8)));
#define LDS_WAIT() asm volatile("s_waitcnt lgkmcnt(0)" ::: "memory")
__device__ __forceinline__ unsigned f2bf(float f) { unsigned u = __builtin_bit_cast(unsigned, f); return (u + 0x7fffu + ((u >> 16) & 1u)) >> 16; }
__device__ __forceinline__ unsigned pk2(float lo, float hi) { return pg8::cvt_pk_bf16(lo, hi); }
__device__ __forceinline__ float bf2f(unsigned h) { return __builtin_bit_cast(float, h << 16); }
template <int CTRL, int ROWMASK> __device__ __forceinline__ float dpp_get(float v) {
    return __builtin_bit_cast(float, __builtin_amdgcn_update_dpp(0, __builtin_bit_cast(int, v), CTRL, ROWMASK, 0xf, false)); }
__device__ __forceinline__ float wave_sum(float v) {
    v += dpp_get<0xB1, 0xf>(v); v += dpp_get<0x4E, 0xf>(v); v += dpp_get<0x124, 0xf>(v); v += dpp_get<0x128, 0xf>(v);
    v += dpp_get<0x142, 0xa>(v); v += dpp_get<0x143, 0xc>(v);
    return __builtin_bit_cast(float, __builtin_amdgcn_readlane(__builtin_bit_cast(int, v), 63));
}
__device__ __forceinline__ float wave_max(float v) {
    v = fmaxf(v, dpp_get<0xB1, 0xf>(v)); v = fmaxf(v, dpp_get<0x4E, 0xf>(v)); v = fmaxf(v, dpp_get<0x124, 0xf>(v)); v = fmaxf(v, dpp_get<0x128, 0xf>(v));
    const int iv = __builtin_bit_cast(int, v);
    const float a = __builtin_bit_cast(float, __builtin_amdgcn_readlane(iv, 0)), b = __builtin_bit_cast(float, __builtin_amdgcn_readlane(iv, 16)),
                c = __builtin_bit_cast(float, __builtin_amdgcn_readlane(iv, 32)), d = __builtin_bit_cast(float, __builtin_amdgcn_readlane(iv, 48));
    return fmaxf(fmaxf(a, b), fmaxf(c, d));
}
__device__ __forceinline__ float dot4(f32x4 a, f32x4 b) { return (a[0] * b[0] + a[1] * b[1]) + (a[2] * b[2] + a[3] * b[3]); }
__device__ __forceinline__ float sigmoidf_(float g) { return 1.0f / (1.0f + __expf(-g)); }

__device__ __forceinline__ int win_dst_group(int sg) {
    if (sg < 48) { const int pn = sg >> 3, wc = (sg & 7) >> 1, bj = sg & 1; return 8 * pn + 4 * bj + wc; }
    if (sg < 80) { const int cc = sg - 48; return 8 * (6 + (cc >> 2)) + (cc & 3); }
    const int cc = sg - 80; return 8 * (6 + (cc >> 2)) + 4 + (cc & 3);
}
__device__ __forceinline__ int win_logical_col(int np) {
    const int dg = np >> 5, e = np & 31, pn = dg >> 3, bj = (dg >> 2) & 1, wc = dg & 3;
    if (dg < 48) return 256 * pn + 64 * wc + 32 * bj + e;
    return (bj ? 2560 : 1536) + 128 * (pn - 6) + 32 * wc + e;
}

using pg8::Unit;
struct Epi1 {
    static constexpr bool PERM = true, AFTER_DRAIN = false;
    bf16 *Q, *K, *V, *U; float* out; const float *gq, *gk, *cosT, *sinT, *SSQ0;
    __device__ __forceinline__ void operator()(const f32x4 (&acc)[2][2][4][2], const Unit& u, int wr, int wc, int fr, int fq) const {
        const int pn = u.pn, rbase = u.pm * 256 + wr * 64 + fr;
        if (pn < 5) {
            const float* g = pn < 4 ? gq : gk; const float qs = pn < 4 ? 0.125f : 1.0f;
            const f32x4 g1a = *(const f32x4*)(g + 8 * fq), g1b = *(const f32x4*)(g + 8 * fq + 4), g2a = *(const f32x4*)(g + 32 + 8 * fq), g2b = *(const f32x4*)(g + 36 + 8 * fq);
#pragma unroll
            for (int ah = 0; ah < 4; ++ah) {
                const int ai = ah >> 1;
                f32x4 rc[4][2], rs[4][2]; float r0[4];
#pragma unroll
                for (int m = 2 * (ah & 1); m < 2 * (ah & 1) + 2; ++m) { const int s = (rbase + ai * 128 + m * 16) & (SEQ - 1);
                    r0[m] = SSQ0[rbase + ai * 128 + m * 16];
                    rc[m][0] = *(const f32x4*)(cosT + s * 32 + 8 * fq); rc[m][1] = *(const f32x4*)(cosT + s * 32 + 8 * fq + 4);
                    rs[m][0] = *(const f32x4*)(sinT + s * 32 + 8 * fq); rs[m][1] = *(const f32x4*)(sinT + s * 32 + 8 * fq + 4); }
                asm volatile("" ::: "memory");
#pragma unroll
                for (int m = 2 * (ah & 1); m < 2 * (ah & 1) + 2; ++m) {
                    const int r = rbase + ai * 128 + m * 16, s = r & (SEQ - 1), b = r >> 11;
                    const float rr = rsqrtf(r0[m] * (1.0f / DM) + EPS);
                    const f32x4 x1a = acc[ai][0][m][0] * rr, x1b = acc[ai][0][m][1] * rr, x2a = acc[ai][1][m][0] * rr, x2b = acc[ai][1][m][1] * rr;
                    float ss = (dot4(x1a, x1a) + dot4(x1b, x1b)) + (dot4(x2a, x2a) + dot4(x2b, x2b));
                    ss += __shfl_xor(ss, 16); ss += __shfl_xor(ss, 32);
                    const float rstd = rsqrtf(ss * (1.0f / 64.0f) + EPS);
                    const f32x4 y1a = x1a * rstd * g1a, y1b = x1b * rstd * g1b, y2a = x2a * rstd * g2a, y2b = x2b * rstd * g2b;
                    const f32x4 ca = rc[m][0], cb = rc[m][1], sa = rs[m][0], sb = rs[m][1];
                    const f32x4 o1a = y1a * ca - y2a * sa, o1b = y1b * cb - y2b * sb, o2a = y2a * ca + y1a * sa, o2b = y2b * cb + y1b * sb;
                    v4u w1, w2;
                    w1.x = pk2(o1a[0] * qs, o1a[1] * qs); w1.y = pk2(o1a[2] * qs, o1a[3] * qs); w1.z = pk2(o1b[0] * qs, o1b[1] * qs); w1.w = pk2(o1b[2] * qs, o1b[3] * qs);
                    w2.x = pk2(o2a[0] * qs, o2a[1] * qs); w2.y = pk2(o2a[2] * qs, o2a[3] * qs); w2.z = pk2(o2b[0] * qs, o2b[1] * qs); w2.w = pk2(o2b[2] * qs, o2b[3] * qs);
                    if (pn < 4) {
                        bf16* p = Q + (size_t)r * 1024 + 64 * (4 * pn + wc) + 8 * fq;
                        *(v4u*)p = w1; *(v4u*)(p + 32) = w2;
                    } else {
                        bf16* p = K + (size_t)r * 256 + 64 * wc + 8 * fq;
                        *(v4u*)p = w1; *(v4u*)(p + 32) = w2;
                        if (s >= SEQ - 128) {
                            float* o = out + O_KP + ((size_t)(b * 128 + s - (SEQ - 128)) * 4 + wc) * 64 + 8 * fq;
                            *(f32x4*)o = o1a; *(f32x4*)(o + 4) = o1b; *(f32x4*)(o + 32) = o2a; *(f32x4*)(o + 36) = o2b;
                        }
                    }
                }
                asm volatile("" ::: "memory");
            }
        } else if (pn == 5) {
#pragma unroll
            for (int ai = 0; ai < 2; ++ai) {
                float r0[4];
#pragma unroll
                for (int m = 0; m < 4; ++m) r0[m] = SSQ0[rbase + ai * 128 + m * 16];
                asm volatile("" ::: "memory");
#pragma unroll
                for (int m = 0; m < 4; ++m) {
                    const int r = rbase + ai * 128 + m * 16, s = r & (SEQ - 1), b = r >> 11; const float rr = rsqrtf(r0[m] * (1.0f / DM) + EPS);
#pragma unroll
                    for (int bj = 0; bj < 2; ++bj) {
                        const f32x4 v0 = acc[ai][bj][m][0] * rr, v1 = acc[ai][bj][m][1] * rr;
                        v4u w; w.x = pk2(v0[0], v0[1]); w.y = pk2(v0[2], v0[3]); w.z = pk2(v1[0], v1[1]); w.w = pk2(v1[2], v1[3]);
                        *(v4u*)(V + (size_t)r * 256 + 64 * wc + 32 * bj + 8 * fq) = w;
                        if (s >= SEQ - 128) {
                            float* o = out + O_VP + ((size_t)(b * 128 + s - (SEQ - 128)) * 4 + wc) * 64 + 32 * bj + 8 * fq;
                            *(f32x4*)o = v0; *(f32x4*)(o + 4) = v1;
                        }
                    }
                }
            }
        } else {
            const int ch = 128 * (pn - 6) + 32 * wc + 8 * fq;
#pragma unroll
            for (int ai = 0; ai < 2; ++ai) {
                float r0[4];
#pragma unroll
                for (int m = 0; m < 4; ++m) r0[m] = SSQ0[rbase + ai * 128 + m * 16];
                asm volatile("" ::: "memory");
#pragma unroll
                for (int m = 0; m < 4; ++m) {
                    const int r = rbase + ai * 128 + m * 16, s = r & (SEQ - 1), b = r >> 11;
                    const float rr = rsqrtf(r0[m] * (1.0f / DM) + EPS);
                    const f32x4 a0 = acc[ai][0][m][0] * rr, a1 = acc[ai][0][m][1] * rr, g0 = acc[ai][1][m][0] * rr, g1 = acc[ai][1][m][1] * rr;
                    f32x4 u0, u1;
#pragma unroll
                    for (int j = 0; j < 4; ++j) { u0[j] = a0[j] * sigmoidf_(g0[j]); u1[j] = a1[j] * sigmoidf_(g1[j]); }
                    v4u w; w.x = pk2(u0[0], u0[1]); w.y = pk2(u0[2], u0[3]); w.z = pk2(u1[0], u1[1]); w.w = pk2(u1[2], u1[3]);
                    *(v4u*)(U + (size_t)r * 1024 + ch) = w;
                    if (s >= SEQ - 30) {
                        float* o = out + O_CP + (size_t)(b * 30 + s - (SEQ - 30)) * 1024 + ch;
                        *(f32x4*)o = u0; *(f32x4*)(o + 4) = u1;
                    }
                }
            }
        }
    }
};
struct Epi3 {
    static constexpr bool PERM = true, AFTER_DRAIN = false;
    const bf16* XB; float* Y; bf16* X1G; const float* gm; float* SSQ;
    __device__ __forceinline__ void operator()(const f32x4 (&acc)[2][2][4][2], const Unit& u, int wr, int wc, int fr, int fq) const {
        const int rbase = u.pm * 256 + wr * 64 + fr, col0 = u.pn * 256 + wc * 32 + 8 * fq;
#pragma unroll
        for (int ai = 0; ai < 2; ++ai) {
            f32x4 pre[4][2][2];
#pragma unroll
            for (int m = 0; m < 4; ++m)
#pragma unroll
                for (int bj = 0; bj < 2; ++bj) { const v4u q = *(const v4u*)(XB + (size_t)(rbase + ai * 128 + m * 16) * DM + col0 + bj * 128);
                    pre[m][bj][0] = (f32x4){bf2f(q.x & 0xffffu), bf2f(q.x >> 16), bf2f(q.y & 0xffffu), bf2f(q.y >> 16)};
                    pre[m][bj][1] = (f32x4){bf2f(q.z & 0xffffu), bf2f(q.z >> 16), bf2f(q.w & 0xffffu), bf2f(q.w >> 16)}; }
            asm volatile("" ::: "memory");
#pragma unroll
            for (int m = 0; m < 4; ++m) {
                const int r = rbase + ai * 128 + m * 16; float ss = 0.f;
#pragma unroll
                for (int bj = 0; bj < 2; ++bj) {
                    const size_t off = (size_t)r * DM + col0 + bj * 128;
                    const f32x4 v0 = acc[ai][bj][m][0] + pre[m][bj][0], v1 = acc[ai][bj][m][1] + pre[m][bj][1];
                    ss += dot4(v0, v0) + dot4(v1, v1);
                    v4u w; w.x = pk2(v0[0], v0[1]); w.y = pk2(v0[2], v0[3]); w.z = pk2(v1[0], v1[1]); w.w = pk2(v1[2], v1[3]);
                    *(v4u*)(X1G + off) = w;
                }
                ss += __shfl_xor(ss, 16); ss += __shfl_xor(ss, 32);
                if (fq == 0) atomicAdd(SSQ + r, ss);
            }
            asm volatile("" ::: "memory");
        }
    }
};
struct Epi4 {
    static constexpr bool PERM = true, AFTER_DRAIN = false;
    const float* SSQ; bf16* H;
    __device__ __forceinline__ void operator()(const f32x4 (&acc)[2][2][4][2], const Unit& u, int wr, int wc, int fr, int fq) const {
        const int rbase = u.pm * 256 + wr * 64 + fr, col0 = u.pn * 256 + wc * 32 + 8 * fq;
        float sq[2][4];
#pragma unroll
        for (int ai = 0; ai < 2; ++ai)
#pragma unroll
            for (int m = 0; m < 4; ++m) sq[ai][m] = SSQ[rbase + ai * 128 + m * 16];
        asm volatile("" ::: "memory");
#pragma unroll
        for (int ai = 0; ai < 2; ++ai)
#pragma unroll
            for (int m = 0; m < 4; ++m) {
                const int r = rbase + ai * 128 + m * 16;
                const float rstd = rsqrtf(sq[ai][m] * (1.0f / DM) + EPS);
#pragma unroll
                for (int bj = 0; bj < 2; ++bj) {
                    f32x4 v0 = acc[ai][bj][m][0] * rstd, v1 = acc[ai][bj][m][1] * rstd;
#pragma unroll
                    for (int j = 0; j < 4; ++j) { v0[j] = fmaxf(v0[j], 0.f); v0[j] *= v0[j]; v1[j] = fmaxf(v1[j], 0.f); v1[j] *= v1[j]; }
                    v4u w; w.x = pk2(v0[0], v0[1]); w.y = pk2(v0[2], v0[3]); w.z = pk2(v1[0], v1[1]); w.w = pk2(v1[2], v1[3]);
                    *(v4u*)(H + (size_t)r * FF + col0 + bj * 128) = w;
                }
            }
    }
};
struct Epi5 {
    static constexpr bool PERM = true, AFTER_DRAIN = false;
    float* Y; const bf16* X1G;
    __device__ __forceinline__ void operator()(const f32x4 (&acc)[2][2][4][2], const Unit& u, int wr, int wc, int fr, int fq) const {
        const int rbase = u.pm * 256 + wr * 64 + fr, col0 = u.pn * 256 + wc * 32 + 8 * fq;
        v4u pre[2][4][2];
#pragma unroll
        for (int ai = 0; ai < 2; ++ai)
#pragma unroll
            for (int m = 0; m < 4; ++m)
#pragma unroll
                for (int bj = 0; bj < 2; ++bj) pre[ai][m][bj] = *(const v4u*)(X1G + (size_t)(rbase + ai * 128 + m * 16) * DM + col0 + bj * 128);
        asm volatile("" ::: "memory");
#pragma unroll
        for (int ai = 0; ai < 2; ++ai)
#pragma unroll
            for (int m = 0; m < 4; ++m)
#pragma unroll
                for (int bj = 0; bj < 2; ++bj) { float* p = Y + (size_t)(rbase + ai * 128 + m * 16) * DM + col0 + bj * 128; const v4u q = pre[ai][m][bj];
                    const f32x4 r0 = {bf2f(q.x & 0xffffu), bf2f(q.x >> 16), bf2f(q.y & 0xffffu), bf2f(q.y >> 16)}, r1 = {bf2f(q.z & 0xffffu), bf2f(q.z >> 16), bf2f(q.w & 0xffffu), bf2f(q.w >> 16)};
                    *(f32x4*)p = acc[ai][bj][m][0] + r0; *(f32x4*)(p + 4) = acc[ai][bj][m][1] + r1; }
    }
};

template <class EpiS>
__device__ __forceinline__ void skinny_phase(LAS unsigned char* lds, const bf16* As, const bf16* Bt, int N, int K, int start, int stride, const EpiS& E, const int wid_in) {
    const int wave = wid_in; int tid = wave * 64 + mk_fresh_lane(); asm volatile("" : "+v"(tid));
    const int lane = tid & 63, fr = lane & 15, fq = lane >> 4;
    LAS float* red = (LAS float*)lds;
    const int kw = K >> 3, kb = wave * kw;
    for (int unit = start; unit < (N >> 4); unit += stride) {
        f32x4 a0 = {0.f, 0.f, 0.f, 0.f}, a1 = {0.f, 0.f, 0.f, 0.f};
        const bf16* bp = Bt + (size_t)(16 * unit + fr) * K + kb + 8 * fq;
        const bf16* ap0 = As + (size_t)fr * K + kb + 8 * fq;
        const bf16* ap1 = ap0 + (size_t)16 * K;
#pragma unroll 8
        for (int k = 0; k < kw; k += 32) {
            const bf16x8 b = *(const bf16x8*)(bp + k), x0 = *(const bf16x8*)(ap0 + k), x1 = *(const bf16x8*)(ap1 + k);
            a0 = __builtin_amdgcn_mfma_f32_16x16x32_bf16(b, x0, a0, 0, 0, 0);
            a1 = __builtin_amdgcn_mfma_f32_16x16x32_bf16(b, x1, a1, 0, 0, 0);
        }
        *(LAS f32x4*)(red + (wave * 2 + 0) * 256 + lane * 4) = a0;
        *(LAS f32x4*)(red + (wave * 2 + 1) * 256 + lane * 4) = a1;
        __syncthreads();
        const int row = tid >> 4, cj = tid & 15, idx = (row >> 4) * 256 + ((row & 15) + 16 * (cj >> 2)) * 4 + (cj & 3);
        float s = 0.f;
#pragma unroll
        for (int w = 0; w < 8; ++w) s += red[w * 512 + idx];
        E(row, 16 * unit + cj, s);
        __syncthreads();
    }
}
struct EpiS1 { float* ZS; const float* SSQ0; __device__ __forceinline__ void operator()(int row, int col, float v) const { ZS[row * INC + win_logical_col(col)] = v * rsqrtf(SSQ0[MP + row] * (1.0f / DM) + EPS); } };
struct EpiS3 { const float* xs; float* Y; bf16* X1G; const float* gm; float* SSQ;
    __device__ __forceinline__ void operator()(int row, int col, float v) const {
        const float x1 = xs[row * DM + col] + v; X1G[(size_t)(MP + row) * DM + col] = (bf16)f2bf(x1);
        float ss = x1 * x1; ss += __shfl_xor(ss, 1); ss += __shfl_xor(ss, 2); ss += __shfl_xor(ss, 4); ss += __shfl_xor(ss, 8);
        if ((mk_fresh_lane() & 15) == 0) atomicAdd(SSQ + MP + row, ss);
    } };
struct EpiS4 { float* SSQ; bf16* H;
    __device__ __forceinline__ void operator()(int row, int col, float v) const {
        const float rstd = rsqrtf(__hip_atomic_load(SSQ + MP + row, __ATOMIC_RELAXED, __HIP_MEMORY_SCOPE_AGENT) * (1.0f / DM) + EPS);
        float h = fmaxf(v * rstd, 0.f); h *= h; H[(size_t)(MP + row) * FF + col] = (bf16)f2bf(h);
    } };
struct EpiS5 { float* Y; const bf16* X1G; float fac; __device__ __forceinline__ void operator()(int row, int col, float v) const { const size_t o = (size_t)(MP + row) * DM + col; Y[o] = (bf2f((unsigned)X1G[o]) + v) * fac; } };

template <int DEPTH, class Dec, bool NTST = false>
__device__ __forceinline__ void cvt_items(LAS float* scr, int first, int total, int stride, int lane, const Dec& D) {
    const int r8 = lane >> 3, c4 = lane & 7;
    int it = first; if (it >= total) return;
    const float* src; int N;
    f32x4 v[DEPTH][8]; bf16* dst[DEPTH]; int K[DEPTH];
#pragma unroll
    for (int d = 0; d < DEPTH; ++d) { dst[d] = nullptr; K[d] = 0; }
#pragma unroll
    for (int d = 0; d < DEPTH - 1; ++d)
        if (it + d * stride < total) { D(it + d * stride, src, N, dst[d], K[d]);
#pragma unroll
            for (int i = 0; i < 8; ++i) v[d][i] = __builtin_nontemporal_load((const f32x4*)(src + (size_t)(r8 + 8 * i) * N + 4 * c4)) * D.rowscale(it + d * stride, r8 + 8 * i); }
    for (;;) {
        const int nl = it + (DEPTH - 1) * stride;
        if (nl < total) { D(nl, src, N, dst[DEPTH - 1], K[DEPTH - 1]);
#pragma unroll
            for (int i = 0; i < 8; ++i) v[DEPTH - 1][i] = __builtin_nontemporal_load((const f32x4*)(src + (size_t)(r8 + 8 * i) * N + 4 * c4)) * D.rowscale(nl, r8 + 8 * i); }
#pragma unroll
        for (int i = 0; i < 8; ++i) { LAS float* s = scr + (r8 + 8 * i) * 33 + 4 * c4; s[0] = v[0][i][0]; s[1] = v[0][i][1]; s[2] = v[0][i][2]; s[3] = v[0][i][3]; }
        LDS_WAIT(); asm volatile("" ::: "memory");
        const int c = lane & 7;
#pragma unroll
        for (int j = 0; j < 4; ++j) { const int n = (lane >> 3) + 8 * j; const LAS float* s = scr + (8 * c) * 33 + n;
            v4u o; o.x = pk2(s[0 * 33], s[1 * 33]); o.y = pk2(s[2 * 33], s[3 * 33]); o.z = pk2(s[4 * 33], s[5 * 33]); o.w = pk2(s[6 * 33], s[7 * 33]);
            if (NTST) __builtin_nontemporal_store(o, (v4u*)(dst[0] + (size_t)n * K[0] + 8 * c)); else *(v4u*)(dst[0] + (size_t)n * K[0] + 8 * c) = o; }
        LDS_WAIT(); asm volatile("" ::: "memory");
        it += stride; if (it >= total) break;
#pragma unroll
        for (int d = 0; d < DEPTH - 1; ++d) {
#pragma unroll
            for (int i = 0; i < 8; ++i) v[d][i] = v[d + 1][i];
            dst[d] = dst[d + 1]; K[d] = K[d + 1]; }
    }
}
struct DecP0 { const float* w_in; bf16* WinT; const float* gmix;
    __device__ __forceinline__ float rowscale(int it, int kk) const { return gmix[64 * (it / (INC / 32)) + kk]; }
    __device__ __forceinline__ void operator()(int it, const float*& src, int& N, bf16*& dst, int& K) const {
        const int kb = it / (INC / 32), nb = it % (INC / 32); src = w_in + (size_t)(64 * kb) * INC + 32 * nb; N = INC; K = DM; dst = WinT + (size_t)(32 * win_dst_group(nb)) * DM + 64 * kb;
    } };
struct DecUp { const float *w_up, *w_out; bf16 *WupT, *WoutT; const float* gm;
    __device__ __forceinline__ float rowscale(int it, int kk) const { constexpr int I_UP = (DM / 64) * (FF / 32); return it < I_UP ? gm[64 * (it / (FF / 32)) + kk] : 1.0f; }
    __device__ __forceinline__ void operator()(int it, const float*& src, int& N, bf16*& dst, int& K) const {
        constexpr int I_UP = (DM / 64) * (FF / 32);
        if (it < I_UP) { const int kb = it / (FF / 32), nb = it % (FF / 32); src = w_up + (size_t)(64 * kb) * FF + 32 * nb; N = FF; K = DM; dst = WupT + (size_t)(32 * nb) * DM + 64 * kb; }
        else { const int r = it - I_UP, kb = r / (DM / 32), nb = r % (DM / 32); src = w_out + (size_t)(64 * kb) * DM + 32 * nb; N = DM; K = DM; dst = WoutT + (size_t)(32 * nb) * DM + 64 * kb; }
    } };
struct DecDn { const float* w_down; bf16* WdnT;
    __device__ __forceinline__ float rowscale(int, int) const { return 1.0f; }
    __device__ __forceinline__ void operator()(int it, const float*& src, int& N, bf16*& dst, int& K) const {
        const int kb = it / (DM / 32), nb = it % (DM / 32); src = w_down + (size_t)(64 * kb) * DM + 32 * nb; N = DM; K = FF; dst = WdnT + (size_t)(32 * nb) * FF + 64 * kb;
    } };
__device__ __forceinline__ void row_to_bf16(const float* xrow, bf16* orow, float* ssq, int lane) {
    const f32x4* xr = (const f32x4*)xrow + lane;
    f32x4 v[8]; float s = 0.f;
#pragma unroll
    for (int j = 0; j < 8; ++j) { v[j] = __builtin_nontemporal_load(xr + 64 * j); s += dot4(v[j], v[j]); }
    v2u* o8 = (v2u*)orow + lane;
#pragma unroll
    for (int j = 0; j < 8; ++j) { v2u w; w.x = pk2(v[j][0], v[j][1]); w.y = pk2(v[j][2], v[j][3]); o8[64 * j] = w; }
    s = wave_sum(s);
    if (lane == 0) *ssq = s;
}

constexpr int KS_STRIDE = 72, VT_STRIDE = 276, KS_BYTES = 272 * KS_STRIDE * 2, VT_BYTES = 64 * VT_STRIDE * 2;
__device__ __forceinline__ void attn_unit(LAS unsigned char* lds, int b, int nb, int kh, const bf16* Q, const bf16* Kb, const bf16* Vb, bf16* MIX, const float* sinks,
                                          int tid, int wave, int lane) {
    LAS bf16* Ks = (LAS bf16*)lds; LAS bf16* Vt = (LAS bf16*)(lds + KS_BYTES);
    const int fr = lane & 15, fq = lane >> 4;
#pragma unroll
    for (int p = 0; p < 4; ++p) {
        const int idx = p * 512 + tid, key = idx >> 3, c = idx & 7, s = 128 * (nb - 1) + key;
        v4u kv = {0u, 0u, 0u, 0u}, vv = {0u, 0u, 0u, 0u};
        if (s >= 0) { const size_t off = (size_t)(b * SEQ + s) * 256 + 64 * kh + 8 * c; kv = *(const v4u*)(Kb + off); vv = *(const v4u*)(Vb + off); }
        *(LAS v4u*)(Ks + key * KS_STRIDE + 8 * c) = kv;
        LAS bf16* vp = Vt + (8 * c) * VT_STRIDE + key;
        vp[0 * VT_STRIDE] = (bf16)(vv.x & 0xffffu); vp[1 * VT_STRIDE] = (bf16)(vv.x >> 16); vp[2 * VT_STRIDE] = (bf16)(vv.y & 0xffffu); vp[3 * VT_STRIDE] = (bf16)(vv.y >> 16);
        vp[4 * VT_STRIDE] = (bf16)(vv.z & 0xffffu); vp[5 * VT_STRIDE] = (bf16)(vv.z >> 16); vp[6 * VT_STRIDE] = (bf16)(vv.w & 0xffffu); vp[7 * VT_STRIDE] = (bf16)(vv.w >> 16);
    }
    if (tid < 144) *(LAS v4u*)(Ks + 256 * KS_STRIDE + tid * 8) = (v4u){0u, 0u, 0u, 0u};
    for (int i = tid; i < 64 * 20; i += 512) Vt[(i / 20) * VT_STRIDE + 256 + (i % 20)] = 0;
    const int g = wave >> 1, h = 4 * kh + g; const float sink = sinks[h];
    bf16x8 qall[4][2];
#pragma unroll
    for (int qi = 0; qi < 4; ++qi) { const size_t r = (size_t)b * SEQ + 128 * nb + 16 * (4 * (wave & 1) + qi) + fr;
        qall[qi][0] = *(const bf16x8*)(Q + r * 1024 + 64 * h + 8 * fq); qall[qi][1] = *(const bf16x8*)(Q + r * 1024 + 64 * h + 32 + 8 * fq); }
    __syncthreads();
#pragma unroll
    for (int qi = 0; qi < 4; ++qi) {
        const int qt = 4 * (wave & 1) + qi, i0 = 16 * qt;
        const size_t r = (size_t)b * SEQ + 128 * nb + i0 + fr;
        bf16x8 qf[2];
        qf[0] = qall[qi][0]; qf[1] = qall[qi][1];
        f32x4 S[10];
#pragma unroll
        for (int t = 0; t < 10; ++t) {
            S[t] = (f32x4){0.f, 0.f, 0.f, 0.f};
#pragma unroll
            for (int ks = 0; ks < 2; ++ks) {
                const bf16x8 kf = *(const LAS bf16x8*)(Ks + (16 * (qt + t) + fr) * KS_STRIDE + 32 * ks + 8 * fq);
                S[t] = __builtin_amdgcn_mfma_f32_16x16x32_bf16(kf, qf[ks], S[t], 0, 0, 0);
            }
        }
        float mx = sink;
#pragma unroll
        for (int t = 0; t < 10; ++t)
#pragma unroll
            for (int j = 0; j < 4; ++j) {
                const int rel = 16 * t + 4 * fq + j - fr;
                const bool ok = rel >= 1 && rel <= 128 && (nb > 0 || (i0 + 16 * t + 4 * fq + j) >= 128);
                S[t][j] = ok ? S[t][j] : -1e30f; mx = fmaxf(mx, S[t][j]);
            }
        mx = fmaxf(mx, __shfl_xor(mx, 16)); mx = fmaxf(mx, __shfl_xor(mx, 32));
        float sum = 0.f;
#pragma unroll
        for (int t = 0; t < 10; ++t)
#pragma unroll
            for (int j = 0; j < 4; ++j) { S[t][j] = __expf(S[t][j] - mx); sum += S[t][j]; }
        sum += __shfl_xor(sum, 16); sum += __shfl_xor(sum, 32); sum += __expf(sink - mx);
        const float inv = 1.0f / sum;
        f32x4 O[4];
#pragma unroll
        for (int dt = 0; dt < 4; ++dt) O[dt] = (f32x4){0.f, 0.f, 0.f, 0.f};
#pragma unroll
        for (int k2 = 0; k2 < 5; ++k2) {
            v4u pw; pw.x = pk2(S[2 * k2][0], S[2 * k2][1]); pw.y = pk2(S[2 * k2][2], S[2 * k2][3]); pw.z = pk2(S[2 * k2 + 1][0], S[2 * k2 + 1][1]); pw.w = pk2(S[2 * k2 + 1][2], S[2 * k2 + 1][3]);
            const bf16x8 pf = __builtin_bit_cast(bf16x8, pw);
#pragma unroll
            for (int dt = 0; dt < 4; ++dt) {
                const LAS bf16* vp = Vt + (16 * dt + fr) * VT_STRIDE + 16 * (qt + 2 * k2) + 4 * fq;
                const v2u lo = *(const LAS v2u*)vp, hi = *(const LAS v2u*)(vp + 16);
                v4u vw; vw.x = lo.x; vw.y = lo.y; vw.z = hi.x; vw.w = hi.y;
                O[dt] = __builtin_amdgcn_mfma_f32_16x16x32_bf16(__builtin_bit_cast(bf16x8, vw), pf, O[dt], 0, 0, 0);
            }
        }
#pragma unroll
        for (int dt = 0; dt < 4; ++dt) {
            v2u w; w.x = pk2(O[dt][0] * inv, O[dt][1] * inv); w.y = pk2(O[dt][2] * inv, O[dt][3] * inv);
            *(v2u*)(MIX + r * DM + 64 * h + 16 * dt + 4 * fq) = w;
        }
    }
    __syncthreads();
}

constexpr int PF_LDS_OFF = 132096;
__device__ __forceinline__ void glds16_pf(const void* gsrc, unsigned lds_dst) { unsigned keep;
    asm volatile("s_mov_b32 %0, m0\n\ts_mov_b32 m0, %2\n\ts_nop 0\n\tglobal_load_lds_dwordx4 %1, off\n\ts_mov_b32 m0, %0" : "=&s"(keep) : "v"(gsrc), "s"(lds_dst) : "memory"); }
__device__ __forceinline__ void conv_unit(LAS unsigned char* lds, int b, int tb, const bf16* U, bf16* MIX, const float* cw, const float* cb, const float* lg, const float* lb,
                                          const float* xpre, int tid, int wave, int lane) {
    LAS unsigned* tile = (LAS unsigned*)lds;
    LAS float* red = (LAS float*)(lds + 62 * 2048);
    LAS float* fin = red + 512;
    const int s0 = 32 * tb;
    {   const int row0 = tid >> 7, c16 = tid & 127;
        const bf16* up = U + ((size_t)b * SEQ + s0 - 30 + row0) * 1024 + 8 * c16;
#pragma unroll
        for (int h8 = 0; h8 < 2; ++h8) {
            v4u tv[8];
#pragma unroll
            for (int t = 0; t < 8; ++t) { const int row = row0 + 4 * (8 * h8 + t);
                tv[t] = (v4u){0u, 0u, 0u, 0u};
                if (row < 62 && s0 - 30 + row >= 0) tv[t] = *(const v4u*)(up + (size_t)(4 * (8 * h8 + t)) * 1024); }
#pragma unroll
            for (int t = 0; t < 8; ++t) { const int row = row0 + 4 * (8 * h8 + t);
                if (row < 62) *(LAS v4u*)(tile + row * 512 + 4 * c16) = tv[t]; }
            asm volatile("" ::: "memory");
        }
    }
    __syncthreads();
    f32x2 w[31];
#pragma unroll
    for (int j = 0; j < 31; ++j) w[j] = *(const f32x2*)(cw + j * 1024 + 2 * tid);
    const f32x2 bias = *(const f32x2*)(cb + 2 * tid);
    const f32x2 g = *(const f32x2*)(lg + 2 * tid), be = *(const f32x2*)(lb + 2 * tid);
#pragma unroll 1
    for (int ck = 0; ck < 4; ++ck) {
        f32x2 c[8];
#pragma unroll
        for (int o = 0; o < 8; ++o) c[o] = bias;
#pragma unroll
        for (int rr = 0; rr < 38; ++rr) {
            const unsigned pv = tile[(8 * ck + rr) * 512 + tid];
            const f32x2 v = {bf2f(pv & 0xffffu), bf2f(pv >> 16)};
#pragma unroll
            for (int o = 0; o < 8; ++o) { const int j = rr - o; if (j >= 0 && j <= 30) c[o] = c[o] + w[j] * v; }
            if ((rr & 7) == 7) asm volatile("" ::: "memory");
        }
#pragma unroll
        for (int o = 0; o < 8; ++o) {
            const f32x2 x = c[o];
            const float s1 = wave_sum(x[0] + x[1]), s2 = wave_sum(x[0] * x[0] + x[1] * x[1]);
            if (lane == 0) { red[(wave * 8 + o) * 2] = s1; red[(wave * 8 + o) * 2 + 1] = s2; }
        }
        asm volatile("s_waitcnt lgkmcnt(0)\n\ts_barrier" ::: "memory");
        if (tid < 16) { float s = 0.f;
#pragma unroll
            for (int wv = 0; wv < 8; ++wv) s += red[wv * 16 + tid];
            fin[tid] = s; }
        asm volatile("s_waitcnt lgkmcnt(0)\n\ts_barrier" ::: "memory");
#pragma unroll
        for (int t = 0; t < 8; ++t) {
            const float mean = fin[2 * t] * (1.0f / CCH), var = fin[2 * t + 1] * (1.0f / CCH) - mean * mean, rstd = rsqrtf(fmaxf(var, 0.f) + EPS);
            const f32x2 y = (c[t] - mean) * rstd * g + be;
            const float o0 = y[0] * sigmoidf_(y[0]), o1 = y[1] * sigmoidf_(y[1]);
            *(unsigned*)(MIX + (size_t)(b * SEQ + s0 + 8 * ck + t) * DM + 1024 + 2 * tid) = pk2(o0, o1);
        }
        if (ck == 0 && xpre) {
            const float* xr = xpre + (size_t)(wave * 32) * DM + lane * 4;
#pragma unroll 8
            for (int i = 0; i < 32; ++i) glds16_pf(xr + (size_t)i * DM, (unsigned)(PF_LDS_OFF + wave * 1024));
        }
    }
    asm volatile("s_waitcnt lgkmcnt(0)\n\ts_barrier" ::: "memory");
}

__device__ __forceinline__ void sample_att(LAS unsigned char* lds, int b, const float* ZS, const float* cache_k, const float* cache_v, const float* state,
                                             const float* gq, const float* gk, const float* sinks, const float* cw, const float* cb, const float* lg, const float* lb,
                                             const float* cosT, const float* sinT, float* out, bf16* MIX, int tid, int wave, int lane) {
    LAS float* zs = (LAS float*)lds;
    LAS float* qs = zs + 3584;
    LAS float* kn = qs + 1024;
    LAS float* vn = kn + 256;
    LAS float* sc = vn + 256;
    LAS float* rd = sc + 2048;
    LAS float* part = rd + 16;
    for (int i = tid; i < INC; i += 512) zs[i] = ZS[b * INC + i];
    __syncthreads();
    for (int hh = wave; hh < 20; hh += 8) {
        const int base = hh < 16 ? 64 * hh : 1024 + 64 * (hh - 16);
        const float x = zs[base + lane];
        const float rstd = rsqrtf(wave_sum(x * x) * (1.0f / 64.0f) + EPS);
        const float y = x * rstd * (hh < 16 ? gq : gk)[lane];
        const float p = __shfl_xor(y, 32);
        const float co = cosT[2048 * 32 + (lane & 31)], si = sinT[2048 * 32 + (lane & 31)];
        const float o = lane < 32 ? y * co - p * si : y * co + p * si;
        if (hh < 16) qs[hh * 64 + lane] = o * 0.125f;
        else { kn[(hh - 16) * 64 + lane] = o; out[O_KS + ((size_t)(b * 128 + 127) * 4 + (hh - 16)) * 64 + lane] = o; }
    }
    if (tid < 256) { const float vv = zs[1280 + tid]; vn[tid] = vv; out[O_VS + (size_t)(b * 128 + 127) * 256 + tid] = vv; }
    __syncthreads();
    {
        const int jj = tid >> 2, kh = tid & 3, j = jj + 1;
        float d0 = 0.f, d1 = 0.f, d2 = 0.f, d3 = 0.f;
        const LAS float* q0 = qs + (4 * kh) * 64;
        if (j < 128) {
            const f32x4* kr = (const f32x4*)(cache_k + ((size_t)(b * 128 + j) * 4 + kh) * 64);
#pragma unroll
            for (int d4 = 0; d4 < 16; ++d4) { const f32x4 kv = kr[d4];
                d0 += dot4(kv, *(const LAS f32x4*)(q0 + 4 * d4)); d1 += dot4(kv, *(const LAS f32x4*)(q0 + 64 + 4 * d4));
                d2 += dot4(kv, *(const LAS f32x4*)(q0 + 128 + 4 * d4)); d3 += dot4(kv, *(const LAS f32x4*)(q0 + 192 + 4 * d4)); }
        } else {
#pragma unroll 4
            for (int d4 = 0; d4 < 16; ++d4) { const f32x4 kv = *(const LAS f32x4*)(kn + kh * 64 + 4 * d4);
                d0 += dot4(kv, *(const LAS f32x4*)(q0 + 4 * d4)); d1 += dot4(kv, *(const LAS f32x4*)(q0 + 64 + 4 * d4));
                d2 += dot4(kv, *(const LAS f32x4*)(q0 + 128 + 4 * d4)); d3 += dot4(kv, *(const LAS f32x4*)(q0 + 192 + 4 * d4)); }
        }
        sc[(4 * kh + 0) * 128 + jj] = d0; sc[(4 * kh + 1) * 128 + jj] = d1; sc[(4 * kh + 2) * 128 + jj] = d2; sc[(4 * kh + 3) * 128 + jj] = d3;
    }
    __syncthreads();
    for (int h = 2 * wave; h < 2 * wave + 2; ++h) {
        const float a = sc[h * 128 + lane], c2 = sc[h * 128 + 64 + lane], sink = sinks[h];
        const float m = fmaxf(wave_max(fmaxf(a, c2)), sink);
        const float pa = __expf(a - m), pb = __expf(c2 - m);
        const float den = wave_sum(pa + pb) + __expf(sink - m), inv = 1.0f / den;
        sc[h * 128 + lane] = pa * inv; sc[h * 128 + 64 + lane] = pb * inv;
    }
    __syncthreads();
    {
        const int d = tid & 63, kg = wave;
#pragma unroll 1
        for (int kh = 0; kh < 4; ++kh) {
            float vv[16];
#pragma unroll
            for (int t = 0; t < 16; ++t) { const int jj = 16 * kg + t;
                vv[t] = (jj < 127) ? cache_v[((size_t)(b * 128 + jj + 1) * 4 + kh) * 64 + d] : vn[kh * 64 + d]; }
            float a0 = 0.f, a1 = 0.f, a2 = 0.f, a3 = 0.f;
            const LAS float* sp = sc + (4 * kh) * 128 + 16 * kg;
#pragma unroll
            for (int t = 0; t < 16; ++t) { a0 += sp[t] * vv[t]; a1 += sp[128 + t] * vv[t]; a2 += sp[256 + t] * vv[t]; a3 += sp[384 + t] * vv[t]; }
            LAS float* pp = part + (kg * 16 + 4 * kh) * 64 + d;
            pp[0] = a0; pp[64] = a1; pp[128] = a2; pp[192] = a3;
        }
        __syncthreads();
#pragma unroll
        for (int hi = 0; hi < 2; ++hi) {
            const int h = (tid >> 6) + 8 * hi; float o = 0.f;
#pragma unroll
            for (int k8 = 0; k8 < 8; ++k8) o += part[(k8 * 16 + h) * 64 + d];
            MIX[(size_t)(MP + b) * DM + 64 * h + d] = (bf16)f2bf(o);
        }
    }
    __syncthreads();
}
__device__ __forceinline__ void sample_conv(LAS unsigned char* lds, int b, const float* ZS, const float* cache_k, const float* cache_v, const float* state,
                                             const float* gq, const float* gk, const float* sinks, const float* cw, const float* cb, const float* lg, const float* lb,
                                             const float* cosT, const float* sinT, float* out, bf16* MIX, int tid, int wave, int lane) {
    LAS float* zs = (LAS float*)lds;
    LAS float* qs = zs + 3584;
    LAS float* kn = qs + 1024;
    LAS float* vn = kn + 256;
    LAS float* sc = vn + 256;
    LAS float* rd = sc + 2048;
    LAS float* part = rd + 16;
    for (int i = 1536 + tid; i < INC; i += 512) zs[i] = ZS[b * INC + i];
    __syncthreads();
    {
        const int ch = 2 * tid;
        const float u0 = zs[1536 + ch] * sigmoidf_(zs[2560 + ch]), u1 = zs[1536 + ch + 1] * sigmoidf_(zs[2560 + ch + 1]);
        *(f32x2*)(out + O_CS + (size_t)(b * 30 + 29) * 1024 + ch) = (f32x2){u0, u1};
        f32x2 c = *(const f32x2*)(cb + ch);
#pragma unroll 10
        for (int j = 0; j < 30; ++j) c = c + *(const f32x2*)(cw + j * 1024 + ch) * *(const f32x2*)(state + (size_t)(b * 30 + j) * 1024 + ch);
        c = c + *(const f32x2*)(cw + 30 * 1024 + ch) * (f32x2){u0, u1};
        const float s1 = wave_sum(c[0] + c[1]), s2 = wave_sum(c[0] * c[0] + c[1] * c[1]);
        if (lane == 0) { rd[wave * 2] = s1; rd[wave * 2 + 1] = s2; }
        __syncthreads();
        float t1 = 0.f, t2 = 0.f;
#pragma unroll
        for (int wv = 0; wv < 8; ++wv) { t1 += rd[wv * 2]; t2 += rd[wv * 2 + 1]; }
        const float mean = t1 * (1.0f / CCH), var = t2 * (1.0f / CCH) - mean * mean, rstd = rsqrtf(fmaxf(var, 0.f) + EPS);
        const f32x2 y = (c - mean) * rstd * *(const f32x2*)(lg + ch) + *(const f32x2*)(lb + ch);
        *(unsigned*)(MIX + (size_t)(MP + b) * DM + 1024 + ch) = pk2(y[0] * sigmoidf_(y[0]), y[1] * sigmoidf_(y[1]));
    }
    __syncthreads();
}

#ifndef MK_DUP
#define MK_DUP (-1)
#endif
#define REPS(k)
#ifndef MK_CG_SEAMS
#define MK_CG_SEAMS 0
#endif
#define P2_CVT() do { const DecDn D{w_down, WdnT}; cvt_items<3, DecDn, true>((LAS float*)(lds + wave * 16384), bx * NWAVES + wave, (FF / 64) * (DM / 32), ncv * NWAVES, lane, D); \
                const int gt = bx * (NWAVES * 64) + tid, NT = ncv * NWAVES * 64;        \
                for (int i = gt; i < 32 * 8128; i += NT) { const int b = i / 8128, o = i % 8128; \
                    ((f32x4*)(out + O_KS + (size_t)b * 32768))[o] = ((const f32x4*)(cache_k + (size_t)b * 32768 + 256))[o]; \
                    ((f32x4*)(out + O_VS + (size_t)b * 32768))[o] = ((const f32x4*)(cache_v + (size_t)b * 32768 + 256))[o]; } \
                for (int i = gt; i < 32 * 7424; i += NT) { const int b = i / 7424, o = i % 7424; \
                    ((f32x4*)(out + O_CS + (size_t)b * 30720))[o] = ((const f32x4*)(state + (size_t)b * 30720 + 1024))[o]; } } while (0)
struct Args { const float* in[18]; float* out; unsigned char* ws; int ph_lo, ph_hi, dry, pad; };
__global__ void __launch_bounds__(NWAVES * 64, 2) mk_fwd(Args args) {
    extern __shared__ __attribute__((aligned(16))) unsigned char lds_raw[];
    LAS unsigned char* lds = (LAS unsigned char*)lds_raw;
    const int wave_k = __builtin_amdgcn_readfirstlane((int)threadIdx.x >> 6);
    const int tid = wave_k * 64 + mk_fresh_lane();
    const int G = gridDim.x, bx = blockIdx.x;
    const int vcu = (G % 8 == 0) ? (bx % 8) * (G / 8) + bx / 8 : bx;
    unsigned char* ws = args.ws;
    const float *xp = args.in[0], *xs = args.in[1], *cache_k = args.in[2], *cache_v = args.in[3], *state = args.in[4], *g_mix = args.in[5], *w_in = args.in[6],
                *gq = args.in[7], *gk = args.in[8], *sinks = args.in[9], *conv_w = args.in[10], *conv_b = args.in[11], *ln_g = args.in[12], *ln_b = args.in[13],
                *w_out = args.in[14], *g_mlp = args.in[15], *w_up = args.in[16], *w_down = args.in[17];
    float* out = args.out;
    float* SSQ = (float*)(ws + WS_SSQ); float* SSQ0 = (float*)(ws + WS_SSQ0); float* cosT = (float*)(ws + WS_COS); float* sinT = (float*)(ws + WS_SIN); float* ZS = (float*)(ws + WS_ZS);
    bf16 *WinT = (bf16*)(ws + WS_WIN), *WoutT = (bf16*)(ws + WS_WOUT), *WupT = (bf16*)(ws + WS_WUP), *WdnT = (bf16*)(ws + WS_WDN);
    bf16 *X1G = (bf16*)(ws + WS_X1G), *HID = (bf16*)(ws + WS_HID), *XN = (bf16*)(ws + WS_XN), *Qb = (bf16*)(ws + WS_Q), *Kb = (bf16*)(ws + WS_K), *Vb = (bf16*)(ws + WS_V),
         *Ub = (bf16*)(ws + WS_U), *MIX = (bf16*)(ws + WS_MIX);
    for (int u = tid; u < (LDS_BYTES - LDSCTL_OFF) / 4; u += NWAVES * 64) ((LAS unsigned*)(lds + LDSCTL_OFF))[u] = 0u;
    __syncthreads();
    volatile LAS unsigned* MISC = (volatile LAS unsigned*)(lds + MISC_OFF);
    XcdBarrier bar; bar.bar = (unsigned*)(ws + WS_CTL) + CW_BAR; bar.x = 0; bar.st = nullptr;
    if (MK_N_LAUNCHES == 1) bar = xcd_barrier_post((unsigned*)(ws + WS_CTL) + CW_BAR, MISC + 8);
#define GRID_BAR(seam) do { if (MK_N_LAUNCHES == 1) { if ((MK_CG_SEAMS >> (seam)) & 1) cg::this_grid().sync(); else xcd_barrier(bar); } STAMP((seam) + 1); } while (0)
#define FRESH_IDS() const int wave = wave_k; int tid = wave * 64 + mk_fresh_lane(); asm volatile("" : "+v"(tid)); const int lane = tid & 63; (void)lane
#ifdef MK_TA
    unsigned long long* TS = (unsigned long long*)(ws + WS_SSQ + 128 * 1024);
#define STAMP(k) do { if (bx == G - 1 && tid == 0) TS[k] = __builtin_amdgcn_s_memrealtime(); } while (0)
#else
#define STAMP(k) do { } while (0)
#endif
    STAMP(0);
    const int lo = args.ph_lo, hi = args.ph_hi;
#ifndef MK_PLAIN
    if (args.pad == 0x5eed) cg::this_grid().sync();
#endif
#define IN(k) (lo <= (k) && (k) < hi)

    if (IN(0)) { REPS(0) {
        FRESH_IDS();
        LAS float* scr = (LAS float*)(lds + wave * 16384);
        const int gw = vcu * NWAVES + wave, NGW = G * NWAVES;
        { const DecP0 D{w_in, WinT, g_mix}; cvt_items<3>(scr, gw, (DM / 64) * (INC / 32), NGW, lane, D); }
        for (int m = gw; m < MT; m += NGW) row_to_bf16(m < MP ? xp + (size_t)m * DM : xs + (size_t)(m - MP) * DM, XN + (size_t)m * DM, SSQ0 + m, lane);
        const int gt = vcu * (NWAVES * 64) + tid, NT = G * NWAVES * 64;
        for (int i = gt; i < 2049 * 32; i += NT) {
            const int pos = i >> 5, k = i & 31; double inv = 1.0;
            for (int j = 0; j < k; ++j) inv *= 0.7498942093324559;
            const float ang = (pos == 2048 ? 16384.0f : (float)pos) * (float)inv;
            double rev = (double)ang * 0.15915494309189535; rev -= __builtin_rint(rev);
            const float rf = (float)rev;
            cosT[i] = __builtin_amdgcn_cosf(rf); sinT[i] = __builtin_amdgcn_sinf(rf);
        }
        }
        if (IN(1)) GRID_BAR(0);
    }
    if (IN(1)) { REPS(1) {
        const int nun = (MP / 256) * (INC / 256), rounds = (nun + G - 1) / G, GG = (nun + rounds - 1) / rounds, nsv = G - GG;
        if (bx < GG) {
            pg8::Gemm g{XN, WinT, MP, INC, DM}; pg8::StaticOrder S; S.init(MP, INC, GG, bx);
            Epi1 E{Qb, Kb, Vb, Ub, out, gq, gk, cosT, sinT, SSQ0};
            pg8::gemm_phase<Epi1, pg8::StaticOrder, true, true>(lds, g, S, E, wave_k);
        }
        FRESH_IDS();
        STAMP(9);
        EpiS1 ES{ZS, SSQ0};
        skinny_phase(lds, XN + (size_t)MP * DM, WinT, INC, DM, bx, G, ES, wave_k);
        {   const DecUp D{w_up, w_out, WupT, WoutT, g_mlp}; constexpr int NIT = (DM / 64) * (FF / 32) + (DM / 64) * (DM / 32);
            if (nsv > 0) { if (bx >= GG) cvt_items<5>((LAS float*)(lds + wave * 16384), (bx - GG) * NWAVES + wave, NIT, nsv * NWAVES, lane, D); }
            else cvt_items<5>((LAS float*)(lds + wave * 16384), bx * NWAVES + wave, NIT, G * NWAVES, lane, D);
        }
        }
        STAMP(12);
        if (IN(2)) GRID_BAR(1);
    }
    if (IN(2)) { REPS(2) {
        FRESH_IDS();
        const int ncv = G > 2 * MS ? G - 2 * MS : G;
        const bool cvt_first = bx < ncv && ((bx >> 3) & 1);
        if (cvt_first) { P2_CVT(); __syncthreads(); }
        for (int a = vcu; a < 256; a += G) attn_unit(lds, a >> 6, (a >> 2) & 15, a & 3, Qb, Kb, Vb, MIX, sinks, tid, wave, lane);
        STAMP(6);
        for (int c = vcu; c < 256; c += G) conv_unit(lds, c >> 6, c & 63, Ub, MIX, conv_w, conv_b, ln_g, ln_b, nullptr, tid, wave, lane);
        STAMP(7);
        if (bx < ncv && !cvt_first) { P2_CVT(); __syncthreads(); }
        for (int j = G - 1 - bx; j < 2 * MS; j += G) {
            if (j < MS) sample_att(lds, j, ZS, cache_k, cache_v, state, gq, gk, sinks, conv_w, conv_b, ln_g, ln_b, cosT, sinT, out, MIX, tid, wave, lane);
            else sample_conv(lds, j - MS, ZS, cache_k, cache_v, state, gq, gk, sinks, conv_w, conv_b, ln_g, ln_b, cosT, sinT, out, MIX, tid, wave, lane);
        }
        }
        STAMP(11);
        if (IN(3)) GRID_BAR(2);
    }
    if (IN(3)) {
        pg8::Gemm g{MIX, WoutT, MP, DM, DM}; pg8::StaticOrder S; S.init(MP, DM, G, bx);
        Epi3 E{XN, out + O_YP, X1G, g_mlp, args.dry ? SSQ + 16384 : SSQ};
        pg8::gemm_phase<Epi3, pg8::StaticOrder, true, true>(lds, g, S, E, wave_k);
        STAMP(13);
        EpiS3 ES{xs, out + O_YP, X1G, g_mlp, args.dry ? SSQ + 16384 : SSQ};
        skinny_phase(lds, MIX + (size_t)MP * DM, WoutT, DM, DM, G - 1 - bx, G, ES, wave_k);
        if (IN(4)) GRID_BAR(3);
    }
    if (IN(4)) { REPS(4) {
        pg8::Gemm g{X1G, WupT, MP, FF, DM}; pg8::StaticOrder S; S.init(MP, FF, G, bx);
        Epi4 E{SSQ, HID};
        EpiS4 ES{SSQ, HID};
        if (bx & 1) skinny_phase(lds, X1G + (size_t)MP * DM, WupT, FF, DM, G - 1 - bx, G, ES, wave_k);
        pg8::gemm_phase<Epi4, pg8::StaticOrder, true, true>(lds, g, S, E, wave_k);
        if (!(bx & 1)) skinny_phase(lds, X1G + (size_t)MP * DM, WupT, FF, DM, G - 1 - bx, G, ES, wave_k);
        }
        if (IN(5)) GRID_BAR(4);
    }
    if (IN(5)) {
        pg8::Gemm g{HID, WdnT, MP, DM, FF}; pg8::StaticOrder S; S.init(MP, DM, G, bx);
        Epi5 E{out + O_YP, X1G};
        pg8::gemm_phase<Epi5, pg8::StaticOrder, true, true>(lds, g, S, E, wave_k);
#ifdef MK_TA
        STAMP(8); __syncthreads();
        EpiS5 ES{out + O_YP, X1G, bx == G - 1 ? 1.0f + 1e-4f * (float)(long long)(__hip_atomic_load(TS + MK_TB, __ATOMIC_RELAXED, __HIP_MEMORY_SCOPE_AGENT) - __hip_atomic_load(TS + MK_TA, __ATOMIC_RELAXED, __HIP_MEMORY_SCOPE_AGENT)) : 1.0f};
#else
        EpiS5 ES{out + O_YP, X1G, 1.0f};
#endif
        skinny_phase(lds, HID + (size_t)MP * FF, WdnT, DM, FF, G - 1 - bx, G, ES, wave_k);
    }
#undef IN
}

extern "C" void kernel_launch(void* const* d_in, const int* in_sizes, int n_in, void* d_out, int out_size, void* d_ws, size_t ws_size, hipStream_t stream) {
    static int grid = 0;
    if (grid == 0) {
        if (n_in != 18 || (size_t)out_size != O_END || ws_size < WS_END) { fprintf(stderr, "kernel_launch: unexpected shapes: n_in %d out %d ws %zu\n", n_in, out_size, ws_size); grid = -1; return; }
        int dev = 0, cus = 0, per_cu = 0;
        if (hipGetDevice(&dev) != hipSuccess || hipDeviceGetAttribute(&cus, hipDeviceAttributeMultiprocessorCount, dev) != hipSuccess) { grid = -1; return; }
        if (hipFuncSetAttribute((const void*)mk_fwd, hipFuncAttributeMaxDynamicSharedMemorySize, LDS_BYTES) != hipSuccess) { fprintf(stderr, "kernel_launch: hipFuncSetAttribute failed\n"); grid = -1; return; }
        if (hipOccupancyMaxActiveBlocksPerMultiprocessor(&per_cu, (const void*)mk_fwd, NWAVES * 64, LDS_BYTES) != hipSuccess || per_cu < 1) { fprintf(stderr, "kernel_launch: occupancy query says %d\n", per_cu); (void)hipGetLastError(); grid = -1; return; }
        grid = cus;
    }
    if (grid < 0) return;
    (void)hipMemsetAsync((char*)d_ws + WS_CTL, 0, CTL_ZERO_BYTES, stream);
    Args a{};
    for (int i = 0; i < 18; ++i) a.in[i] = (const float*)d_in[i];
    a.out = (float*)d_out; a.ws = (unsigned char*)d_ws;
#if MK_N_LAUNCHES == 1 && defined(MK_PLAIN)
    a.ph_lo = 0; a.ph_hi = 6;
    hipLaunchKernelGGL(mk_fwd, dim3(grid), dim3(NWAVES * 64), LDS_BYTES, stream, a);
#elif MK_N_LAUNCHES == 1
    a.ph_lo = 0; a.ph_hi = 6;
    void* params[] = {&a};
    hipError_t e = hipLaunchCooperativeKernel((const void*)mk_fwd, dim3(grid), dim3(NWAVES * 64), params, LDS_BYTES, stream);
    if (e != hipSuccess) fprintf(stderr, "kernel_launch: cooperative launch failed: %s (grid %d)\n", hipGetErrorString(e), grid);
#else
    for (int p = 0; p < 6; ++p) for (int rep = 0; rep < (p == MK_DUP ? 2 : 1); ++rep) { a.ph_lo = p; a.ph_hi = p + 1; a.dry = (p == MK_DUP && rep == 0 && (p == 3 || p == 5)) ? 1 : 0; hipLaunchKernelGGL(mk_fwd, dim3(grid), dim3(NWAVES * 64), LDS_BYTES, stream, a); }
#endif
}
```

```cpp
#include <hip/hip_runtime.h>
#include <hip/hip_cooperative_groups.h>
#include <cstdio>
#include <cstdint>
namespace cg = cooperative_groups;
__device__ __forceinline__ int mk_fresh_lane() { int l; asm volatile("v_mbcnt_lo_u32_b32 %0, -1, 0\n\tv_mbcnt_hi_u32_b32 %0, -1, %0" : "=v"(l)); return l; }
#define MK_PLAIN 1
#define MK_N_LAUNCHES 1
namespace pg8 {
#define PG8_LAS __attribute__((address_space(3)))
typedef unsigned short bf16_t;
typedef short bf16x8 __attribute__((ext_vector_type(8)));
typedef float f32x4 __attribute__((ext_vector_type(4)));
typedef unsigned u32x4 __attribute__((ext_vector_type(4)));
constexpr int BM = 256, BK = 64, HALF = 128, HTB = HALF * BK * 2  , STAGE_BYTES = 8 * HTB, NXCD = 8, WGM = 8;

__host__ __device__ __forceinline__ int lds_byte(int r, int c) { const int st = (r >> 4) * 2 + (c >> 5), rr = r & 15, cc = c & 31, ob = rr * 64 + cc * 2; return st * 1024 + (ob ^ (((ob >> 9) & 1) << 5)); }
__host__ __device__ __forceinline__ void stage_rc(int b, int& R, int& C) { const int st = b / 1024, sb = b % 1024, swz = sb ^ (((sb >> 9) & 1) << 5); R = (st >> 1) * 16 + swz / 64; C = (st & 1) * 32 + (swz % 64) / 2; }
__host__ __device__ __forceinline__ int perm32(int rho) { const int n = rho >> 4, i = rho & 15; return 8 * (i >> 2) + 4 * n + (i & 3); }

struct Unit { int pm, pn; };
struct Gemm { const bf16_t* A; const bf16_t* Bt; int M, N, K; };

struct StaticOrder {
    int nM, nN, nwg, G, c;
    __host__ __device__ void init(int M, int N, int G_, int c_) { nM = M / BM; nN = N / BM; nwg = nM * nN; G = G_; c = c_; }
    __host__ __device__ bool next(int i, Unit& u) const {
        const long L = (long)i * G + c; if (L >= nwg) return false;
        int wgid = (int)L; { const int q = nwg / NXCD, r = nwg % NXCD, xcd = wgid % NXCD, off = wgid / NXCD; wgid = (xcd < r ? xcd * (q + 1) : r * (q + 1) + (xcd - r) * q) + off; }
        const int nig = WGM * nN, gid = wgid / nig, fm = gid * WGM, gsz = (nM - fm) < WGM ? (nM - fm) : WGM;
        u.pm = fm + ((wgid % nig) % gsz); u.pn = (wgid % nig) / gsz; return true;
    }
    __device__ __forceinline__ void a_ready(const Unit&) const {}
    __device__ __forceinline__ void done(const Unit&) const {}
};

__device__ __forceinline__ unsigned cvt_pk_bf16(float lo, float hi) { unsigned r; asm volatile("v_cvt_pk_bf16_f32 %0, %1, %2" : "=v"(r) : "v"(lo), "v"(hi)); return r; }
typedef float f32x2 __attribute__((ext_vector_type(2)));
template <class Epi, class Sched, bool ALIGN_EPI = false, bool SP2 = false>
__device__ __forceinline__ void gemm_phase(PG8_LAS unsigned char* lds, const Gemm g, const Sched& S, const Epi& E, const int wid_in) {
    const int wid = wid_in; int tid = wid * 64 + mk_fresh_lane(); asm volatile("" : "+v"(tid));
    const int lane = tid & 63, wr = wid >> 2, wc = wid & 3, fr = lane & 15, fq = lane >> 4;
    const int K = g.K, nt = K / BK;
    unsigned voffA[2], voffB[2];
#pragma unroll
    for (int i = 0; i < 2; ++i) { int R, C; stage_rc(tid * 16 + i * 8192, R, C); const int Rb = Epi::PERM ? ((R & ~31) + perm32(R & 31)) : R;
        voffA[i] = (unsigned)(R * K + C) * 2u; voffB[i] = (unsigned)(Rb * K + C) * 2u; }
    const size_t kstep = (size_t)(BK * 2);
    const size_t hstep = (size_t)HALF * K * 2;
    const size_t tstep = 2 * hstep;
    const unsigned ldsw = (unsigned)wid * 1024u;
    const int aoff = lds_byte(wr * 64 + fr, fq * 8), boff = lds_byte(wc * 32 + fr, fq * 8);
#define PG8_SA(b, h) (((b) * 2 + (h)) * HTB)
#define PG8_SB(b, h) ((4 + (b) * 2 + (h)) * HTB)
#define PG8_STAGE(bufoff, gbase, voff) do { _Pragma("unroll") for (int _i = 0; _i < 2; ++_i) \
        __builtin_amdgcn_global_load_lds((const unsigned*)((const char*)(gbase) + (voff)[_i]), (PG8_LAS unsigned*)(lds + (bufoff) + ldsw + _i * 8192), 16, 0, 0); } while (0)
#define PG8_LDA(dst, b, h) do { _Pragma("unroll") for (int m = 0; m < 4; ++m) _Pragma("unroll") for (int k = 0; k < 2; ++k) dst[m][k] = *(const PG8_LAS bf16x8*)(lds + PG8_SA(b, h) + aoff + m * 2048 + k * 1024); } while (0)
#define PG8_LDB(dst, b, h) do { _Pragma("unroll") for (int n = 0; n < 2; ++n) _Pragma("unroll") for (int k = 0; k < 2; ++k) dst[n][k] = *(const PG8_LAS bf16x8*)(lds + PG8_SB(b, h) + boff + n * 2048 + k * 1024); } while (0)
#define PG8_MMA(ai, bj, At, Bt) do { __builtin_amdgcn_s_setprio(1); _Pragma("unroll") for (int m = 0; m < 4; ++m) _Pragma("unroll") for (int n = 0; n < 2; ++n) _Pragma("unroll") for (int k = 0; k < 2; ++k) \
        acc[ai][bj][m][n] = __builtin_amdgcn_mfma_f32_16x16x32_bf16(Bt[n][k], At[m][k], acc[ai][bj][m][n], 0, 0, 0); __builtin_amdgcn_s_setprio(0); } while (0)
#define PG8_WAIT_V(n) asm volatile("s_waitcnt vmcnt(" #n ")" ::: "memory")
#define PG8_WAIT_L(n) asm volatile("s_waitcnt lgkmcnt(" #n ")" ::: "memory")
#define PG8_BAR __builtin_amdgcn_s_barrier()
#define PG8_SCHED __builtin_amdgcn_sched_barrier(0)
    Unit cur, nxt; int ui = 0;
    if (!S.next(0, cur)) return;
    f32x4 acc[2][2][4][2];
#pragma unroll
    for (int a = 0; a < 2; ++a)
#pragma unroll
        for (int b = 0; b < 2; ++b)
#pragma unroll
            for (int m = 0; m < 4; ++m)
#pragma unroll
                for (int n = 0; n < 2; ++n) acc[a][b][m][n] = (f32x4){0.f, 0.f, 0.f, 0.f};
    bf16x8 At[4][2], B0[2][2], B1[2][2];
    const char* cA = (const char*)g.A + (size_t)cur.pm * tstep; const char* cB = (const char*)g.Bt + (size_t)cur.pn * tstep;
    S.a_ready(cur);
    if constexpr (SP2) {
        PG8_STAGE(PG8_SB(0, 0), cB, voffB); PG8_STAGE(PG8_SB(0, 1), cB + hstep, voffB); PG8_STAGE(PG8_SA(0, 0), cA, voffA); PG8_STAGE(PG8_SA(0, 1), cA + hstep, voffA);
        if (wr == 1) PG8_BAR;
        PG8_WAIT_V(2); PG8_BAR;
        PG8_STAGE(PG8_SB(1, 0), cB + kstep, voffB); PG8_STAGE(PG8_SA(1, 0), cA + kstep, voffA); PG8_STAGE(PG8_SB(1, 1), cB + hstep + kstep, voffB);
        PG8_WAIT_V(6); PG8_BAR;
    } else {
        PG8_STAGE(PG8_SB(0, 0), cB, voffB); PG8_STAGE(PG8_SA(0, 0), cA, voffA); PG8_STAGE(PG8_SB(0, 1), cB + hstep, voffB); PG8_STAGE(PG8_SA(0, 1), cA + hstep, voffA);
        if (wr == 1) PG8_BAR;
        PG8_WAIT_V(4); PG8_BAR;
        PG8_STAGE(PG8_SB(1, 0), cB + kstep, voffB); PG8_STAGE(PG8_SA(1, 0), cA + kstep, voffA); PG8_STAGE(PG8_SB(1, 1), cB + hstep + kstep, voffB);
        PG8_WAIT_V(6); PG8_BAR;
    }
    for (;;) {
        const bool has_next = S.next(ui + 1, nxt);
        const char* nA = has_next ? (const char*)g.A + (size_t)nxt.pm * tstep : cA; const char* nB = has_next ? (const char*)g.Bt + (size_t)nxt.pn * tstep : cB;
        for (int t = 0; t < nt; t += 2) {
            const bool last = (t == nt - 2);
            const char* a1 = cA + (size_t)(t + 1) * kstep;
            const char* a2 = last ? nA : cA + (size_t)(t + 2) * kstep; const char* b2 = last ? nB : cB + (size_t)(t + 2) * kstep;
            const char* a3 = a2 + kstep; const char* b3 = b2 + kstep;
            if (last && has_next) S.a_ready(nxt);
            if constexpr (SP2) {
            PG8_LDB(B0, 0, 0); PG8_LDB(B1, 0, 1); PG8_SCHED; PG8_LDA(At, 0, 0); PG8_STAGE(PG8_SA(1, 1), a1 + hstep, voffA);
            PG8_WAIT_V(8); PG8_WAIT_L(0); PG8_BAR; PG8_MMA(0, 0, At, B0); PG8_MMA(0, 1, At, B1); PG8_BAR; PG8_SCHED;
            PG8_LDA(At, 0, 1); PG8_STAGE(PG8_SB(0, 0), b2, voffB); PG8_STAGE(PG8_SB(0, 1), b2 + hstep, voffB); PG8_STAGE(PG8_SA(0, 0), a2, voffA);
            PG8_WAIT_V(8); PG8_WAIT_L(0); PG8_BAR; PG8_MMA(1, 0, At, B0); PG8_MMA(1, 1, At, B1); PG8_BAR; PG8_SCHED;
            PG8_LDB(B0, 1, 0); PG8_LDB(B1, 1, 1); PG8_SCHED; PG8_LDA(At, 1, 0); PG8_STAGE(PG8_SA(0, 1), a2 + hstep, voffA);
            PG8_WAIT_V(8); PG8_WAIT_L(0); PG8_BAR; PG8_MMA(0, 0, At, B0); PG8_MMA(0, 1, At, B1); PG8_BAR; PG8_SCHED;
            PG8_LDA(At, 1, 1); PG8_STAGE(PG8_SB(1, 0), b3, voffB); PG8_STAGE(PG8_SB(1, 1), b3 + hstep, voffB); PG8_STAGE(PG8_SA(1, 0), a3, voffA);
            PG8_WAIT_V(8); PG8_WAIT_L(0); PG8_BAR; PG8_MMA(1, 0, At, B0); PG8_MMA(1, 1, At, B1); PG8_BAR; PG8_SCHED;
            } else {
            PG8_LDB(B0, 0, 0); PG8_SCHED; PG8_LDA(At, 0, 0); PG8_STAGE(PG8_SA(1, 1), a1 + hstep, voffA);
            PG8_WAIT_L(8); PG8_BAR; PG8_WAIT_L(0); PG8_MMA(0, 0, At, B0); PG8_BAR; PG8_SCHED;
            PG8_LDB(B1, 0, 1); PG8_STAGE(PG8_SB(0, 0), b2, voffB);
            PG8_BAR; PG8_WAIT_L(0); PG8_MMA(0, 1, At, B1); PG8_BAR;
            PG8_LDA(At, 0, 1); PG8_STAGE(PG8_SA(0, 0), a2, voffA);
            PG8_BAR; PG8_WAIT_L(0); PG8_MMA(1, 0, At, B0); PG8_BAR; PG8_SCHED;
            PG8_STAGE(PG8_SB(0, 1), b2 + hstep, voffB);
            PG8_WAIT_V(6); PG8_BAR; PG8_MMA(1, 1, At, B1); PG8_BAR;
            PG8_LDB(B0, 1, 0); PG8_SCHED; PG8_LDA(At, 1, 0); PG8_STAGE(PG8_SA(0, 1), a2 + hstep, voffA);
            PG8_WAIT_L(8); PG8_BAR; PG8_WAIT_L(0); PG8_MMA(0, 0, At, B0); PG8_BAR; PG8_SCHED;
            PG8_LDB(B1, 1, 1); PG8_STAGE(PG8_SB(1, 0), b3, voffB);
            PG8_BAR; PG8_WAIT_L(0); PG8_MMA(0, 1, At, B1); PG8_BAR;
            PG8_LDA(At, 1, 1); PG8_STAGE(PG8_SA(1, 0), a3, voffA);
            PG8_BAR; PG8_WAIT_L(0); PG8_MMA(1, 0, At, B0); PG8_BAR; PG8_SCHED;
            PG8_STAGE(PG8_SB(1, 1), b3 + hstep, voffB);
            PG8_WAIT_V(6); PG8_BAR; PG8_MMA(1, 1, At, B1); PG8_BAR;
            }
        }
        if constexpr (ALIGN_EPI) { if (wr == 0) PG8_BAR; }
        if constexpr (!Epi::AFTER_DRAIN) { E(acc, cur, wr, wc, fr, fq); S.done(cur); }
        if (!has_next) break;
#pragma unroll
        for (int a = 0; a < 2; ++a)
#pragma unroll
            for (int b = 0; b < 2; ++b)
#pragma unroll
                for (int m = 0; m < 4; ++m)
#pragma unroll
                    for (int n = 0; n < 2; ++n) acc[a][b][m][n] = (f32x4){0.f, 0.f, 0.f, 0.f};
        cur = nxt; cA = nA; cB = nB; ++ui;
        if constexpr (ALIGN_EPI) { if (wr == 1) PG8_BAR; }
    }
    PG8_WAIT_V(0);
    if constexpr (!ALIGN_EPI) { if (wr == 0) PG8_BAR; }
    PG8_BAR;
    if constexpr (Epi::AFTER_DRAIN) { E.fused(acc, cur, wr, wc, fr, fq, lds, wid, lane); S.done(cur); }
#undef PG8_SA
#undef PG8_SB
#undef PG8_STAGE
#undef PG8_LDA
#undef PG8_LDB
#undef PG8_MMA
#undef PG8_WAIT_V
#undef PG8_WAIT_L
#undef PG8_BAR
#undef PG8_SCHED
}
}
#define GAS __attribute__((address_space(1)))
#define LAS __attribute__((address_space(3)))
#define XB_TMO      128
#define XB_XCNT(j)  (256  + 64 * (j))
#define XB_XSUB(j)  (1280 + 64 * (j))
#define XB_XGEN(j)  (2304 + 64 * (j))
#define XB_TOP      3328
#define XB_TOPGEN   3392
#define XCD_BAR_WORDS 3456
#define XB_SPIN_CAP (1u << 18)

__device__ __forceinline__ unsigned xb_ld(unsigned* p)              { return __hip_atomic_load(p, __ATOMIC_RELAXED, __HIP_MEMORY_SCOPE_AGENT); }
__device__ __forceinline__ unsigned xb_add(unsigned* p, unsigned v) { return __hip_atomic_fetch_add(p, v, __ATOMIC_RELAXED, __HIP_MEMORY_SCOPE_AGENT); }
__device__ __forceinline__ unsigned xb_xcc_id() { return (unsigned)__builtin_amdgcn_s_getreg((3 << 11) | 20) & 0xFu; }
#define XB_SPIN(cond, bar) do { unsigned _sp = 0; while (cond) { __builtin_amdgcn_s_sleep(1); \
    if ((++_sp & 255u) == 0u) { if (xb_ld(&(bar)[XB_TMO])) break; if (_sp > XB_SPIN_CAP) { atomicAdd(&(bar)[XB_TMO], 1u); break; } } } } while (0)

struct XcdBarrier {
    unsigned* bar; unsigned x;
    volatile LAS unsigned* st;
};

__device__ __forceinline__ XcdBarrier xcd_barrier_post(unsigned* bar, volatile LAS unsigned* st) {
    XcdBarrier b; b.bar = bar; b.x = xb_xcc_id(); b.st = st;
    if (threadIdx.x == 0) (void)xb_add(&bar[XB_XCNT(b.x)], 1u);
    return b;
}
__device__ __forceinline__ void xcd_barrier_complete(unsigned* bar, unsigned x, unsigned& nloc, unsigned& nx) {
    const unsigned G = gridDim.x * gridDim.y * gridDim.z;
    unsigned sum, cnt, mine, sp = 0u;
    for (;;) {
        sum = 0u; cnt = 0u; mine = 0u;
#pragma unroll
        for (unsigned j = 0; j < 16; ++j) { const unsigned c = xb_ld(&bar[XB_XCNT(j)]); sum += c; cnt += (c > 0u) ? 1u : 0u; mine = (j == x) ? c : mine; }
        if (sum == G) break;
        __builtin_amdgcn_s_sleep(1);
        if ((++sp & 255u) == 0u) { if (xb_ld(&bar[XB_TMO])) break; if (sp > XB_SPIN_CAP) { atomicAdd(&bar[XB_TMO], 1u); break; } }
    }
    nloc = mine > 0u ? mine : 1u; nx = cnt > 0u ? cnt : 1u;
}

__device__ __forceinline__ void xcd_barrier(const XcdBarrier& b) {
    asm volatile("s_waitcnt vmcnt(0)" ::: "memory");
    __syncthreads();
    if (threadIdx.x == 0) {
        unsigned* bar = b.bar;
        __builtin_amdgcn_s_waitcnt(0);
        unsigned nloc = b.st[0], nx = b.st[1];
        if (nloc == 0u) { xcd_barrier_complete(bar, b.x, nloc, nx); b.st[0] = nloc; b.st[1] = nx; }
        const unsigned old = xb_add(&bar[XB_XSUB(b.x)], 1u);
        const unsigned gen = old / nloc;
        if (old + 1u == (gen + 1u) * nloc) {
            __builtin_amdgcn_fence(__ATOMIC_RELEASE, "agent");
            asm volatile("s_waitcnt vmcnt(0)" ::: "memory");
            const unsigned og = xb_add(&bar[XB_TOP], 1u);
            const unsigned tg = og / nx;
            if (og + 1u == (tg + 1u) * nx) xb_add(&bar[XB_TOPGEN], 1u);
            else XB_SPIN(xb_ld(&bar[XB_TOPGEN]) == tg, bar);
            __builtin_amdgcn_fence(__ATOMIC_ACQUIRE, "agent");
            xb_add(&bar[XB_XGEN(b.x)], 1u);
            asm volatile("s_waitcnt vmcnt(0)" ::: "memory");
        } else {
            XB_SPIN(xb_ld(&bar[XB_XGEN(b.x)]) == gen, bar);
            __builtin_amdgcn_fence(__ATOMIC_ACQUIRE, "agent");
            asm volatile("s_waitcnt vmcnt(0)" ::: "memory");
        }
    }
    __syncthreads();
}

#ifndef MK_N_LAUNCHES
#define MK_N_LAUNCHES 1
#endif
constexpr int NWAVES = 8;
constexpr int DM = 2048, SEQ = 2048, NBATCH = 4, MP = NBATCH * SEQ, MS = 32, MT = MP + MS;
constexpr int INC = 3584, FF = 8192, NH = 16, NKV = 4, HD = 64, CCH = 1024, CW = 31;
constexpr float EPS = 1e-6f;
constexpr size_t O_YP = 0, O_YS = (size_t)MP * DM, O_KP = O_YS + (size_t)MS * DM, O_VP = O_KP + 131072, O_CP = O_VP + 131072,
                 O_KS = O_CP + 122880, O_VS = O_KS + 1048576, O_CS = O_VS + 1048576, O_END = O_CS + 983040;
constexpr size_t MiB = 1u << 20;
constexpr size_t WS_CTL = 0, CTL_ZERO_BYTES = 68 * 1024;
constexpr size_t WS_SSQ = 32 * 1024, WS_SSQ0 = 96 * 1024;
constexpr size_t WS_COS = 1 * MiB, WS_SIN = 2 * MiB;
constexpr size_t WS_ZS = 3 * MiB;
constexpr size_t WS_WIN = 4 * MiB, WS_WOUT = 18 * MiB, WS_WUP = 26 * MiB, WS_WDN = 58 * MiB;
constexpr size_t WS_X1G = 90 * MiB;
constexpr size_t WS_HID = 123 * MiB;
constexpr size_t WS_XN = 123 * MiB, WS_Q = 156 * MiB, WS_K = 172 * MiB, WS_V = 176 * MiB, WS_U = 180 * MiB, WS_MIX = 196 * MiB;
constexpr size_t WS_END = 256 * MiB;
static_assert(WS_HID + (size_t)MT * FF * 2 <= WS_END && WS_MIX + (size_t)MT * DM * 2 <= WS_END && WS_X1G + (size_t)MT * DM * 2 <= WS_HID, "ws map");
constexpr int CW_BAR = 4096;
constexpr int RING_BYTES = 131072, LDSCTL_OFF = RING_BYTES, MISC_OFF = LDSCTL_OFF + 320, LDS_BYTES = 147456;

typedef unsigned short bf16;
typedef unsigned v4u __attribute__((ext_vector_type(4)));
typedef unsigned v2u __attribute__((ext_vector_type(2)));
typedef float f32x4 __attribute__((ext_vector_type(4)));
typedef float f32x2 __attribute__((ext_vector_type(2)));
typedef short bf16x8 __attribute__((ext_vector_type(8)));
#define LDS_WAIT() asm volatile("s_waitcnt lgkmcnt(0)" ::: "memory")
__device__ __forceinline__ unsigned f2bf(float f) { unsigned u = __builtin_bit_cast(unsigned, f); return (u + 0x7fffu + ((u >> 16) & 1u)) >> 16; }
__device__ __forceinline__ unsigned pk2(float lo, float hi) { return pg8::cvt_pk_bf16(lo, hi); }
__device__ __forceinline__ float bf2f(unsigned h) { return __builtin_bit_cast(float, h << 16); }
template <int CTRL, int ROWMASK> __device__ __forceinline__ float dpp_get(float v) {
    return __builtin_bit_cast(float, __builtin_amdgcn_update_dpp(0, __builtin_bit_cast(int, v), CTRL, ROWMASK, 0xf, false)); }
__device__ __forceinline__ float wave_sum(float v) {
    v += dpp_get<0xB1, 0xf>(v); v += dpp_get<0x4E, 0xf>(v); v += dpp_get<0x124, 0xf>(v); v += dpp_get<0x128, 0xf>(v);
    v += dpp_get<0x142, 0xa>(v); v += dpp_get<0x143, 0xc>(v);
    return __builtin_bit_cast(float, __builtin_amdgcn_readlane(__builtin_bit_cast(int, v), 63));
}
__device__ __forceinline__ float wave_max(float v) {
    v = fmaxf(v, dpp_get<0xB1, 0xf>(v)); v = fmaxf(v, dpp_get<0x4E, 0xf>(v)); v = fmaxf(v, dpp_get<0x124, 0xf>(v)); v = fmaxf(v, dpp_get<0x128, 0xf>(v));
    const int iv = __builtin_bit_cast(int, v);
    const float a = __builtin_bit_cast(float, __builtin_amdgcn_readlane(iv, 0)), b = __builtin_bit_cast(float, __builtin_amdgcn_readlane(iv, 16)),
                c = __builtin_bit_cast(float, __builtin_amdgcn_readlane(iv, 32)), d = __builtin_bit_cast(float, __builtin_amdgcn_readlane(iv, 48));
    return fmaxf(fmaxf(a, b), fmaxf(c, d));
}
__device__ __forceinline__ float dot4(f32x4 a, f32x4 b) { return (a[0] * b[0] + a[1] * b[1]) + (a[2] * b[2] + a[3] * b[3]); }
__device__ __forceinline__ float sigmoidf_(float g) { return 1.0f / (1.0f + __expf(-g)); }

__device__ __forceinline__ int win_dst_group(int sg) {
    if (sg < 48) { const int pn = sg >> 3, wc = (sg & 7) >> 1, bj = sg & 1; return 8 * pn + 4 * bj + wc; }
    if (sg < 80) { const int cc = sg - 48; return 8 * (6 + (cc >> 2)) + (cc & 3); }
    const int cc = sg - 80; return 8 * (6 + (cc >> 2)) + 4 + (cc & 3);
}
__device__ __forceinline__ int win_logical_col(int np) {
    const int dg = np >> 5, e = np & 31, pn = dg >> 3, bj = (dg >> 2) & 1, wc = dg & 3;
    if (dg < 48) return 256 * pn + 64 * wc + 32 * bj + e;
    return (bj ? 2560 : 1536) + 128 * (pn - 6) + 32 * wc + e;
}

using pg8::Unit;
struct Epi1 {
    static constexpr bool PERM = true, AFTER_DRAIN = false;
    bf16 *Q, *K, *V, *U; float* out; const float *gq, *gk, *cosT, *sinT, *SSQ0;
    __device__ __forceinline__ void operator()(const f32x4 (&acc)[2][2][4][2], const Unit& u, int wr, int wc, int fr, int fq) const {
        const int pn = u.pn, rbase = u.pm * 256 + wr * 64 + fr;
        if (pn < 5) {
            const float* g = pn < 4 ? gq : gk; const float qs = pn < 4 ? 0.125f : 1.0f;
            const f32x4 g1a = *(const f32x4*)(g + 8 * fq), g1b = *(const f32x4*)(g + 8 * fq + 4), g2a = *(const f32x4*)(g + 32 + 8 * fq), g2b = *(const f32x4*)(g + 36 + 8 * fq);
#pragma unroll
            for (int ah = 0; ah < 4; ++ah) {
                const int ai = ah >> 1;
                f32x4 rc[4][2], rs[4][2]; float r0[4];
#pragma unroll
                for (int m = 2 * (ah & 1); m < 2 * (ah & 1) + 2; ++m) { const int s = (rbase + ai * 128 + m * 16) & (SEQ - 1);
                    r0[m] = SSQ0[rbase + ai * 128 + m * 16];
                    rc[m][0] = *(const f32x4*)(cosT + s * 32 + 8 * fq); rc[m][1] = *(const f32x4*)(cosT + s * 32 + 8 * fq + 4);
                    rs[m][0] = *(const f32x4*)(sinT + s * 32 + 8 * fq); rs[m][1] = *(const f32x4*)(sinT + s * 32 + 8 * fq + 4); }
                asm volatile("" ::: "memory");
#pragma unroll
                for (int m = 2 * (ah & 1); m < 2 * (ah & 1) + 2; ++m) {
                    const int r = rbase + ai * 128 + m * 16, s = r & (SEQ - 1), b = r >> 11;
                    const float rr = rsqrtf(r0[m] * (1.0f / DM) + EPS);
                    const f32x4 x1a = acc[ai][0][m][0] * rr, x1b = acc[ai][0][m][1] * rr, x2a = acc[ai][1][m][0] * rr, x2b = acc[ai][1][m][1] * rr;
                    float ss = (dot4(x1a, x1a) + dot4(x1b, x1b)) + (dot4(x2a, x2a) + dot4(x2b, x2b));
                    ss += __shfl_xor(ss, 16); ss += __shfl_xor(ss, 32);
                    const float rstd = rsqrtf(ss * (1.0f / 64.0f) + EPS);
                    const f32x4 y1a = x1a * rstd * g1a, y1b = x1b * rstd * g1b, y2a = x2a * rstd * g2a, y2b = x2b * rstd * g2b;
                    const f32x4 ca = rc[m][0], cb = rc[m][1], sa = rs[m][0], sb = rs[m][1];
                    const f32x4 o1a = y1a * ca - y2a * sa, o1b = y1b * cb - y2b * sb, o2a = y2a * ca + y1a * sa, o2b = y2b * cb + y1b * sb;
                    v4u w1, w2;
                    w1.x = pk2(o1a[0] * qs, o1a[1] * qs); w1.y = pk2(o1a[2] * qs, o1a[3] * qs); w1.z = pk2(o1b[0] * qs, o1b[1] * qs); w1.w = pk2(o1b[2] * qs, o1b[3] * qs);
                    w2.x = pk2(o2a[0] * qs, o2a[1] * qs); w2.y = pk2(o2a[2] * qs, o2a[3] * qs); w2.z = pk2(o2b[0] * qs, o2b[1] * qs); w2.w = pk2(o2b[2] * qs, o2b[3] * qs);
                    if (pn < 4) {
                        bf16* p = Q + (size_t)r * 1024 + 64 * (4 * pn + wc) + 8 * fq;
                        *(v4u*)p = w1; *(v4u*)(p + 32) = w2;
                    } else {
                        bf16* p = K + (size_t)r * 256 + 64 * wc + 8 * fq;
                        *(v4u*)p = w1; *(v4u*)(p + 32) = w2;
                        if (s >= SEQ - 128) {
                            float* o = out + O_KP + ((size_t)(b * 128 + s - (SEQ - 128)) * 4 + wc) * 64 + 8 * fq;
                            *(f32x4*)o = o1a; *(f32x4*)(o + 4) = o1b; *(f32x4*)(o + 32) = o2a; *(f32x4*)(o + 36) = o2b;
                        }
                    }
                }
                asm volatile("" ::: "memory");
            }
        } else if (pn == 5) {
#pragma unroll
            for (int ai = 0; ai < 2; ++ai) {
                float r0[4];
#pragma unroll
                for (int m = 0; m < 4; ++m) r0[m] = SSQ0[rbase + ai * 128 + m * 16];
                asm volatile("" ::: "memory");
#pragma unroll
                for (int m = 0; m < 4; ++m) {
                    const int r = rbase + ai * 128 + m * 16, s = r & (SEQ - 1), b = r >> 11; const float rr = rsqrtf(r0[m] * (1.0f / DM) + EPS);
#pragma unroll
                    for (int bj = 0; bj < 2; ++bj) {
                        const f32x4 v0 = acc[ai][bj][m][0] * rr, v1 = acc[ai][bj][m][1] * rr;
                        v4u w; w.x = pk2(v0[0], v0[1]); w.y = pk2(v0[2], v0[3]); w.z = pk2(v1[0], v1[1]); w.w = pk2(v1[2], v1[3]);
                        *(v4u*)(V + (size_t)r * 256 + 64 * wc + 32 * bj + 8 * fq) = w;
                        if (s >= SEQ - 128) {
                            float* o = out + O_VP + ((size_t)(b * 128 + s - (SEQ - 128)) * 4 + wc) * 64 + 32 * bj + 8 * fq;
                            *(f32x4*)o = v0; *(f32x4*)(o + 4) = v1;
                        }
                    }
                }
            }
        } else {
            const int ch = 128 * (pn - 6) + 32 * wc + 8 * fq;
#pragma unroll
            for (int ai = 0; ai < 2; ++ai) {
                float r0[4];
#pragma unroll
                for (int m = 0; m < 4; ++m) r0[m] = SSQ0[rbase + ai * 128 + m * 16];
                asm volatile("" ::: "memory");
#pragma unroll
                for (int m = 0; m < 4; ++m) {
                    const int r = rbase + ai * 128 + m * 16, s = r & (SEQ - 1), b = r >> 11;
                    const float rr = rsqrtf(r0[m] * (1.0f / DM) + EPS);
                    const f32x4 a0 = acc[ai][0][m][0] * rr, a1 = acc[ai][0][m][1] * rr, g0 = acc[ai][1][m][0] * rr, g1 = acc[ai][1][m][1] * rr;
                    f32x4 u0, u1;
#pragma unroll
                    for (int j = 0; j < 4; ++j) { u0[j] = a0[j] * sigmoidf_(g0[j]); u1[j] = a1[j] * sigmoidf_(g1[j]); }
                    v4u w; w.x = pk2(u0[0], u0[1]); w.y = pk2(u0[2], u0[3]); w.z = pk2(u1[0], u1[1]); w.w = pk2(u1[2], u1[3]);
                    *(v4u*)(U + (size_t)r * 1024 + ch) = w;
                    if (s >= SEQ - 30) {
                        float* o = out + O_CP + (size_t)(b * 30 + s - (SEQ - 30)) * 1024 + ch;
                        *(f32x4*)o = u0; *(f32x4*)(o + 4) = u1;
                    }
                }
            }
        }
    }
};
struct Epi3 {
    static constexpr bool PERM = true, AFTER_DRAIN = false;
    const bf16* XB; float* Y; bf16* X1G; const float* gm; float* SSQ;
    __device__ __forceinline__ void operator()(const f32x4 (&acc)[2][2][4][2], const Unit& u, int wr, int wc, int fr, int fq) const {
        const int rbase = u.pm * 256 + wr * 64 + fr, col0 = u.pn * 256 + wc * 32 + 8 * fq;
#pragma unroll
        for (int ai = 0; ai < 2; ++ai) {
            f32x4 pre[4][2][2];
#pragma unroll
            for (int m = 0; m < 4; ++m)
#pragma unroll
                for (int bj = 0; bj < 2; ++bj) { const v4u q = *(const v4u*)(XB + (size_t)(rbase + ai * 128 + m * 16) * DM + col0 + bj * 128);
                    pre[m][bj][0] = (f32x4){bf2f(q.x & 0xffffu), bf2f(q.x >> 16), bf2f(q.y & 0xffffu), bf2f(q.y >> 16)};
                    pre[m][bj][1] = (f32x4){bf2f(q.z & 0xffffu), bf2f(q.z >> 16), bf2f(q.w & 0xffffu), bf2f(q.w >> 16)}; }
            asm volatile("" ::: "memory");
#pragma unroll
            for (int m = 0; m < 4; ++m) {
                const int r = rbase + ai * 128 + m * 16; float ss = 0.f;
#pragma unroll
                for (int bj = 0; bj < 2; ++bj) {
                    const size_t off = (size_t)r * DM + col0 + bj * 128;
                    const f32x4 v0 = acc[ai][bj][m][0] + pre[m][bj][0], v1 = acc[ai][bj][m][1] + pre[m][bj][1];
                    ss += dot4(v0, v0) + dot4(v1, v1);
                    v4u w; w.x = pk2(v0[0], v0[1]); w.y = pk2(v0[2], v0[3]); w.z = pk2(v1[0], v1[1]); w.w = pk2(v1[2], v1[3]);
                    *(v4u*)(X1G + off) = w;
                }
                ss += __shfl_xor(ss, 16); ss += __shfl_xor(ss, 32);
                if (fq == 0) atomicAdd(SSQ + r, ss);
            }
            asm volatile("" ::: "memory");
        }
    }
};
struct Epi4 {
    static constexpr bool PERM = true, AFTER_DRAIN = false;
    const float* SSQ; bf16* H;
    __device__ __forceinline__ void operator()(const f32x4 (&acc)[2][2][4][2], const Unit& u, int wr, int wc, int fr, int fq) const {
        const int rbase = u.pm * 256 + wr * 64 + fr, col0 = u.pn * 256 + wc * 32 + 8 * fq;
        float sq[2][4];
#pragma unroll
        for (int ai = 0; ai < 2; ++ai)
#pragma unroll
            for (int m = 0; m < 4; ++m) sq[ai][m] = SSQ[rbase + ai * 128 + m * 16];
        asm volatile("" ::: "memory");
#pragma unroll
        for (int ai = 0; ai < 2; ++ai)
#pragma unroll
            for (int m = 0; m < 4; ++m) {
                const int r = rbase + ai * 128 + m * 16;
                const float rstd = rsqrtf(sq[ai][m] * (1.0f / DM) + EPS);
#pragma unroll
                for (int bj = 0; bj < 2; ++bj) {
                    f32x4 v0 = acc[ai][bj][m][0] * rstd, v1 = acc[ai][bj][m][1] * rstd;
#pragma unroll
                    for (int j = 0; j < 4; ++j) { v0[j] = fmaxf(v0[j], 0.f); v0[j] *= v0[j]; v1[j] = fmaxf(v1[j], 0.f); v1[j] *= v1[j]; }
                    v4u w; w.x = pk2(v0[0], v0[1]); w.y = pk2(v0[2], v0[3]); w.z = pk2(v1[0], v1[1]); w.w = pk2(v1[2], v1[3]);
                    *(v4u*)(H + (size_t)r * FF + col0 + bj * 128) = w;
                }
            }
    }
};
struct Epi5 {
    static constexpr bool PERM = true, AFTER_DRAIN = false;
    float* Y; const bf16* X1G;
    __device__ __forceinline__ void operator()(const f32x4 (&acc)[2][2][4][2], const Unit& u, int wr, int wc, int fr, int fq) const {
        const int rbase = u.pm * 256 + wr * 64 + fr, col0 = u.pn * 256 + wc * 32 + 8 * fq;
        v4u pre[2][4][2];
#pragma unroll
        for (int ai = 0; ai < 2; ++ai)
#pragma unroll
            for (int m = 0; m < 4; ++m)
#pragma unroll
                for (int bj = 0; bj < 2; ++bj) pre[ai][m][bj] = *(const v4u*)(X1G + (size_t)(rbase + ai * 128 + m * 16) * DM + col0 + bj * 128);
        asm volatile("" ::: "memory");
#pragma unroll
        for (int ai = 0; ai < 2; ++ai)
#pragma unroll
            for (int m = 0; m < 4; ++m)
#pragma unroll
                for (int bj = 0; bj < 2; ++bj) { float* p = Y + (size_t)(rbase + ai * 128 + m * 16) * DM + col0 + bj * 128; const v4u q = pre[ai][m][bj];
                    const f32x4 r0 = {bf2f(q.x & 0xffffu), bf2f(q.x >> 16), bf2f(q.y & 0xffffu), bf2f(q.y >> 16)}, r1 = {bf2f(q.z & 0xffffu), bf2f(q.z >> 16), bf2f(q.w & 0xffffu), bf2f(q.w >> 16)};
                    *(f32x4*)p = acc[ai][bj][m][0] + r0; *(f32x4*)(p + 4) = acc[ai][bj][m][1] + r1; }
    }
};

template <class EpiS>
__device__ __forceinline__ void skinny_phase(LAS unsigned char* lds, const bf16* As, const bf16* Bt, int N, int K, int start, int stride, const EpiS& E, const int wid_in) {
    const int wave = wid_in; int tid = wave * 64 + mk_fresh_lane(); asm volatile("" : "+v"(tid));
    const int lane = tid & 63, fr = lane & 15, fq = lane >> 4;
    LAS float* red = (LAS float*)lds;
    const int kw = K >> 3, kb = wave * kw;
    for (int unit = start; unit < (N >> 4); unit += stride) {
        f32x4 a0 = {0.f, 0.f, 0.f, 0.f}, a1 = {0.f, 0.f, 0.f, 0.f};
        const bf16* bp = Bt + (size_t)(16 * unit + fr) * K + kb + 8 * fq;
        const bf16* ap0 = As + (size_t)fr * K + kb + 8 * fq;
        const bf16* ap1 = ap0 + (size_t)16 * K;
#pragma unroll 8
        for (int k = 0; k < kw; k += 32) {
            const bf16x8 b = *(const bf16x8*)(bp + k), x0 = *(const bf16x8*)(ap0 + k), x1 = *(const bf16x8*)(ap1 + k);
            a0 = __builtin_amdgcn_mfma_f32_16x16x32_bf16(b, x0, a0, 0, 0, 0);
            a1 = __builtin_amdgcn_mfma_f32_16x16x32_bf16(b, x1, a1, 0, 0, 0);
        }
        *(LAS f32x4*)(red + (wave * 2 + 0) * 256 + lane * 4) = a0;
        *(LAS f32x4*)(red + (wave * 2 + 1) * 256 + lane * 4) = a1;
        __syncthreads();
        const int row = tid >> 4, cj = tid & 15, idx = (row >> 4) * 256 + ((row & 15) + 16 * (cj >> 2)) * 4 + (cj & 3);
        float s = 0.f;
#pragma unroll
        for (int w = 0; w < 8; ++w) s += red[w * 512 + idx];
        E(row, 16 * unit + cj, s);
        __syncthreads();
    }
}
struct EpiS1 { float* ZS; const float* SSQ0; __device__ __forceinline__ void operator()(int row, int col, float v) const { ZS[row * INC + win_logical_col(col)] = v * rsqrtf(SSQ0[MP + row] * (1.0f / DM) + EPS); } };
struct EpiS3 { const float* xs; float* Y; bf16* X1G; const float* gm; float* SSQ;
    __device__ __forceinline__ void operator()(int row, int col, float v) const {
        const float x1 = xs[row * DM + col] + v; X1G[(size_t)(MP + row) * DM + col] = (bf16)f2bf(x1);
        float ss = x1 * x1; ss += __shfl_xor(ss, 1); ss += __shfl_xor(ss, 2); ss += __shfl_xor(ss, 4); ss += __shfl_xor(ss, 8);
        if ((mk_fresh_lane() & 15) == 0) atomicAdd(SSQ + MP + row, ss);
    } };
struct EpiS4 { float* SSQ; bf16* H;
    __device__ __forceinline__ void operator()(int row, int col, float v) const {
        const float rstd = rsqrtf(__hip_atomic_load(SSQ + MP + row, __ATOMIC_RELAXED, __HIP_MEMORY_SCOPE_AGENT) * (1.0f / DM) + EPS);
        float h = fmaxf(v * rstd, 0.f); h *= h; H[(size_t)(MP + row) * FF + col] = (bf16)f2bf(h);
    } };
struct EpiS5 { float* Y; const bf16* X1G; float fac; __device__ __forceinline__ void operator()(int row, int col, float v) const { const size_t o = (size_t)(MP + row) * DM + col; Y[o] = (bf2f((unsigned)X1G[o]) + v) * fac; } };

template <int DEPTH, class Dec, bool NTST = false>
__device__ __forceinline__ void cvt_items(LAS float* scr, int first, int total, int stride, int lane, const Dec& D) {
    const int r8 = lane >> 3, c4 = lane & 7;
    int it = first; if (it >= total) return;
    const float* src; int N;
    f32x4 v[DEPTH][8]; bf16* dst[DEPTH]; int K[DEPTH];
#pragma unroll
    for (int d = 0; d < DEPTH; ++d) { dst[d] = nullptr; K[d] = 0; }
#pragma unroll
    for (int d = 0; d < DEPTH - 1; ++d)
        if (it + d * stride < total) { D(it + d * stride, src, N, dst[d], K[d]);
#pragma unroll
            for (int i = 0; i < 8; ++i) v[d][i] = __builtin_nontemporal_load((const f32x4*)(src + (size_t)(r8 + 8 * i) * N + 4 * c4)) * D.rowscale(it + d * stride, r8 + 8 * i); }
    for (;;) {
        const int nl = it + (DEPTH - 1) * stride;
        if (nl < total) { D(nl, src, N, dst[DEPTH - 1], K[DEPTH - 1]);
#pragma unroll
            for (int i = 0; i < 8; ++i) v[DEPTH - 1][i] = __builtin_nontemporal_load((const f32x4*)(src + (size_t)(r8 + 8 * i) * N + 4 * c4)) * D.rowscale(nl, r8 + 8 * i); }
#pragma unroll
        for (int i = 0; i < 8; ++i) { LAS float* s = scr + (r8 + 8 * i) * 33 + 4 * c4; s[0] = v[0][i][0]; s[1] = v[0][i][1]; s[2] = v[0][i][2]; s[3] = v[0][i][3]; }
        LDS_WAIT(); asm volatile("" ::: "memory");
        const int c = lane & 7;
#pragma unroll
        for (int j = 0; j < 4; ++j) { const int n = (lane >> 3) + 8 * j; const LAS float* s = scr + (8 * c) * 33 + n;
            v4u o; o.x = pk2(s[0 * 33], s[1 * 33]); o.y = pk2(s[2 * 33], s[3 * 33]); o.z = pk2(s[4 * 33], s[5 * 33]); o.w = pk2(s[6 * 33], s[7 * 33]);
            if (NTST) __builtin_nontemporal_store(o, (v4u*)(dst[0] + (size_t)n * K[0] + 8 * c)); else *(v4u*)(dst[0] + (size_t)n * K[0] + 8 * c) = o; }
        LDS_WAIT(); asm volatile("" ::: "memory");
        it += stride; if (it >= total) break;
#pragma unroll
        for (int d = 0; d < DEPTH - 1; ++d) {
#pragma unroll
            for (int i = 0; i < 8; ++i) v[d][i] = v[d + 1][i];
            dst[d] = dst[d + 1]; K[d] = K[d + 1]; }
    }
}
struct DecP0 { const float* w_in; bf16* WinT; const float* gmix;
    __device__ __forceinline__ float rowscale(int it, int kk) const { return gmix[64 * (it / (INC / 32)) + kk]; }
    __device__ __forceinline__ void operator()(int it, const float*& src, int& N, bf16*& dst, int& K) const {
        const int kb = it / (INC / 32), nb = it % (INC / 32); src = w_in + (size_t)(64 * kb) * INC + 32 * nb; N = INC; K = DM; dst = WinT + (size_t)(32 * win_dst_group(nb)) * DM + 64 * kb;
    } };
struct DecUp { const float *w_up, *w_out; bf16 *WupT, *WoutT; const float* gm;
    __device__ __forceinline__ float rowscale(int it, int kk) const { constexpr int I_UP = (DM / 64) * (FF / 32); return it < I_UP ? gm[64 * (it / (FF / 32)) + kk] : 1.0f; }
    __device__ __forceinline__ void operator()(int it, const float*& src, int& N, bf16*& dst, int& K) const {
        constexpr int I_UP = (DM / 64) * (FF / 32);
        if (it < I_UP) { const int kb = it / (FF / 32), nb = it % (FF / 32); src = w_up + (size_t)(64 * kb) * FF + 32 * nb; N = FF; K = DM; dst = WupT + (size_t)(32 * nb) * DM + 64 * kb; }
        else { const int r = it - I_UP, kb = r / (DM / 32), nb = r % (DM / 32); src = w_out + (size_t)(64 * kb) * DM + 32 * nb; N = DM; K = DM; dst = WoutT + (size_t)(32 * nb) * DM + 64 * kb; }
    } };
struct DecDn { const float* w_down; bf16* WdnT;
    __device__ __forceinline__ float rowscale(int, int) const { return 1.0f; }
    __device__ __forceinline__ void operator()(int it, const float*& src, int& N, bf16*& dst, int& K) const {
        const int kb = it / (DM / 32), nb = it % (DM / 32); src = w_down + (size_t)(64 * kb) * DM + 32 * nb; N = DM; K = FF; dst = WdnT + (size_t)(32 * nb) * FF + 64 * kb;
    } };
__device__ __forceinline__ void row_to_bf16(const float* xrow, bf16* orow, float* ssq, int lane) {
    const f32x4* xr = (const f32x4*)xrow + lane;
    f32x4 v[8]; float s = 0.f;
#pragma unroll
    for (int j = 0; j < 8; ++j) { v[j] = __builtin_nontemporal_load(xr + 64 * j); s += dot4(v[j], v[j]); }
    v2u* o8 = (v2u*)orow + lane;
#pragma unroll
    for (int j = 0; j < 8; ++j) { v2u w; w.x = pk2(v[j][0], v[j][1]); w.y = pk2(v[j][2], v[j][3]); o8[64 * j] = w; }
    s = wave_sum(s);
    if (lane == 0) *ssq = s;
}

constexpr int KS_STRIDE = 72, VT_STRIDE = 276, KS_BYTES = 272 * KS_STRIDE * 2, VT_BYTES = 64 * VT_STRIDE * 2;
__device__ __forceinline__ void attn_unit(LAS unsigned char* lds, int b, int nb, int kh, const bf16* Q, const bf16* Kb, const bf16* Vb, bf16* MIX, const float* sinks,
                                          int tid, int wave, int lane) {
    LAS bf16* Ks = (LAS bf16*)lds; LAS bf16* Vt = (LAS bf16*)(lds + KS_BYTES);
    const int fr = lane & 15, fq = lane >> 4;
#pragma unroll
    for (int p = 0; p < 4; ++p) {
        const int idx = p * 512 + tid, key = idx >> 3, c = idx & 7, s = 128 * (nb - 1) + key;
        v4u kv = {0u, 0u, 0u, 0u}, vv = {0u, 0u, 0u, 0u};
        if (s >= 0) { const size_t off = (size_t)(b * SEQ + s) * 256 + 64 * kh + 8 * c; kv = *(const v4u*)(Kb + off); vv = *(const v4u*)(Vb + off); }
        *(LAS v4u*)(Ks + key * KS_STRIDE + 8 * c) = kv;
        LAS bf16* vp = Vt + (8 * c) * VT_STRIDE + key;
        vp[0 * VT_STRIDE] = (bf16)(vv.x & 0xffffu); vp[1 * VT_STRIDE] = (bf16)(vv.x >> 16); vp[2 * VT_STRIDE] = (bf16)(vv.y & 0xffffu); vp[3 * VT_STRIDE] = (bf16)(vv.y >> 16);
        vp[4 * VT_STRIDE] = (bf16)(vv.z & 0xffffu); vp[5 * VT_STRIDE] = (bf16)(vv.z >> 16); vp[6 * VT_STRIDE] = (bf16)(vv.w & 0xffffu); vp[7 * VT_STRIDE] = (bf16)(vv.w >> 16);
    }
    if (tid < 144) *(LAS v4u*)(Ks + 256 * KS_STRIDE + tid * 8) = (v4u){0u, 0u, 0u, 0u};
    for (int i = tid; i < 64 * 20; i += 512) Vt[(i / 20) * VT_STRIDE + 256 + (i % 20)] = 0;
    const int g = wave >> 1, h = 4 * kh + g; const float sink = sinks[h];
    bf16x8 qall[4][2];
#pragma unroll
    for (int qi = 0; qi < 4; ++qi) { const size_t r = (size_t)b * SEQ + 128 * nb + 16 * (4 * (wave & 1) + qi) + fr;
        qall[qi][0] = *(const bf16x8*)(Q + r * 1024 + 64 * h + 8 * fq); qall[qi][1] = *(const bf16x8*)(Q + r * 1024 + 64 * h + 32 + 8 * fq); }
    __syncthreads();
#pragma unroll
    for (int qi = 0; qi < 4; ++qi) {
        const int qt = 4 * (wave & 1) + qi, i0 = 16 * qt;
        const size_t r = (size_t)b * SEQ + 128 * nb + i0 + fr;
        bf16x8 qf[2];
        qf[0] = qall[qi][0]; qf[1] = qall[qi][1];
        f32x4 S[10];
#pragma unroll
        for (int t = 0; t < 10; ++t) {
            S[t] = (f32x4){0.f, 0.f, 0.f, 0.f};
#pragma unroll
            for (int ks = 0; ks < 2; ++ks) {
                const bf16x8 kf = *(const LAS bf16x8*)(Ks + (16 * (qt + t) + fr) * KS_STRIDE + 32 * ks + 8 * fq);
                S[t] = __builtin_amdgcn_mfma_f32_16x16x32_bf16(kf, qf[ks], S[t], 0, 0, 0);
            }
        }
        float mx = sink;
#pragma unroll
        for (int t = 0; t < 10; ++t)
#pragma unroll
            for (int j = 0; j < 4; ++j) {
                const int rel = 16 * t + 4 * fq + j - fr;
                const bool ok = rel >= 1 && rel <= 128 && (nb > 0 || (i0 + 16 * t + 4 * fq + j) >= 128);
                S[t][j] = ok ? S[t][j] : -1e30f; mx = fmaxf(mx, S[t][j]);
            }
        mx = fmaxf(mx, __shfl_xor(mx, 16)); mx = fmaxf(mx, __shfl_xor(mx, 32));
        float sum = 0.f;
#pragma unroll
        for (int t = 0; t < 10; ++t)
#pragma unroll
            for (int j = 0; j < 4; ++j) { S[t][j] = __expf(S[t][j] - mx); sum += S[t][j]; }
        sum += __shfl_xor(sum, 16); sum += __shfl_xor(sum, 32); sum += __expf(sink - mx);
        const float inv = 1.0f / sum;
        f32x4 O[4];
#pragma unroll
        for (int dt = 0; dt < 4; ++dt) O[dt] = (f32x4){0.f, 0.f, 0.f, 0.f};
#pragma unroll
        for (int k2 = 0; k2 < 5; ++k2) {
            v4u pw; pw.x = pk2(S[2 * k2][0], S[2 * k2][1]); pw.y = pk2(S[2 * k2][2], S[2 * k2][3]); pw.z = pk2(S[2 * k2 + 1][0], S[2 * k2 + 1][1]); pw.w = pk2(S[2 * k2 + 1][2], S[2 * k2 + 1][3]);
            const bf16x8 pf = __builtin_bit_cast(bf16x8, pw);
#pragma unroll
            for (int dt = 0; dt < 4; ++dt) {
                const LAS bf16* vp = Vt + (16 * dt + fr) * VT_STRIDE + 16 * (qt + 2 * k2) + 4 * fq;
                const v2u lo = *(const LAS v2u*)vp, hi = *(const LAS v2u*)(vp + 16);
                v4u vw; vw.x = lo.x; vw.y = lo.y; vw.z = hi.x; vw.w = hi.y;
                O[dt] = __builtin_amdgcn_mfma_f32_16x16x32_bf16(__builtin_bit_cast(bf16x8, vw), pf, O[dt], 0, 0, 0);
            }
        }
#pragma unroll
        for (int dt = 0; dt < 4; ++dt) {
            v2u w; w.x = pk2(O[dt][0] * inv, O[dt][1] * inv); w.y = pk2(O[dt][2] * inv, O[dt][3] * inv);
            *(v2u*)(MIX + r * DM + 64 * h + 16 * dt + 4 * fq) = w;
        }
    }
    __syncthreads();
}

constexpr int PF_LDS_OFF = 132096;
__device__ __forceinline__ void glds16_pf(const void* gsrc, unsigned lds_dst) { unsigned keep;
    asm volatile("s_mov_b32 %0, m0\n\ts_mov_b32 m0, %2\n\ts_nop 0\n\tglobal_load_lds_dwordx4 %1, off\n\ts_mov_b32 m0, %0" : "=&s"(keep) : "v"(gsrc), "s"(lds_dst) : "memory"); }
__device__ __forceinline__ void conv_unit(LAS unsigned char* lds, int b, int tb, const bf16* U, bf16* MIX, const float* cw, const float* cb, const float* lg, const float* lb,
                                          const float* xpre, int tid, int wave, int lane) {
    LAS unsigned* tile = (LAS unsigned*)lds;
    LAS float* red = (LAS float*)(lds + 62 * 2048);
    LAS float* fin = red + 512;
    const int s0 = 32 * tb;
    {   const int row0 = tid >> 7, c16 = tid & 127;
        const bf16* up = U + ((size_t)b * SEQ + s0 - 30 + row0) * 1024 + 8 * c16;
#pragma unroll
        for (int h8 = 0; h8 < 2; ++h8) {
            v4u tv[8];
#pragma unroll
            for (int t = 0; t < 8; ++t) { const int row = row0 + 4 * (8 * h8 + t);
                tv[t] = (v4u){0u, 0u, 0u, 0u};
                if (row < 62 && s0 - 30 + row >= 0) tv[t] = *(const v4u*)(up + (size_t)(4 * (8 * h8 + t)) * 1024); }
#pragma unroll
            for (int t = 0; t < 8; ++t) { const int row = row0 + 4 * (8 * h8 + t);
                if (row < 62) *(LAS v4u*)(tile + row * 512 + 4 * c16) = tv[t]; }
            asm volatile("" ::: "memory");
        }
    }
    __syncthreads();
    f32x2 w[31];
#pragma unroll
    for (int j = 0; j < 31; ++j) w[j] = *(const f32x2*)(cw + j * 1024 + 2 * tid);
    const f32x2 bias = *(const f32x2*)(cb + 2 * tid);
    const f32x2 g = *(const f32x2*)(lg + 2 * tid), be = *(const f32x2*)(lb + 2 * tid);
#pragma unroll 1
    for (int ck = 0; ck < 4; ++ck) {
        f32x2 c[8];
#pragma unroll
        for (int o = 0; o < 8; ++o) c[o] = bias;
#pragma unroll
        for (int rr = 0; rr < 38; ++rr) {
            const unsigned pv = tile[(8 * ck + rr) * 512 + tid];
            const f32x2 v = {bf2f(pv & 0xffffu), bf2f(pv >> 16)};
#pragma unroll
            for (int o = 0; o < 8; ++o) { const int j = rr - o; if (j >= 0 && j <= 30) c[o] = c[o] + w[j] * v; }
            if ((rr & 7) == 7) asm volatile("" ::: "memory");
        }
#pragma unroll
        for (int o = 0; o < 8; ++o) {
            const f32x2 x = c[o];
            const float s1 = wave_sum(x[0] + x[1]), s2 = wave_sum(x[0] * x[0] + x[1] * x[1]);
            if (lane == 0) { red[(wave * 8 + o) * 2] = s1; red[(wave * 8 + o) * 2 + 1] = s2; }
        }
        asm volatile("s_waitcnt lgkmcnt(0)\n\ts_barrier" ::: "memory");
        if (tid < 16) { float s = 0.f;
#pragma unroll
            for (int wv = 0; wv < 8; ++wv) s += red[wv * 16 + tid];
            fin[tid] = s; }
        asm volatile("s_waitcnt lgkmcnt(0)\n\ts_barrier" ::: "memory");
#pragma unroll
        for (int t = 0; t < 8; ++t) {
            const float mean = fin[2 * t] * (1.0f / CCH), var = fin[2 * t + 1] * (1.0f / CCH) - mean * mean, rstd = rsqrtf(fmaxf(var, 0.f) + EPS);
            const f32x2 y = (c[t] - mean) * rstd * g + be;
            const float o0 = y[0] * sigmoidf_(y[0]), o1 = y[1] * sigmoidf_(y[1]);
            *(unsigned*)(MIX + (size_t)(b * SEQ + s0 + 8 * ck + t) * DM + 1024 + 2 * tid) = pk2(o0, o1);
        }
        if (ck == 0 && xpre) {
            const float* xr = xpre + (size_t)(wave * 32) * DM + lane * 4;
#pragma unroll 8
            for (int i = 0; i < 32; ++i) glds16_pf(xr + (size_t)i * DM, (unsigned)(PF_LDS_OFF + wave * 1024));
        }
    }
    asm volatile("s_waitcnt lgkmcnt(0)\n\ts_barrier" ::: "memory");
}

__device__ __forceinline__ void sample_att(LAS unsigned char* lds, int b, const float* ZS, const float* cache_k, const float* cache_v, const float* state,
                                             const float* gq, const float* gk, const float* sinks, const float* cw, const float* cb, const float* lg, const float* lb,
                                             const float* cosT, const float* sinT, float* out, bf16* MIX, int tid, int wave, int lane) {
    LAS float* zs = (LAS float*)lds;
    LAS float* qs = zs + 3584;
    LAS float* kn = qs + 1024;
    LAS float* vn = kn + 256;
    LAS float* sc = vn + 256;
    LAS float* rd = sc + 2048;
    LAS float* part = rd + 16;
    for (int i = tid; i < INC; i += 512) zs[i] = ZS[b * INC + i];
    __syncthreads();
    for (int hh = wave; hh < 20; hh += 8) {
        const int base = hh < 16 ? 64 * hh : 1024 + 64 * (hh - 16);
        const float x = zs[base + lane];
        const float rstd = rsqrtf(wave_sum(x * x) * (1.0f / 64.0f) + EPS);
        const float y = x * rstd * (hh < 16 ? gq : gk)[lane];
        const float p = __shfl_xor(y, 32);
        const float co = cosT[2048 * 32 + (lane & 31)], si = sinT[2048 * 32 + (lane & 31)];
        const float o = lane < 32 ? y * co - p * si : y * co + p * si;
        if (hh < 16) qs[hh * 64 + lane] = o * 0.125f;
        else { kn[(hh - 16) * 64 + lane] = o; out[O_KS + ((size_t)(b * 128 + 127) * 4 + (hh - 16)) * 64 + lane] = o; }
    }
    if (tid < 256) { const float vv = zs[1280 + tid]; vn[tid] = vv; out[O_VS + (size_t)(b * 128 + 127) * 256 + tid] = vv; }
    __syncthreads();
    {
        const int jj = tid >> 2, kh = tid & 3, j = jj + 1;
        float d0 = 0.f, d1 = 0.f, d2 = 0.f, d3 = 0.f;
        const LAS float* q0 = qs + (4 * kh) * 64;
        if (j < 128) {
            const f32x4* kr = (const f32x4*)(cache_k + ((size_t)(b * 128 + j) * 4 + kh) * 64);
#pragma unroll
            for (int d4 = 0; d4 < 16; ++d4) { const f32x4 kv = kr[d4];
                d0 += dot4(kv, *(const LAS f32x4*)(q0 + 4 * d4)); d1 += dot4(kv, *(const LAS f32x4*)(q0 + 64 + 4 * d4));
                d2 += dot4(kv, *(const LAS f32x4*)(q0 + 128 + 4 * d4)); d3 += dot4(kv, *(const LAS f32x4*)(q0 + 192 + 4 * d4)); }
        } else {
#pragma unroll 4
            for (int d4 = 0; d4 < 16; ++d4) { const f32x4 kv = *(const LAS f32x4*)(kn + kh * 64 + 4 * d4);
                d0 += dot4(kv, *(const LAS f32x4*)(q0 + 4 * d4)); d1 += dot4(kv, *(const LAS f32x4*)(q0 + 64 + 4 * d4));
                d2 += dot4(kv, *(const LAS f32x4*)(q0 + 128 + 4 * d4)); d3 += dot4(kv, *(const LAS f32x4*)(q0 + 192 + 4 * d4)); }
        }
        sc[(4 * kh + 0) * 128 + jj] = d0; sc[(4 * kh + 1) * 128 + jj] = d1; sc[(4 * kh + 2) * 128 + jj] = d2; sc[(4 * kh + 3) * 128 + jj] = d3;
    }
    __syncthreads();
    for (int h = 2 * wave; h < 2 * wave + 2; ++h) {
        const float a = sc[h * 128 + lane], c2 = sc[h * 128 + 64 + lane], sink = sinks[h];
        const float m = fmaxf(wave_max(fmaxf(a, c2)), sink);
        const float pa = __expf(a - m), pb = __expf(c2 - m);
        const float den = wave_sum(pa + pb) + __expf(sink - m), inv = 1.0f / den;
        sc[h * 128 + lane] = pa * inv; sc[h * 128 + 64 + lane] = pb * inv;
    }
    __syncthreads();
    {
        const int d = tid & 63, kg = wave;
#pragma unroll 1
        for (int kh = 0; kh < 4; ++kh) {
            float vv[16];
#pragma unroll
            for (int t = 0; t < 16; ++t) { const int jj = 16 * kg + t;
                vv[t] = (jj < 127) ? cache_v[((size_t)(b * 128 + jj + 1) * 4 + kh) * 64 + d] : vn[kh * 64 + d]; }
            float a0 = 0.f, a1 = 0.f, a2 = 0.f, a3 = 0.f;
            const LAS float* sp = sc + (4 * kh) * 128 + 16 * kg;
#pragma unroll
            for (int t = 0; t < 16; ++t) { a0 += sp[t] * vv[t]; a1 += sp[128 + t] * vv[t]; a2 += sp[256 + t] * vv[t]; a3 += sp[384 + t] * vv[t]; }
            LAS float* pp = part + (kg * 16 + 4 * kh) * 64 + d;
            pp[0] = a0; pp[64] = a1; pp[128] = a2; pp[192] = a3;
        }
        __syncthreads();
#pragma unroll
        for (int hi = 0; hi < 2; ++hi) {
            const int h = (tid >> 6) + 8 * hi; float o = 0.f;
#pragma unroll
            for (int k8 = 0; k8 < 8; ++k8) o += part[(k8 * 16 + h) * 64 + d];
            MIX[(size_t)(MP + b) * DM + 64 * h + d] = (bf16)f2bf(o);
        }
    }
    __syncthreads();
}
__device__ __forceinline__ void sample_conv(LAS unsigned char* lds, int b, const float* ZS, const float* cache_k, const float* cache_v, const float* state,
                                             const float* gq, const float* gk, const float* sinks, const float* cw, const float* cb, const float* lg, const float* lb,
                                             const float* cosT, const float* sinT, float* out, bf16* MIX, int tid, int wave, int lane) {
    LAS float* zs = (LAS float*)lds;
    LAS float* qs = zs + 3584;
    LAS float* kn = qs + 1024;
    LAS float* vn = kn + 256;
    LAS float* sc = vn + 256;
    LAS float* rd = sc + 2048;
    LAS float* part = rd + 16;
    for (int i = 1536 + tid; i < INC; i += 512) zs[i] = ZS[b * INC + i];
    __syncthreads();
    {
        const int ch = 2 * tid;
        const float u0 = zs[1536 + ch] * sigmoidf_(zs[2560 + ch]), u1 = zs[1536 + ch + 1] * sigmoidf_(zs[2560 + ch + 1]);
        *(f32x2*)(out + O_CS + (size_t)(b * 30 + 29) * 1024 + ch) = (f32x2){u0, u1};
        f32x2 c = *(const f32x2*)(cb + ch);
#pragma unroll 10
        for (int j = 0; j < 30; ++j) c = c + *(const f32x2*)(cw + j * 1024 + ch) * *(const f32x2*)(state + (size_t)(b * 30 + j) * 1024 + ch);
        c = c + *(const f32x2*)(cw + 30 * 1024 + ch) * (f32x2){u0, u1};
        const float s1 = wave_sum(c[0] + c[1]), s2 = wave_sum(c[0] * c[0] + c[1] * c[1]);
        if (lane == 0) { rd[wave * 2] = s1; rd[wave * 2 + 1] = s2; }
        __syncthreads();
        float t1 = 0.f, t2 = 0.f;
#pragma unroll
        for (int wv = 0; wv < 8; ++wv) { t1 += rd[wv * 2]; t2 += rd[wv * 2 + 1]; }
        const float mean = t1 * (1.0f / CCH), var = t2 * (1.0f / CCH) - mean * mean, rstd = rsqrtf(fmaxf(var, 0.f) + EPS);
        const f32x2 y = (c - mean) * rstd * *(const f32x2*)(lg + ch) + *(const f32x2*)(lb + ch);
        *(unsigned*)(MIX + (size_t)(MP + b) * DM + 1024 + ch) = pk2(y[0] * sigmoidf_(y[0]), y[1] * sigmoidf_(y[1]));
    }
    __syncthreads();
}

#ifndef MK_DUP
#define MK_DUP (-1)
#endif
#define REPS(k)
#ifndef MK_CG_SEAMS
#define MK_CG_SEAMS 0
#endif
#define P2_CVT() do { const DecDn D{w_down, WdnT}; cvt_items<3, DecDn, true>((LAS float*)(lds + wave * 16384), bx * NWAVES + wave, (FF / 64) * (DM / 32), ncv * NWAVES, lane, D); \
                const int gt = bx * (NWAVES * 64) + tid, NT = ncv * NWAVES * 64;        \
                for (int i = gt; i < 32 * 8128; i += NT) { const int b = i / 8128, o = i % 8128; \
                    __builtin_nontemporal_store(((const f32x4*)(cache_k + (size_t)b * 32768 + 256))[o], (f32x4*)(out + O_KS + (size_t)b * 32768) + o); \
                    __builtin_nontemporal_store(((const f32x4*)(cache_v + (size_t)b * 32768 + 256))[o], (f32x4*)(out + O_VS + (size_t)b * 32768) + o); } \
                for (int i = gt; i < 32 * 7424; i += NT) { const int b = i / 7424, o = i % 7424; \
                    __builtin_nontemporal_store(((const f32x4*)(state + (size_t)b * 30720 + 1024))[o], (f32x4*)(out + O_CS + (size_t)b * 30720) + o); } } while (0)
struct Args { const float* in[18]; float* out; unsigned char* ws; int ph_lo, ph_hi, dry, pad; };
__global__ void __launch_bounds__(NWAVES * 64, 2) mk_fwd(Args args) {
    extern __shared__ __attribute__((aligned(16))) unsigned char lds_raw[];
    LAS unsigned char* lds = (LAS unsigned char*)lds_raw;
    const int wave_k = __builtin_amdgcn_readfirstlane((int)threadIdx.x >> 6);
    const int tid = wave_k * 64 + mk_fresh_lane();
    const int G = gridDim.x, bx = blockIdx.x;
    const int vcu = (G % 8 == 0) ? (bx % 8) * (G / 8) + bx / 8 : bx;
    unsigned char* ws = args.ws;
    const float *xp = args.in[0], *xs = args.in[1], *cache_k = args.in[2], *cache_v = args.in[3], *state = args.in[4], *g_mix = args.in[5], *w_in = args.in[6],
                *gq = args.in[7], *gk = args.in[8], *sinks = args.in[9], *conv_w = args.in[10], *conv_b = args.in[11], *ln_g = args.in[12], *ln_b = args.in[13],
                *w_out = args.in[14], *g_mlp = args.in[15], *w_up = args.in[16], *w_down = args.in[17];
    float* out = args.out;
    float* SSQ = (float*)(ws + WS_SSQ); float* SSQ0 = (float*)(ws + WS_SSQ0); float* cosT = (float*)(ws + WS_COS); float* sinT = (float*)(ws + WS_SIN); float* ZS = (float*)(ws + WS_ZS);
    bf16 *WinT = (bf16*)(ws + WS_WIN), *WoutT = (bf16*)(ws + WS_WOUT), *WupT = (bf16*)(ws + WS_WUP), *WdnT = (bf16*)(ws + WS_WDN);
    bf16 *X1G = (bf16*)(ws + WS_X1G), *HID = (bf16*)(ws + WS_HID), *XN = (bf16*)(ws + WS_XN), *Qb = (bf16*)(ws + WS_Q), *Kb = (bf16*)(ws + WS_K), *Vb = (bf16*)(ws + WS_V),
         *Ub = (bf16*)(ws + WS_U), *MIX = (bf16*)(ws + WS_MIX);
    for (int u = tid; u < (LDS_BYTES - LDSCTL_OFF) / 4; u += NWAVES * 64) ((LAS unsigned*)(lds + LDSCTL_OFF))[u] = 0u;
    __syncthreads();
    volatile LAS unsigned* MISC = (volatile LAS unsigned*)(lds + MISC_OFF);
    XcdBarrier bar; bar.bar = (unsigned*)(ws + WS_CTL) + CW_BAR; bar.x = 0; bar.st = nullptr;
    if (MK_N_LAUNCHES == 1) bar = xcd_barrier_post((unsigned*)(ws + WS_CTL) + CW_BAR, MISC + 8);
#define GRID_BAR(seam) do { if (MK_N_LAUNCHES == 1) { if ((MK_CG_SEAMS >> (seam)) & 1) cg::this_grid().sync(); else xcd_barrier(bar); } STAMP((seam) + 1); } while (0)
#define FRESH_IDS() const int wave = wave_k; int tid = wave * 64 + mk_fresh_lane(); asm volatile("" : "+v"(tid)); const int lane = tid & 63; (void)lane
#ifdef MK_TA
    unsigned long long* TS = (unsigned long long*)(ws + WS_SSQ + 128 * 1024);
#define STAMP(k) do { if (bx == G - 1 && tid == 0) TS[k] = __builtin_amdgcn_s_memrealtime(); } while (0)
#else
#define STAMP(k) do { } while (0)
#endif
    STAMP(0);
    const int lo = args.ph_lo, hi = args.ph_hi;
#ifndef MK_PLAIN
    if (args.pad == 0x5eed) cg::this_grid().sync();
#endif
#define IN(k) (lo <= (k) && (k) < hi)

    if (IN(0)) { REPS(0) {
        FRESH_IDS();
        LAS float* scr = (LAS float*)(lds + wave * 16384);
        const int gw = vcu * NWAVES + wave, NGW = G * NWAVES;
        { const DecP0 D{w_in, WinT, g_mix}; cvt_items<3>(scr, gw, (DM / 64) * (INC / 32), NGW, lane, D); }
        for (int m = gw; m < MT; m += NGW) row_to_bf16(m < MP ? xp + (size_t)m * DM : xs + (size_t)(m - MP) * DM, XN + (size_t)m * DM, SSQ0 + m, lane);
        const int gt = vcu * (NWAVES * 64) + tid, NT = G * NWAVES * 64;
        for (int i = gt; i < 2049 * 32; i += NT) {
            const int pos = i >> 5, k = i & 31; double inv = 1.0;
            for (int j = 0; j < k; ++j) inv *= 0.7498942093324559;
            const float ang = (pos == 2048 ? 16384.0f : (float)pos) * (float)inv;
            double rev = (double)ang * 0.15915494309189535; rev -= __builtin_rint(rev);
            const float rf = (float)rev;
            cosT[i] = __builtin_amdgcn_cosf(rf); sinT[i] = __builtin_amdgcn_sinf(rf);
        }
        }
        if (IN(1)) GRID_BAR(0);
    }
    if (IN(1)) { REPS(1) {
        const int nun = (MP / 256) * (INC / 256), rounds = (nun + G - 1) / G, GG = (nun + rounds - 1) / rounds, nsv = G - GG;
        if (bx < GG) {
            pg8::Gemm g{XN, WinT, MP, INC, DM}; pg8::StaticOrder S; S.init(MP, INC, GG, bx);
            Epi1 E{Qb, Kb, Vb, Ub, out, gq, gk, cosT, sinT, SSQ0};
            pg8::gemm_phase<Epi1, pg8::StaticOrder, true, true>(lds, g, S, E, wave_k);
        }
        FRESH_IDS();
        STAMP(9);
        EpiS1 ES{ZS, SSQ0};
        skinny_phase(lds, XN + (size_t)MP * DM, WinT, INC, DM, bx, G, ES, wave_k);
        {   const DecUp D{w_up, w_out, WupT, WoutT, g_mlp}; constexpr int NIT = (DM / 64) * (FF / 32) + (DM / 64) * (DM / 32);
            if (nsv > 0) { if (bx >= GG) cvt_items<5>((LAS float*)(lds + wave * 16384), (bx - GG) * NWAVES + wave, NIT, nsv * NWAVES, lane, D); }
            else cvt_items<5>((LAS float*)(lds + wave * 16384), bx * NWAVES + wave, NIT, G * NWAVES, lane, D);
        }
        }
        STAMP(12);
        if (IN(2)) GRID_BAR(1);
    }
    if (IN(2)) { REPS(2) {
        FRESH_IDS();
        const int ncv = G > 2 * MS ? G - 2 * MS : G;
        const bool cvt_first = bx < ncv && ((bx >> 3) & 1);
        if (cvt_first) { P2_CVT(); __syncthreads(); }
        for (int a = vcu; a < 256; a += G) attn_unit(lds, a >> 6, (a >> 2) & 15, a & 3, Qb, Kb, Vb, MIX, sinks, tid, wave, lane);
        STAMP(6);
        for (int c = vcu; c < 256; c += G) conv_unit(lds, c >> 6, c & 63, Ub, MIX, conv_w, conv_b, ln_g, ln_b, nullptr, tid, wave, lane);
        STAMP(7);
        if (bx < ncv && !cvt_first) { P2_CVT(); __syncthreads(); }
        for (int j = G - 1 - bx; j < 2 * MS; j += G) {
            if (j < MS) sample_att(lds, j, ZS, cache_k, cache_v, state, gq, gk, sinks, conv_w, conv_b, ln_g, ln_b, cosT, sinT, out, MIX, tid, wave, lane);
            else sample_conv(lds, j - MS, ZS, cache_k, cache_v, state, gq, gk, sinks, conv_w, conv_b, ln_g, ln_b, cosT, sinT, out, MIX, tid, wave, lane);
        }
        }
        STAMP(11);
        if (IN(3)) GRID_BAR(2);
    }
    if (IN(3)) {
        pg8::Gemm g{MIX, WoutT, MP, DM, DM}; pg8::StaticOrder S; S.init(MP, DM, G, bx);
        Epi3 E{XN, out + O_YP, X1G, g_mlp, args.dry ? SSQ + 16384 : SSQ};
        pg8::gemm_phase<Epi3, pg8::StaticOrder, true, true>(lds, g, S, E, wave_k);
        STAMP(13);
        EpiS3 ES{xs, out + O_YP, X1G, g_mlp, args.dry ? SSQ + 16384 : SSQ};
        skinny_phase(lds, MIX + (size_t)MP * DM, WoutT, DM, DM, G - 1 - bx, G, ES, wave_k);
        if (IN(4)) GRID_BAR(3);
    }
    if (IN(4)) { REPS(4) {
        pg8::Gemm g{X1G, WupT, MP, FF, DM}; pg8::StaticOrder S; S.init(MP, FF, G, bx);
        Epi4 E{SSQ, HID};
        EpiS4 ES{SSQ, HID};
        if (bx & 1) skinny_phase(lds, X1G + (size_t)MP * DM, WupT, FF, DM, G - 1 - bx, G, ES, wave_k);
        pg8::gemm_phase<Epi4, pg8::StaticOrder, true, true>(lds, g, S, E, wave_k);
        if (!(bx & 1)) skinny_phase(lds, X1G + (size_t)MP * DM, WupT, FF, DM, G - 1 - bx, G, ES, wave_k);
        }
        if (IN(5)) GRID_BAR(4);
    }
    if (IN(5)) {
        pg8::Gemm g{HID, WdnT, MP, DM, FF}; pg8::StaticOrder S; S.init(MP, DM, G, bx);
        Epi5 E{out + O_YP, X1G};
        pg8::gemm_phase<Epi5, pg8::StaticOrder, true, true>(lds, g, S, E, wave_k);
#ifdef MK_TA
        STAMP(8); __syncthreads();
        EpiS5 ES{out + O_YP, X1G, bx == G - 1 ? 1.0f + 1e-4f * (float)(long long)(__hip_atomic_load(TS + MK_TB, __ATOMIC_RELAXED, __HIP_MEMORY_SCOPE_AGENT) - __hip_atomic_load(TS + MK_TA, __ATOMIC_RELAXED, __HIP_MEMORY_SCOPE_AGENT)) : 1.0f};
#else
        EpiS5 ES{out + O_YP, X1G, 1.0f};
#endif
        skinny_phase(lds, HID + (size_t)MP * FF, WdnT, DM, FF, G - 1 - bx, G, ES, wave_k);
    }
#undef IN
}

extern "C" void kernel_launch(void* const* d_in, const int* in_sizes, int n_in, void* d_out, int out_size, void* d_ws, size_t ws_size, hipStream_t stream) {
    static int grid = 0;
    if (grid == 0) {
        if (n_in != 18 || (size_t)out_size != O_END || ws_size < WS_END) { fprintf(stderr, "kernel_launch: unexpected shapes: n_in %d out %d ws %zu\n", n_in, out_size, ws_size); grid = -1; return; }
        int dev = 0, cus = 0, per_cu = 0;
        if (hipGetDevice(&dev) != hipSuccess || hipDeviceGetAttribute(&cus, hipDeviceAttributeMultiprocessorCount, dev) != hipSuccess) { grid = -1; return; }
        if (hipFuncSetAttribute((const void*)mk_fwd, hipFuncAttributeMaxDynamicSharedMemorySize, LDS_BYTES) != hipSuccess) { fprintf(stderr, "kernel_launch: hipFuncSetAttribute failed\n"); grid = -1; return; }
        if (hipOccupancyMaxActiveBlocksPerMultiprocessor(&per_cu, (const void*)mk_fwd, NWAVES * 64, LDS_BYTES) != hipSuccess || per_cu < 1) { fprintf(stderr, "kernel_launch: occupancy query says %d\n", per_cu); (void)hipGetLastError(); grid = -1; return; }
        grid = cus;
    }
    if (grid < 0) return;
    (void)hipMemsetAsync((char*)d_ws + WS_CTL, 0, CTL_ZERO_BYTES, stream);
    Args a{};
    for (int i = 0; i < 18; ++i) a.in[i] = (const float*)d_in[i];
    a.out = (float*)d_out; a.ws = (unsigned char*)d_ws;
#if MK_N_LAUNCHES == 1 && defined(MK_PLAIN)
    a.ph_lo = 0; a.ph_hi = 6;
    hipLaunchKernelGGL(mk_fwd, dim3(grid), dim3(NWAVES * 64), LDS_BYTES, stream, a);
#elif MK_N_LAUNCHES == 1
    a.ph_lo = 0; a.ph_hi = 6;
    void* params[] = {&a};
    hipError_t e = hipLaunchCooperativeKernel((const void*)mk_fwd, dim3(grid), dim3(NWAVES * 64), params, LDS_BYTES, stream);
    if (e != hipSuccess) fprintf(stderr, "kernel_launch: cooperative launch failed: %s (grid %d)\n", hipGetErrorString(e), grid);
#else
    for (int p = 0; p < 6; ++p) for (int rep = 0; rep < (p == MK_DUP ? 2 : 1); ++rep) { a.ph_lo = p; a.ph_hi = p + 1; a.dry = (p == MK_DUP && rep == 0 && (p == 3 || p == 5)) ? 1 : 0; hipLaunchKernelGGL(mk_fwd, dim3(grid), dim3(NWAVES * 64), LDS_BYTES, stream, a); }
#endif
}
```

```cpp
#include <hip/hip_runtime.h>
#include <hip/hip_cooperative_groups.h>
#include <cstdio>
#include <cstdint>
namespace cg = cooperative_groups;
__device__ __forceinline__ int mk_fresh_lane() { int l; asm volatile("v_mbcnt_lo_u32_b32 %0, -1, 0\n\tv_mbcnt_hi_u32_b32 %0, -1, %0" : "=v"(l)); return l; }
#define MK_PLAIN 1
#define MK_N_LAUNCHES 1
namespace pg8 {
#define PG8_LAS __attribute__((address_space(3)))
typedef unsigned short bf16_t;
typedef short bf16x8 __attribute__((ext_vector_type(8)));
typedef float f32x4 __attribute__((ext_vector_type(4)));
typedef unsigned u32x4 __attribute__((ext_vector_type(4)));
constexpr int BM = 256, BK = 64, HALF = 128, HTB = HALF * BK * 2  , STAGE_BYTES = 8 * HTB, NXCD = 8, WGM = 8;

__host__ __device__ __forceinline__ int lds_byte(int r, int c) { const int st = (r >> 4) * 2 + (c >> 5), rr = r & 15, cc = c & 31, ob = rr * 64 + cc * 2; return st * 1024 + (ob ^ (((ob >> 9) & 1) << 5)); }
__host__ __device__ __forceinline__ void stage_rc(int b, int& R, int& C) { const int st = b / 1024, sb = b % 1024, swz = sb ^ (((sb >> 9) & 1) << 5); R = (st >> 1) * 16 + swz / 64; C = (st & 1) * 32 + (swz % 64) / 2; }
__host__ __device__ __forceinline__ int perm32(int rho) { const int n = rho >> 4, i = rho & 15; return 8 * (i >> 2) + 4 * n + (i & 3); }

struct Unit { int pm, pn; };
struct Gemm { const bf16_t* A; const bf16_t* Bt; int M, N, K; };

struct StaticOrder {
    int nM, nN, nwg, G, c;
    __host__ __device__ void init(int M, int N, int G_, int c_) { nM = M / BM; nN = N / BM; nwg = nM * nN; G = G_; c = c_; }
    __host__ __device__ bool next(int i, Unit& u) const {
        const long L = (long)i * G + c; if (L >= nwg) return false;
        int wgid = (int)L; { const int q = nwg / NXCD, r = nwg % NXCD, xcd = wgid % NXCD, off = wgid / NXCD; wgid = (xcd < r ? xcd * (q + 1) : r * (q + 1) + (xcd - r) * q) + off; }
        const int nig = WGM * nN, gid = wgid / nig, fm = gid * WGM, gsz = (nM - fm) < WGM ? (nM - fm) : WGM;
        u.pm = fm + ((wgid % nig) % gsz); u.pn = (wgid % nig) / gsz; return true;
    }
    __device__ __forceinline__ void a_ready(const Unit&) const {}
    __device__ __forceinline__ void done(const Unit&) const {}
};

__device__ __forceinline__ unsigned cvt_pk_bf16(float lo, float hi) { unsigned r; asm volatile("v_cvt_pk_bf16_f32 %0, %1, %2" : "=v"(r) : "v"(lo), "v"(hi)); return r; }
typedef float f32x2 __attribute__((ext_vector_type(2)));
template <class Epi, class Sched, bool ALIGN_EPI = false, bool SP2 = false>
__device__ __forceinline__ void gemm_phase(PG8_LAS unsigned char* lds, const Gemm g, const Sched& S, const Epi& E, const int wid_in) {
    const int wid = wid_in; int tid = wid * 64 + mk_fresh_lane(); asm volatile("" : "+v"(tid));
    const int lane = tid & 63, wr = wid >> 2, wc = wid & 3, fr = lane & 15, fq = lane >> 4;
    const int K = g.K, nt = K / BK;
    unsigned voffA[2], voffB[2];
#pragma unroll
    for (int i = 0; i < 2; ++i) { int R, C; stage_rc(tid * 16 + i * 8192, R, C); const int Rb = Epi::PERM ? ((R & ~31) + perm32(R & 31)) : R;
        voffA[i] = (unsigned)(R * K + C) * 2u; voffB[i] = (unsigned)(Rb * K + C) * 2u; }
    const size_t kstep = (size_t)(BK * 2);
    const size_t hstep = (size_t)HALF * K * 2;
    const size_t tstep = 2 * hstep;
    const unsigned ldsw = (unsigned)wid * 1024u;
    const int aoff = lds_byte(wr * 64 + fr, fq * 8), boff = lds_byte(wc * 32 + fr, fq * 8);
#define PG8_SA(b, h) (((b) * 2 + (h)) * HTB)
#define PG8_SB(b, h) ((4 + (b) * 2 + (h)) * HTB)
#define PG8_STAGE(bufoff, gbase, voff) do { _Pragma("unroll") for (int _i = 0; _i < 2; ++_i) \
        __builtin_amdgcn_global_load_lds((const unsigned*)((const char*)(gbase) + (voff)[_i]), (PG8_LAS unsigned*)(lds + (bufoff) + ldsw + _i * 8192), 16, 0, 0); } while (0)
#define PG8_LDA(dst, b, h) do { _Pragma("unroll") for (int m = 0; m < 4; ++m) _Pragma("unroll") for (int k = 0; k < 2; ++k) dst[m][k] = *(const PG8_LAS bf16x8*)(lds + PG8_SA(b, h) + aoff + m * 2048 + k * 1024); } while (0)
#define PG8_LDB(dst, b, h) do { _Pragma("unroll") for (int n = 0; n < 2; ++n) _Pragma("unroll") for (int k = 0; k < 2; ++k) dst[n][k] = *(const PG8_LAS bf16x8*)(lds + PG8_SB(b, h) + boff + n * 2048 + k * 1024); } while (0)
#define PG8_MMA(ai, bj, At, Bt) do { __builtin_amdgcn_s_setprio(1); _Pragma("unroll") for (int m = 0; m < 4; ++m) _Pragma("unroll") for (int n = 0; n < 2; ++n) _Pragma("unroll") for (int k = 0; k < 2; ++k) \
        acc[ai][bj][m][n] = __builtin_amdgcn_mfma_f32_16x16x32_bf16(Bt[n][k], At[m][k], acc[ai][bj][m][n], 0, 0, 0); __builtin_amdgcn_s_setprio(0); } while (0)
#define PG8_WAIT_V(n) asm volatile("s_waitcnt vmcnt(" #n ")" ::: "memory")
#define PG8_WAIT_L(n) asm volatile("s_waitcnt lgkmcnt(" #n ")" ::: "memory")
#define PG8_BAR __builtin_amdgcn_s_barrier()
#define PG8_SCHED __builtin_amdgcn_sched_barrier(0)
    Unit cur, nxt; int ui = 0;
    if (!S.next(0, cur)) return;
    f32x4 acc[2][2][4][2];
#pragma unroll
    for (int a = 0; a < 2; ++a)
#pragma unroll
        for (int b = 0; b < 2; ++b)
#pragma unroll
            for (int m = 0; m < 4; ++m)
#pragma unroll
                for (int n = 0; n < 2; ++n) acc[a][b][m][n] = (f32x4){0.f, 0.f, 0.f, 0.f};
    bf16x8 At[4][2], B0[2][2], B1[2][2];
    const char* cA = (const char*)g.A + (size_t)cur.pm * tstep; const char* cB = (const char*)g.Bt + (size_t)cur.pn * tstep;
    S.a_ready(cur);
    if constexpr (SP2) {
        PG8_STAGE(PG8_SB(0, 0), cB, voffB); PG8_STAGE(PG8_SB(0, 1), cB + hstep, voffB); PG8_STAGE(PG8_SA(0, 0), cA, voffA); PG8_STAGE(PG8_SA(0, 1), cA + hstep, voffA);
        if (wr == 1) PG8_BAR;
        PG8_WAIT_V(2); PG8_BAR;
        PG8_STAGE(PG8_SB(1, 0), cB + kstep, voffB); PG8_STAGE(PG8_SA(1, 0), cA + kstep, voffA); PG8_STAGE(PG8_SB(1, 1), cB + hstep + kstep, voffB);
        PG8_WAIT_V(6); PG8_BAR;
    } else {
        PG8_STAGE(PG8_SB(0, 0), cB, voffB); PG8_STAGE(PG8_SA(0, 0), cA, voffA); PG8_STAGE(PG8_SB(0, 1), cB + hstep, voffB); PG8_STAGE(PG8_SA(0, 1), cA + hstep, voffA);
        if (wr == 1) PG8_BAR;
        PG8_WAIT_V(4); PG8_BAR;
        PG8_STAGE(PG8_SB(1, 0), cB + kstep, voffB); PG8_STAGE(PG8_SA(1, 0), cA + kstep, voffA); PG8_STAGE(PG8_SB(1, 1), cB + hstep + kstep, voffB);
        PG8_WAIT_V(6); PG8_BAR;
    }
    for (;;) {
        const bool has_next = S.next(ui + 1, nxt);
        const char* nA = has_next ? (const char*)g.A + (size_t)nxt.pm * tstep : cA; const char* nB = has_next ? (const char*)g.Bt + (size_t)nxt.pn * tstep : cB;
        for (int t = 0; t < nt; t += 2) {
            const bool last = (t == nt - 2);
            const char* a1 = cA + (size_t)(t + 1) * kstep;
            const char* a2 = last ? nA : cA + (size_t)(t + 2) * kstep; const char* b2 = last ? nB : cB + (size_t)(t + 2) * kstep;
            const char* a3 = a2 + kstep; const char* b3 = b2 + kstep;
            if (last && has_next) S.a_ready(nxt);
            if constexpr (SP2) {
            PG8_LDB(B0, 0, 0); PG8_LDB(B1, 0, 1); PG8_SCHED; PG8_LDA(At, 0, 0); PG8_STAGE(PG8_SA(1, 1), a1 + hstep, voffA);
            PG8_WAIT_V(8); PG8_WAIT_L(0); PG8_BAR; PG8_MMA(0, 0, At, B0); PG8_MMA(0, 1, At, B1); PG8_BAR; PG8_SCHED;
            PG8_LDA(At, 0, 1); PG8_STAGE(PG8_SB(0, 0), b2, voffB); PG8_STAGE(PG8_SB(0, 1), b2 + hstep, voffB); PG8_STAGE(PG8_SA(0, 0), a2, voffA);
            PG8_WAIT_V(8); PG8_WAIT_L(0); PG8_BAR; PG8_MMA(1, 0, At, B0); PG8_MMA(1, 1, At, B1); PG8_BAR; PG8_SCHED;
            PG8_LDB(B0, 1, 0); PG8_LDB(B1, 1, 1); PG8_SCHED; PG8_LDA(At, 1, 0); PG8_STAGE(PG8_SA(0, 1), a2 + hstep, voffA);
            PG8_WAIT_V(8); PG8_WAIT_L(0); PG8_BAR; PG8_MMA(0, 0, At, B0); PG8_MMA(0, 1, At, B1); PG8_BAR; PG8_SCHED;
            PG8_LDA(At, 1, 1); PG8_STAGE(PG8_SB(1, 0), b3, voffB); PG8_STAGE(PG8_SB(1, 1), b3 + hstep, voffB); PG8_STAGE(PG8_SA(1, 0), a3, voffA);
            PG8_WAIT_V(8); PG8_WAIT_L(0); PG8_BAR; PG8_MMA(1, 0, At, B0); PG8_MMA(1, 1, At, B1); PG8_BAR; PG8_SCHED;
            } else {
            PG8_LDB(B0, 0, 0); PG8_SCHED; PG8_LDA(At, 0, 0); PG8_STAGE(PG8_SA(1, 1), a1 + hstep, voffA);
            PG8_WAIT_L(8); PG8_BAR; PG8_WAIT_L(0); PG8_MMA(0, 0, At, B0); PG8_BAR; PG8_SCHED;
            PG8_LDB(B1, 0, 1); PG8_STAGE(PG8_SB(0, 0), b2, voffB);
            PG8_BAR; PG8_WAIT_L(0); PG8_MMA(0, 1, At, B1); PG8_BAR;
            PG8_LDA(At, 0, 1); PG8_STAGE(PG8_SA(0, 0), a2, voffA);
            PG8_BAR; PG8_WAIT_L(0); PG8_MMA(1, 0, At, B0); PG8_BAR; PG8_SCHED;
            PG8_STAGE(PG8_SB(0, 1), b2 + hstep, voffB);
            PG8_WAIT_V(6); PG8_BAR; PG8_MMA(1, 1, At, B1); PG8_BAR;
            PG8_LDB(B0, 1, 0); PG8_SCHED; PG8_LDA(At, 1, 0); PG8_STAGE(PG8_SA(0, 1), a2 + hstep, voffA);
            PG8_WAIT_L(8); PG8_BAR; PG8_WAIT_L(0); PG8_MMA(0, 0, At, B0); PG8_BAR; PG8_SCHED;
            PG8_LDB(B1, 1, 1); PG8_STAGE(PG8_SB(1, 0), b3, voffB);
            PG8_BAR; PG8_WAIT_L(0); PG8_MMA(0, 1, At, B1); PG8_BAR;
            PG8_LDA(At, 1, 1); PG8_STAGE(PG8_SA(1, 0), a3, voffA);
            PG8_BAR; PG8_WAIT_L(0); PG8_MMA(1, 0, At, B0); PG8_BAR; PG8_SCHED;
            PG8_STAGE(PG8_SB(1, 1), b3 + hstep, voffB);
            PG8_WAIT_V(6); PG8_BAR; PG8_MMA(1, 1, At, B1); PG8_BAR;
            }
        }
        if constexpr (ALIGN_EPI) { if (wr == 0) PG8_BAR; }
        if constexpr (!Epi::AFTER_DRAIN) { E(acc, cur, wr, wc, fr, fq); S.done(cur); }
        if (!has_next) break;
#pragma unroll
        for (int a = 0; a < 2; ++a)
#pragma unroll
            for (int b = 0; b < 2; ++b)
#pragma unroll
                for (int m = 0; m < 4; ++m)
#pragma unroll
                    for (int n = 0; n < 2; ++n) acc[a][b][m][n] = (f32x4){0.f, 0.f, 0.f, 0.f};
        cur = nxt; cA = nA; cB = nB; ++ui;
        if constexpr (ALIGN_EPI) { if (wr == 1) PG8_BAR; }
    }
    PG8_WAIT_V(0);
    if constexpr (!ALIGN_EPI) { if (wr == 0) PG8_BAR; }
    PG8_BAR;
    if constexpr (Epi::AFTER_DRAIN) { E.fused(acc, cur, wr, wc, fr, fq, lds, wid, lane); S.done(cur); }
#undef PG8_SA
#undef PG8_SB
#undef PG8_STAGE
#undef PG8_LDA
#undef PG8_LDB
#undef PG8_MMA
#undef PG8_WAIT_V
#undef PG8_WAIT_L
#undef PG8_BAR
#undef PG8_SCHED
}
}
#define GAS __attribute__((address_space(1)))
#define LAS __attribute__((address_space(3)))
#define XB_TMO      128
#define XB_XCNT(j)  (256  + 64 * (j))
#define XB_XSUB(j)  (1280 + 64 * (j))
#define XB_XGEN(j)  (2304 + 64 * (j))
#define XB_TOP      3328
#define XB_TOPGEN   3392
#define XCD_BAR_WORDS 3456
#define XB_SPIN_CAP (1u << 18)

__device__ __forceinline__ unsigned xb_ld(unsigned* p)              { return __hip_atomic_load(p, __ATOMIC_RELAXED, __HIP_MEMORY_SCOPE_AGENT); }
__device__ __forceinline__ unsigned xb_add(unsigned* p, unsigned v) { return __hip_atomic_fetch_add(p, v, __ATOMIC_RELAXED, __HIP_MEMORY_SCOPE_AGENT); }
__device__ __forceinline__ unsigned xb_xcc_id() { return (unsigned)__builtin_amdgcn_s_getreg((3 << 11) | 20) & 0xFu; }
#define XB_SPIN(cond, bar) do { unsigned _sp = 0; while (cond) { __builtin_amdgcn_s_sleep(1); \
    if ((++_sp & 255u) == 0u) { if (xb_ld(&(bar)[XB_TMO])) break; if (_sp > XB_SPIN_CAP) { atomicAdd(&(bar)[XB_TMO], 1u); break; } } } } while (0)

struct XcdBarrier {
    unsigned* bar; unsigned x;
    volatile LAS unsigned* st;
};

__device__ __forceinline__ XcdBarrier xcd_barrier_post(unsigned* bar, volatile LAS unsigned* st) {
    XcdBarrier b; b.bar = bar; b.x = xb_xcc_id(); b.st = st;
    if (threadIdx.x == 0) (void)xb_add(&bar[XB_XCNT(b.x)], 1u);
    return b;
}
__device__ __forceinline__ void xcd_barrier_complete(unsigned* bar, unsigned x, unsigned& nloc, unsigned& nx) {
    const unsigned G = gridDim.x * gridDim.y * gridDim.z;
    unsigned sum, cnt, mine, sp = 0u;
    for (;;) {
        sum = 0u; cnt = 0u; mine = 0u;
#pragma unroll
        for (unsigned j = 0; j < 16; ++j) { const unsigned c = xb_ld(&bar[XB_XCNT(j)]); sum += c; cnt += (c > 0u) ? 1u : 0u; mine = (j == x) ? c : mine; }
        if (sum == G) break;
        __builtin_amdgcn_s_sleep(1);
        if ((++sp & 255u) == 0u) { if (xb_ld(&bar[XB_TMO])) break; if (sp > XB_SPIN_CAP) { atomicAdd(&bar[XB_TMO], 1u); break; } }
    }
    nloc = mine > 0u ? mine : 1u; nx = cnt > 0u ? cnt : 1u;
}

__device__ __forceinline__ void xcd_barrier(const XcdBarrier& b) {
    asm volatile("s_waitcnt vmcnt(0)" ::: "memory");
    __syncthreads();
    if (threadIdx.x == 0) {
        unsigned* bar = b.bar;
        __builtin_amdgcn_s_waitcnt(0);
        unsigned nloc = b.st[0], nx = b.st[1];
        if (nloc == 0u) { xcd_barrier_complete(bar, b.x, nloc, nx); b.st[0] = nloc; b.st[1] = nx; }
        const unsigned old = xb_add(&bar[XB_XSUB(b.x)], 1u);
        const unsigned gen = old / nloc;
        if (old + 1u == (gen + 1u) * nloc) {
            __builtin_amdgcn_fence(__ATOMIC_RELEASE, "agent");
            asm volatile("s_waitcnt vmcnt(0)" ::: "memory");
            const unsigned og = xb_add(&bar[XB_TOP], 1u);
            const unsigned tg = og / nx;
            if (og + 1u == (tg + 1u) * nx) xb_add(&bar[XB_TOPGEN], 1u);
            else XB_SPIN(xb_ld(&bar[XB_TOPGEN]) == tg, bar);
            __builtin_amdgcn_fence(__ATOMIC_ACQUIRE, "agent");
            xb_add(&bar[XB_XGEN(b.x)], 1u);
            asm volatile("s_waitcnt vmcnt(0)" ::: "memory");
        } else {
            XB_SPIN(xb_ld(&bar[XB_XGEN(b.x)]) == gen, bar);
            __builtin_amdgcn_fence(__ATOMIC_ACQUIRE, "agent");
            asm volatile("s_waitcnt vmcnt(0)" ::: "memory");
        }
    }
    __syncthreads();
}

#ifndef MK_N_LAUNCHES
#define MK_N_LAUNCHES 1
#endif
constexpr int NWAVES = 8;
constexpr int DM = 2048, SEQ = 2048, NBATCH = 4, MP = NBATCH * SEQ, MS = 32, MT = MP + MS;
constexpr int INC = 3584, FF = 8192, NH = 16, NKV = 4, HD = 64, CCH = 1024, CW = 31;
constexpr float EPS = 1e-6f;
constexpr size_t O_YP = 0, O_YS = (size_t)MP * DM, O_KP = O_YS + (size_t)MS * DM, O_VP = O_KP + 131072, O_CP = O_VP + 131072,
                 O_KS = O_CP + 122880, O_VS = O_KS + 1048576, O_CS = O_VS + 1048576, O_END = O_CS + 983040;
constexpr size_t MiB = 1u << 20;
constexpr size_t WS_CTL = 0, CTL_ZERO_BYTES = 68 * 1024;
constexpr size_t WS_SSQ = 32 * 1024, WS_SSQ0 = 96 * 1024;
constexpr size_t WS_COS = 1 * MiB, WS_SIN = 2 * MiB;
constexpr size_t WS_ZS = 3 * MiB;
constexpr size_t WS_WIN = 4 * MiB, WS_WOUT = 18 * MiB, WS_WUP = 26 * MiB, WS_WDN = 58 * MiB;
constexpr size_t WS_X1G = 90 * MiB;
constexpr size_t WS_HID = 123 * MiB;
constexpr size_t WS_XN = 123 * MiB, WS_Q = 156 * MiB, WS_K = 172 * MiB, WS_V = 176 * MiB, WS_U = 180 * MiB, WS_MIX = 196 * MiB;
constexpr size_t WS_END = 256 * MiB;
static_assert(WS_HID + (size_t)MT * FF * 2 <= WS_END && WS_MIX + (size_t)MT * DM * 2 <= WS_END && WS_X1G + (size_t)MT * DM * 2 <= WS_HID, "ws map");
constexpr int CW_BAR = 4096;
constexpr int RING_BYTES = 131072, LDSCTL_OFF = RING_BYTES, MISC_OFF = LDSCTL_OFF + 320, LDS_BYTES = 147456;

typedef unsigned short bf16;
typedef unsigned v4u __attribute__((ext_vector_type(4)));
typedef unsigned v2u __attribute__((ext_vector_type(2)));
typedef float f32x4 __attribute__((ext_vector_type(4)));
typedef float f32x2 __attribute__((ext_vector_type(2)));
typedef short bf16x8 __attribute__((ext_vector_type(8)));
#define LDS_WAIT() asm volatile("s_waitcnt lgkmcnt(0)" ::: "memory")
__device__ __forceinline__ unsigned f2bf(float f) { unsigned u = __builtin_bit_cast(unsigned, f); return (u + 0x7fffu + ((u >> 16) & 1u)) >> 16; }
__device__ __forceinline__ unsigned pk2(float lo, float hi) { return pg8::cvt_pk_bf16(lo, hi); }
__device__ __forceinline__ float bf2f(unsigned h) { return __builtin_bit_cast(float, h << 16); }
template <int CTRL, int ROWMASK> __device__ __forceinline__ float dpp_get(float v) {
    return __builtin_bit_cast(float, __builtin_amdgcn_update_dpp(0, __builtin_bit_cast(int, v), CTRL, ROWMASK, 0xf, false)); }
__device__ __forceinline__ float wave_sum(float v) {
    v += dpp_get<0xB1, 0xf>(v); v += dpp_get<0x4E, 0xf>(v); v += dpp_get<0x124, 0xf>(v); v += dpp_get<0x128, 0xf>(v);
    v += dpp_get<0x142, 0xa>(v); v += dpp_get<0x143, 0xc>(v);
    return __builtin_bit_cast(float, __builtin_amdgcn_readlane(__builtin_bit_cast(int, v), 63));
}
__device__ __forceinline__ float wave_max(float v) {
    v = fmaxf(v, dpp_get<0xB1, 0xf>(v)); v = fmaxf(v, dpp_get<0x4E, 0xf>(v)); v = fmaxf(v, dpp_get<0x124, 0xf>(v)); v = fmaxf(v, dpp_get<0x128, 0xf>(v));
    const int iv = __builtin_bit_cast(int, v);
    const float a = __builtin_bit_cast(float, __builtin_amdgcn_readlane(iv, 0)), b = __builtin_bit_cast(float, __builtin_amdgcn_readlane(iv, 16)),
                c = __builtin_bit_cast(float, __builtin_amdgcn_readlane(iv, 32)), d = __builtin_bit_cast(float, __builtin_amdgcn_readlane(iv, 48));
    return fmaxf(fmaxf(a, b), fmaxf(c, d));
}
__device__ __forceinline__ float dot4(f32x4 a, f32x4 b) { return (a[0] * b[0] + a[1] * b[1]) + (a[2] * b[2] + a[3] * b[3]); }
__device__ __forceinline__ float sigmoidf_(float g) { return 1.0f / (1.0f + __expf(-g)); }

__device__ __forceinline__ int win_dst_group(int sg) {
    if (sg < 48) { const int pn = sg >> 3, wc = (sg & 7) >> 1, bj = sg & 1; return 8 * pn + 4 * bj + wc; }
    if (sg < 80) { const int cc = sg - 48; return 8 * (6 + (cc >> 2)) + (cc & 3); }
    const int cc = sg - 80; return 8 * (6 + (cc >> 2)) + 4 + (cc & 3);
}
__device__ __forceinline__ int win_logical_col(int np) {
    const int dg = np >> 5, e = np & 31, pn = dg >> 3, bj = (dg >> 2) & 1, wc = dg & 3;
    if (dg < 48) return 256 * pn + 64 * wc + 32 * bj + e;
    return (bj ? 2560 : 1536) + 128 * (pn - 6) + 32 * wc + e;
}

using pg8::Unit;
struct Epi1 {
    static constexpr bool PERM = true, AFTER_DRAIN = false;
    bf16 *Q, *K, *V, *U; float* out; const float *gq, *gk, *cosT, *sinT, *SSQ0;
    __device__ __forceinline__ void operator()(const f32x4 (&acc)[2][2][4][2], const Unit& u, int wr, int wc, int fr, int fq) const {
        const int pn = u.pn, rbase = u.pm * 256 + wr * 64 + fr;
        if (pn < 5) {
            const float* g = pn < 4 ? gq : gk; const float qs = pn < 4 ? 0.125f : 1.0f;
            const f32x4 g1a = *(const f32x4*)(g + 8 * fq), g1b = *(const f32x4*)(g + 8 * fq + 4), g2a = *(const f32x4*)(g + 32 + 8 * fq), g2b = *(const f32x4*)(g + 36 + 8 * fq);
#pragma unroll
            for (int ah = 0; ah < 4; ++ah) {
                const int ai = ah >> 1;
                f32x4 rc[4][2], rs[4][2]; float r0[4];
#pragma unroll
                for (int m = 2 * (ah & 1); m < 2 * (ah & 1) + 2; ++m) { const int s = (rbase + ai * 128 + m * 16) & (SEQ - 1);
                    r0[m] = SSQ0[rbase + ai * 128 + m * 16];
                    rc[m][0] = *(const f32x4*)(cosT + s * 32 + 8 * fq); rc[m][1] = *(const f32x4*)(cosT + s * 32 + 8 * fq + 4);
                    rs[m][0] = *(const f32x4*)(sinT + s * 32 + 8 * fq); rs[m][1] = *(const f32x4*)(sinT + s * 32 + 8 * fq + 4); }
                asm volatile("" ::: "memory");
#pragma unroll
                for (int m = 2 * (ah & 1); m < 2 * (ah & 1) + 2; ++m) {
                    const int r = rbase + ai * 128 + m * 16, s = r & (SEQ - 1), b = r >> 11;
                    const float rr = rsqrtf(r0[m] * (1.0f / DM) + EPS);
                    const f32x4 x1a = acc[ai][0][m][0] * rr, x1b = acc[ai][0][m][1] * rr, x2a = acc[ai][1][m][0] * rr, x2b = acc[ai][1][m][1] * rr;
                    float ss = (dot4(x1a, x1a) + dot4(x1b, x1b)) + (dot4(x2a, x2a) + dot4(x2b, x2b));
                    ss += __shfl_xor(ss, 16); ss += __shfl_xor(ss, 32);
                    const float rstd = rsqrtf(ss * (1.0f / 64.0f) + EPS);
                    const f32x4 y1a = x1a * rstd * g1a, y1b = x1b * rstd * g1b, y2a = x2a * rstd * g2a, y2b = x2b * rstd * g2b;
                    const f32x4 ca = rc[m][0], cb = rc[m][1], sa = rs[m][0], sb = rs[m][1];
                    const f32x4 o1a = y1a * ca - y2a * sa, o1b = y1b * cb - y2b * sb, o2a = y2a * ca + y1a * sa, o2b = y2b * cb + y1b * sb;
                    v4u w1, w2;
                    w1.x = pk2(o1a[0] * qs, o1a[1] * qs); w1.y = pk2(o1a[2] * qs, o1a[3] * qs); w1.z = pk2(o1b[0] * qs, o1b[1] * qs); w1.w = pk2(o1b[2] * qs, o1b[3] * qs);
                    w2.x = pk2(o2a[0] * qs, o2a[1] * qs); w2.y = pk2(o2a[2] * qs, o2a[3] * qs); w2.z = pk2(o2b[0] * qs, o2b[1] * qs); w2.w = pk2(o2b[2] * qs, o2b[3] * qs);
                    if (pn < 4) {
                        bf16* p = Q + (size_t)r * 1024 + 64 * (4 * pn + wc) + 8 * fq;
                        *(v4u*)p = w1; *(v4u*)(p + 32) = w2;
                    } else {
                        bf16* p = K + (size_t)r * 256 + 64 * wc + 8 * fq;
                        *(v4u*)p = w1; *(v4u*)(p + 32) = w2;
                        if (s >= SEQ - 128) {
                            float* o = out + O_KP + ((size_t)(b * 128 + s - (SEQ - 128)) * 4 + wc) * 64 + 8 * fq;
                            *(f32x4*)o = o1a; *(f32x4*)(o + 4) = o1b; *(f32x4*)(o + 32) = o2a; *(f32x4*)(o + 36) = o2b;
                        }
                    }
                }
                asm volatile("" ::: "memory");
            }
        } else if (pn == 5) {
#pragma unroll
            for (int ai = 0; ai < 2; ++ai) {
                float r0[4];
#pragma unroll
                for (int m = 0; m < 4; ++m) r0[m] = SSQ0[rbase + ai * 128 + m * 16];
                asm volatile("" ::: "memory");
#pragma unroll
                for (int m = 0; m < 4; ++m) {
                    const int r = rbase + ai * 128 + m * 16, s = r & (SEQ - 1), b = r >> 11; const float rr = rsqrtf(r0[m] * (1.0f / DM) + EPS);
#pragma unroll
                    for (int bj = 0; bj < 2; ++bj) {
                        const f32x4 v0 = acc[ai][bj][m][0] * rr, v1 = acc[ai][bj][m][1] * rr;
                        v4u w; w.x = pk2(v0[0], v0[1]); w.y = pk2(v0[2], v0[3]); w.z = pk2(v1[0], v1[1]); w.w = pk2(v1[2], v1[3]);
                        *(v4u*)(V + (size_t)r * 256 + 64 * wc + 32 * bj + 8 * fq) = w;
                        if (s >= SEQ - 128) {
                            float* o = out + O_VP + ((size_t)(b * 128 + s - (SEQ - 128)) * 4 + wc) * 64 + 32 * bj + 8 * fq;
                            *(f32x4*)o = v0; *(f32x4*)(o + 4) = v1;
                        }
                    }
                }
            }
        } else {
            const int ch = 128 * (pn - 6) + 32 * wc + 8 * fq;
#pragma unroll
            for (int ai = 0; ai < 2; ++ai) {
                float r0[4];
#pragma unroll
                for (int m = 0; m < 4; ++m) r0[m] = SSQ0[rbase + ai * 128 + m * 16];
                asm volatile("" ::: "memory");
#pragma unroll
                for (int m = 0; m < 4; ++m) {
                    const int r = rbase + ai * 128 + m * 16, s = r & (SEQ - 1), b = r >> 11;
                    const float rr = rsqrtf(r0[m] * (1.0f / DM) + EPS);
                    const f32x4 a0 = acc[ai][0][m][0] * rr, a1 = acc[ai][0][m][1] * rr, g0 = acc[ai][1][m][0] * rr, g1 = acc[ai][1][m][1] * rr;
                    f32x4 u0, u1;
#pragma unroll
                    for (int j = 0; j < 4; ++j) { u0[j] = a0[j] * sigmoidf_(g0[j]); u1[j] = a1[j] * sigmoidf_(g1[j]); }
                    v4u w; w.x = pk2(u0[0], u0[1]); w.y = pk2(u0[2], u0[3]); w.z = pk2(u1[0], u1[1]); w.w = pk2(u1[2], u1[3]);
                    *(v4u*)(U + (size_t)r * 1024 + ch) = w;
                    if (s >= SEQ - 30) {
                        float* o = out + O_CP + (size_t)(b * 30 + s - (SEQ - 30)) * 1024 + ch;
                        *(f32x4*)o = u0; *(f32x4*)(o + 4) = u1;
                    }
                }
            }
        }
    }
};
struct Epi3 {
    static constexpr bool PERM = true, AFTER_DRAIN = false;
    const bf16* XB; float* Y; bf16* X1G; const float* gm; float* SSQ;
    __device__ __forceinline__ void operator()(const f32x4 (&acc)[2][2][4][2], const Unit& u, int wr, int wc, int fr, int fq) const {
        const int rbase = u.pm * 256 + wr * 64 + fr, col0 = u.pn * 256 + wc * 32 + 8 * fq;
#pragma unroll
        for (int ai = 0; ai < 2; ++ai) {
            f32x4 pre[4][2][2];
#pragma unroll
            for (int m = 0; m < 4; ++m)
#pragma unroll
                for (int bj = 0; bj < 2; ++bj) { const v4u q = *(const v4u*)(XB + (size_t)(rbase + ai * 128 + m * 16) * DM + col0 + bj * 128);
                    pre[m][bj][0] = (f32x4){bf2f(q.x & 0xffffu), bf2f(q.x >> 16), bf2f(q.y & 0xffffu), bf2f(q.y >> 16)};
                    pre[m][bj][1] = (f32x4){bf2f(q.z & 0xffffu), bf2f(q.z >> 16), bf2f(q.w & 0xffffu), bf2f(q.w >> 16)}; }
            asm volatile("" ::: "memory");
#pragma unroll
            for (int m = 0; m < 4; ++m) {
                const int r = rbase + ai * 128 + m * 16; float ss = 0.f;
#pragma unroll
                for (int bj = 0; bj < 2; ++bj) {
                    const size_t off = (size_t)r * DM + col0 + bj * 128;
                    const f32x4 v0 = acc[ai][bj][m][0] + pre[m][bj][0], v1 = acc[ai][bj][m][1] + pre[m][bj][1];
                    ss += dot4(v0, v0) + dot4(v1, v1);
                    v4u w; w.x = pk2(v0[0], v0[1]); w.y = pk2(v0[2], v0[3]); w.z = pk2(v1[0], v1[1]); w.w = pk2(v1[2], v1[3]);
                    *(v4u*)(X1G + off) = w;
                }
                ss += __shfl_xor(ss, 16); ss += __shfl_xor(ss, 32);
                if (fq == 0) atomicAdd(SSQ + r, ss);
            }
            asm volatile("" ::: "memory");
        }
    }
};
struct Epi4 {
    static constexpr bool PERM = true, AFTER_DRAIN = false;
    const float* SSQ; bf16* H;
    __device__ __forceinline__ void operator()(const f32x4 (&acc)[2][2][4][2], const Unit& u, int wr, int wc, int fr, int fq) const {
        const int rbase = u.pm * 256 + wr * 64 + fr, col0 = u.pn * 256 + wc * 32 + 8 * fq;
        float sq[2][4];
#pragma unroll
        for (int ai = 0; ai < 2; ++ai)
#pragma unroll
            for (int m = 0; m < 4; ++m) sq[ai][m] = SSQ[rbase + ai * 128 + m * 16];
        asm volatile("" ::: "memory");
#pragma unroll
        for (int ai = 0; ai < 2; ++ai)
#pragma unroll
            for (int m = 0; m < 4; ++m) {
                const int r = rbase + ai * 128 + m * 16;
                const float rstd = rsqrtf(sq[ai][m] * (1.0f / DM) + EPS);
#pragma unroll
                for (int bj = 0; bj < 2; ++bj) {
                    f32x4 v0 = acc[ai][bj][m][0] * rstd, v1 = acc[ai][bj][m][1] * rstd;
#pragma unroll
                    for (int j = 0; j < 4; ++j) { v0[j] = fmaxf(v0[j], 0.f); v0[j] *= v0[j]; v1[j] = fmaxf(v1[j], 0.f); v1[j] *= v1[j]; }
                    v4u w; w.x = pk2(v0[0], v0[1]); w.y = pk2(v0[2], v0[3]); w.z = pk2(v1[0], v1[1]); w.w = pk2(v1[2], v1[3]);
                    *(v4u*)(H + (size_t)r * FF + col0 + bj * 128) = w;
                }
            }
    }
};
struct Epi5 {
    static constexpr bool PERM = true, AFTER_DRAIN = false;
    float* Y; const bf16* X1G;
    __device__ __forceinline__ void operator()(const f32x4 (&acc)[2][2][4][2], const Unit& u, int wr, int wc, int fr, int fq) const {
        const int rbase = u.pm * 256 + wr * 64 + fr, col0 = u.pn * 256 + wc * 32 + 8 * fq;
        v4u pre[2][4][2];
#pragma unroll
        for (int ai = 0; ai < 2; ++ai)
#pragma unroll
            for (int m = 0; m < 4; ++m)
#pragma unroll
                for (int bj = 0; bj < 2; ++bj) pre[ai][m][bj] = *(const v4u*)(X1G + (size_t)(rbase + ai * 128 + m * 16) * DM + col0 + bj * 128);
        asm volatile("" ::: "memory");
#pragma unroll
        for (int ai = 0; ai < 2; ++ai)
#pragma unroll
            for (int m = 0; m < 4; ++m)
#pragma unroll
                for (int bj = 0; bj < 2; ++bj) { float* p = Y + (size_t)(rbase + ai * 128 + m * 16) * DM + col0 + bj * 128; const v4u q = pre[ai][m][bj];
                    const f32x4 r0 = {bf2f(q.x & 0xffffu), bf2f(q.x >> 16), bf2f(q.y & 0xffffu), bf2f(q.y >> 16)}, r1 = {bf2f(q.z & 0xffffu), bf2f(q.z >> 16), bf2f(q.w & 0xffffu), bf2f(q.w >> 16)};
                    *(f32x4*)p = acc[ai][bj][m][0] + r0; *(f32x4*)(p + 4) = acc[ai][bj][m][1] + r1; }
    }
};

template <int NC = 1, class EpiS>
__device__ __forceinline__ void skinny_phase(LAS unsigned char* lds, const bf16* As, const bf16* Bt, int N, int K, int start, int stride, const EpiS& E, const int wid_in) {
    const int wave = wid_in; int tid = wave * 64 + mk_fresh_lane(); asm volatile("" : "+v"(tid));
    const int lane = tid & 63, fr = lane & 15, fq = lane >> 4;
    LAS float* red = (LAS float*)lds;
    const int kw = K >> 3, kb = wave * kw;
    for (int unit = start; unit < (N >> 4) / NC; unit += stride) {
        f32x4 a0[NC], a1[NC];
#pragma unroll
        for (int c = 0; c < NC; ++c) { a0[c] = (f32x4){0.f, 0.f, 0.f, 0.f}; a1[c] = (f32x4){0.f, 0.f, 0.f, 0.f}; }
        const bf16* bp = Bt + (size_t)(16 * NC * unit + fr) * K + kb + 8 * fq;
        const bf16* ap0 = As + (size_t)fr * K + kb + 8 * fq;
        const bf16* ap1 = ap0 + (size_t)16 * K;
#pragma unroll 8
        for (int k = 0; k < kw; k += 32) {
            const bf16x8 x0 = *(const bf16x8*)(ap0 + k), x1 = *(const bf16x8*)(ap1 + k);
#pragma unroll
            for (int c = 0; c < NC; ++c) { const bf16x8 b = *(const bf16x8*)(bp + (size_t)(16 * c) * K + k);
                a0[c] = __builtin_amdgcn_mfma_f32_16x16x32_bf16(b, x0, a0[c], 0, 0, 0);
                a1[c] = __builtin_amdgcn_mfma_f32_16x16x32_bf16(b, x1, a1[c], 0, 0, 0); }
        }
#pragma unroll
        for (int c = 0; c < NC; ++c) {
            *(LAS f32x4*)(red + ((wave * NC + c) * 2 + 0) * 256 + lane * 4) = a0[c];
            *(LAS f32x4*)(red + ((wave * NC + c) * 2 + 1) * 256 + lane * 4) = a1[c]; }
        __syncthreads();
        const int row = tid >> 4, cj = tid & 15, idx = (row >> 4) * 256 + ((row & 15) + 16 * (cj >> 2)) * 4 + (cj & 3);
#pragma unroll
        for (int c = 0; c < NC; ++c) {
            float s = 0.f;
#pragma unroll
            for (int w = 0; w < 8; ++w) s += red[(w * NC + c) * 512 + idx];
            E(row, 16 * (NC * unit + c) + cj, s);
        }
        __syncthreads();
    }
}
struct EpiS1 { float* ZS; const float* SSQ0; __device__ __forceinline__ void operator()(int row, int col, float v) const { ZS[row * INC + win_logical_col(col)] = v * rsqrtf(SSQ0[MP + row] * (1.0f / DM) + EPS); } };
struct EpiS3 { const float* xs; float* Y; bf16* X1G; const float* gm; float* SSQ;
    __device__ __forceinline__ void operator()(int row, int col, float v) const {
        const float x1 = xs[row * DM + col] + v; X1G[(size_t)(MP + row) * DM + col] = (bf16)f2bf(x1);
        float ss = x1 * x1; ss += __shfl_xor(ss, 1); ss += __shfl_xor(ss, 2); ss += __shfl_xor(ss, 4); ss += __shfl_xor(ss, 8);
        if ((mk_fresh_lane() & 15) == 0) atomicAdd(SSQ + MP + row, ss);
    } };
struct EpiS4 { float* SSQ; bf16* H;
    __device__ __forceinline__ void operator()(int row, int col, float v) const {
        const float rstd = rsqrtf(__hip_atomic_load(SSQ + MP + row, __ATOMIC_RELAXED, __HIP_MEMORY_SCOPE_AGENT) * (1.0f / DM) + EPS);
        float h = fmaxf(v * rstd, 0.f); h *= h; H[(size_t)(MP + row) * FF + col] = (bf16)f2bf(h);
    } };
struct EpiS5 { float* Y; const bf16* X1G; float fac; __device__ __forceinline__ void operator()(int row, int col, float v) const { const size_t o = (size_t)(MP + row) * DM + col; Y[o] = (bf2f((unsigned)X1G[o]) + v) * fac; } };

template <int DEPTH, class Dec, bool NTST = false>
__device__ __forceinline__ void cvt_items(LAS float* scr, int first, int total, int stride, int lane, const Dec& D) {
    const int r8 = lane >> 3, c4 = lane & 7;
    int it = first; if (it >= total) return;
    const float* src; int N;
    f32x4 v[DEPTH][8]; bf16* dst[DEPTH]; int K[DEPTH];
#pragma unroll
    for (int d = 0; d < DEPTH; ++d) { dst[d] = nullptr; K[d] = 0; }
#pragma unroll
    for (int d = 0; d < DEPTH - 1; ++d)
        if (it + d * stride < total) { D(it + d * stride, src, N, dst[d], K[d]);
#pragma unroll
            for (int i = 0; i < 8; ++i) v[d][i] = __builtin_nontemporal_load((const f32x4*)(src + (size_t)(r8 + 8 * i) * N + 4 * c4)) * D.rowscale(it + d * stride, r8 + 8 * i); }
    for (;;) {
        const int nl = it + (DEPTH - 1) * stride;
        if (nl < total) { D(nl, src, N, dst[DEPTH - 1], K[DEPTH - 1]);
#pragma unroll
            for (int i = 0; i < 8; ++i) v[DEPTH - 1][i] = __builtin_nontemporal_load((const f32x4*)(src + (size_t)(r8 + 8 * i) * N + 4 * c4)) * D.rowscale(nl, r8 + 8 * i); }
#pragma unroll
        for (int i = 0; i < 8; ++i) { LAS float* s = scr + (r8 + 8 * i) * 33 + 4 * c4; s[0] = v[0][i][0]; s[1] = v[0][i][1]; s[2] = v[0][i][2]; s[3] = v[0][i][3]; }
        LDS_WAIT(); asm volatile("" ::: "memory");
        const int c = lane & 7;
#pragma unroll
        for (int j = 0; j < 4; ++j) { const int n = (lane >> 3) + 8 * j; const LAS float* s = scr + (8 * c) * 33 + n;
            v4u o; o.x = pk2(s[0 * 33], s[1 * 33]); o.y = pk2(s[2 * 33], s[3 * 33]); o.z = pk2(s[4 * 33], s[5 * 33]); o.w = pk2(s[6 * 33], s[7 * 33]);
            if (NTST) __builtin_nontemporal_store(o, (v4u*)(dst[0] + (size_t)n * K[0] + 8 * c)); else *(v4u*)(dst[0] + (size_t)n * K[0] + 8 * c) = o; }
        LDS_WAIT(); asm volatile("" ::: "memory");
        it += stride; if (it >= total) break;
#pragma unroll
        for (int d = 0; d < DEPTH - 1; ++d) {
#pragma unroll
            for (int i = 0; i < 8; ++i) v[d][i] = v[d + 1][i];
            dst[d] = dst[d + 1]; K[d] = K[d + 1]; }
    }
}
struct DecP0 { const float* w_in; bf16* WinT; const float* gmix;
    __device__ __forceinline__ float rowscale(int it, int kk) const { return gmix[64 * (it / (INC / 32)) + kk]; }
    __device__ __forceinline__ void operator()(int it, const float*& src, int& N, bf16*& dst, int& K) const {
        const int kb = it / (INC / 32), nb = it % (INC / 32); src = w_in + (size_t)(64 * kb) * INC + 32 * nb; N = INC; K = DM; dst = WinT + (size_t)(32 * win_dst_group(nb)) * DM + 64 * kb;
    } };
struct DecUp { const float *w_up, *w_out; bf16 *WupT, *WoutT; const float* gm;
    __device__ __forceinline__ float rowscale(int it, int kk) const { constexpr int I_UP = (DM / 64) * (FF / 32); return it < I_UP ? gm[64 * (it / (FF / 32)) + kk] : 1.0f; }
    __device__ __forceinline__ void operator()(int it, const float*& src, int& N, bf16*& dst, int& K) const {
        constexpr int I_UP = (DM / 64) * (FF / 32);
        if (it < I_UP) { const int kb = it / (FF / 32), nb = it % (FF / 32); src = w_up + (size_t)(64 * kb) * FF + 32 * nb; N = FF; K = DM; dst = WupT + (size_t)(32 * nb) * DM + 64 * kb; }
        else { const int r = it - I_UP, kb = r / (DM / 32), nb = r % (DM / 32); src = w_out + (size_t)(64 * kb) * DM + 32 * nb; N = DM; K = DM; dst = WoutT + (size_t)(32 * nb) * DM + 64 * kb; }
    } };
struct DecDn { const float* w_down; bf16* WdnT;
    __device__ __forceinline__ float rowscale(int, int) const { return 1.0f; }
    __device__ __forceinline__ void operator()(int it, const float*& src, int& N, bf16*& dst, int& K) const {
        const int kb = it / (DM / 32), nb = it % (DM / 32); src = w_down + (size_t)(64 * kb) * DM + 32 * nb; N = DM; K = FF; dst = WdnT + (size_t)(32 * nb) * FF + 64 * kb;
    } };
__device__ __forceinline__ void row_to_bf16(const float* xrow, bf16* orow, float* ssq, int lane) {
    const f32x4* xr = (const f32x4*)xrow + lane;
    f32x4 v[8]; float s = 0.f;
#pragma unroll
    for (int j = 0; j < 8; ++j) { v[j] = __builtin_nontemporal_load(xr + 64 * j); s += dot4(v[j], v[j]); }
    v2u* o8 = (v2u*)orow + lane;
#pragma unroll
    for (int j = 0; j < 8; ++j) { v2u w; w.x = pk2(v[j][0], v[j][1]); w.y = pk2(v[j][2], v[j][3]); o8[64 * j] = w; }
    s = wave_sum(s);
    if (lane == 0) *ssq = s;
}

constexpr int KS_STRIDE = 72, VT_STRIDE = 276, KS_BYTES = 272 * KS_STRIDE * 2, VT_BYTES = 64 * VT_STRIDE * 2;
__device__ __forceinline__ void attn_unit(LAS unsigned char* lds, int b, int nb, int kh, const bf16* Q, const bf16* Kb, const bf16* Vb, bf16* MIX, const float* sinks,
                                          int tid, int wave, int lane) {
    LAS bf16* Ks = (LAS bf16*)lds; LAS bf16* Vt = (LAS bf16*)(lds + KS_BYTES);
    const int fr = lane & 15, fq = lane >> 4;
#pragma unroll
    for (int p = 0; p < 4; ++p) {
        const int idx = p * 512 + tid, key = idx >> 3, c = idx & 7, s = 128 * (nb - 1) + key;
        v4u kv = {0u, 0u, 0u, 0u}, vv = {0u, 0u, 0u, 0u};
        if (s >= 0) { const size_t off = (size_t)(b * SEQ + s) * 256 + 64 * kh + 8 * c; kv = *(const v4u*)(Kb + off); vv = *(const v4u*)(Vb + off); }
        *(LAS v4u*)(Ks + key * KS_STRIDE + 8 * c) = kv;
        LAS bf16* vp = Vt + (8 * c) * VT_STRIDE + key;
        vp[0 * VT_STRIDE] = (bf16)(vv.x & 0xffffu); vp[1 * VT_STRIDE] = (bf16)(vv.x >> 16); vp[2 * VT_STRIDE] = (bf16)(vv.y & 0xffffu); vp[3 * VT_STRIDE] = (bf16)(vv.y >> 16);
        vp[4 * VT_STRIDE] = (bf16)(vv.z & 0xffffu); vp[5 * VT_STRIDE] = (bf16)(vv.z >> 16); vp[6 * VT_STRIDE] = (bf16)(vv.w & 0xffffu); vp[7 * VT_STRIDE] = (bf16)(vv.w >> 16);
    }
    if (tid < 144) *(LAS v4u*)(Ks + 256 * KS_STRIDE + tid * 8) = (v4u){0u, 0u, 0u, 0u};
    for (int i = tid; i < 64 * 20; i += 512) Vt[(i / 20) * VT_STRIDE + 256 + (i % 20)] = 0;
    const int g = wave >> 1, h = 4 * kh + g; const float sink = sinks[h];
    bf16x8 qall[4][2];
#pragma unroll
    for (int qi = 0; qi < 4; ++qi) { const size_t r = (size_t)b * SEQ + 128 * nb + 16 * (4 * (wave & 1) + qi) + fr;
        qall[qi][0] = *(const bf16x8*)(Q + r * 1024 + 64 * h + 8 * fq); qall[qi][1] = *(const bf16x8*)(Q + r * 1024 + 64 * h + 32 + 8 * fq); }
    __syncthreads();
#pragma unroll
    for (int qi = 0; qi < 4; ++qi) {
        const int qt = 4 * (wave & 1) + qi, i0 = 16 * qt;
        const size_t r = (size_t)b * SEQ + 128 * nb + i0 + fr;
        bf16x8 qf[2];
        qf[0] = qall[qi][0]; qf[1] = qall[qi][1];
        f32x4 S[10];
#pragma unroll
        for (int t = 0; t < 10; ++t) {
            S[t] = (f32x4){0.f, 0.f, 0.f, 0.f};
#pragma unroll
            for (int ks = 0; ks < 2; ++ks) {
                const bf16x8 kf = *(const LAS bf16x8*)(Ks + (16 * (qt + t) + fr) * KS_STRIDE + 32 * ks + 8 * fq);
                S[t] = __builtin_amdgcn_mfma_f32_16x16x32_bf16(kf, qf[ks], S[t], 0, 0, 0);
            }
        }
        float mx = sink;
#pragma unroll
        for (int t = 0; t < 10; ++t)
#pragma unroll
            for (int j = 0; j < 4; ++j) {
                const int rel = 16 * t + 4 * fq + j - fr;
                const bool ok = rel >= 1 && rel <= 128 && (nb > 0 || (i0 + 16 * t + 4 * fq + j) >= 128);
                S[t][j] = ok ? S[t][j] : -1e30f; mx = fmaxf(mx, S[t][j]);
            }
        mx = fmaxf(mx, __shfl_xor(mx, 16)); mx = fmaxf(mx, __shfl_xor(mx, 32));
        float sum = 0.f;
#pragma unroll
        for (int t = 0; t < 10; ++t)
#pragma unroll
            for (int j = 0; j < 4; ++j) { S[t][j] = __expf(S[t][j] - mx); sum += S[t][j]; }
        sum += __shfl_xor(sum, 16); sum += __shfl_xor(sum, 32); sum += __expf(sink - mx);
        const float inv = 1.0f / sum;
        f32x4 O[4];
#pragma unroll
        for (int dt = 0; dt < 4; ++dt) O[dt] = (f32x4){0.f, 0.f, 0.f, 0.f};
#pragma unroll
        for (int k2 = 0; k2 < 5; ++k2) {
            v4u pw; pw.x = pk2(S[2 * k2][0], S[2 * k2][1]); pw.y = pk2(S[2 * k2][2], S[2 * k2][3]); pw.z = pk2(S[2 * k2 + 1][0], S[2 * k2 + 1][1]); pw.w = pk2(S[2 * k2 + 1][2], S[2 * k2 + 1][3]);
            const bf16x8 pf = __builtin_bit_cast(bf16x8, pw);
#pragma unroll
            for (int dt = 0; dt < 4; ++dt) {
                const LAS bf16* vp = Vt + (16 * dt + fr) * VT_STRIDE + 16 * (qt + 2 * k2) + 4 * fq;
                const v2u lo = *(const LAS v2u*)vp, hi = *(const LAS v2u*)(vp + 16);
                v4u vw; vw.x = lo.x; vw.y = lo.y; vw.z = hi.x; vw.w = hi.y;
                O[dt] = __builtin_amdgcn_mfma_f32_16x16x32_bf16(__builtin_bit_cast(bf16x8, vw), pf, O[dt], 0, 0, 0);
            }
        }
#pragma unroll
        for (int dt = 0; dt < 4; ++dt) {
            v2u w; w.x = pk2(O[dt][0] * inv, O[dt][1] * inv); w.y = pk2(O[dt][2] * inv, O[dt][3] * inv);
            *(v2u*)(MIX + r * DM + 64 * h + 16 * dt + 4 * fq) = w;
        }
    }
    __syncthreads();
}

constexpr int PF_LDS_OFF = 132096;
__device__ __forceinline__ void glds16_pf(const void* gsrc, unsigned lds_dst) { unsigned keep;
    asm volatile("s_mov_b32 %0, m0\n\ts_mov_b32 m0, %2\n\ts_nop 0\n\tglobal_load_lds_dwordx4 %1, off\n\ts_mov_b32 m0, %0" : "=&s"(keep) : "v"(gsrc), "s"(lds_dst) : "memory"); }
__device__ __forceinline__ void conv_unit(LAS unsigned char* lds, int b, int tb, const bf16* U, bf16* MIX, const float* cw, const float* cb, const float* lg, const float* lb,
                                          const float* xpre, int tid, int wave, int lane) {
    LAS unsigned* tile = (LAS unsigned*)lds;
    LAS float* red = (LAS float*)(lds + 62 * 2048);
    LAS float* fin = red + 512;
    const int s0 = 32 * tb;
    {   const int row0 = tid >> 7, c16 = tid & 127;
        const bf16* up = U + ((size_t)b * SEQ + s0 - 30 + row0) * 1024 + 8 * c16;
#pragma unroll
        for (int h8 = 0; h8 < 2; ++h8) {
            v4u tv[8];
#pragma unroll
            for (int t = 0; t < 8; ++t) { const int row = row0 + 4 * (8 * h8 + t);
                tv[t] = (v4u){0u, 0u, 0u, 0u};
                if (row < 62 && s0 - 30 + row >= 0) tv[t] = *(const v4u*)(up + (size_t)(4 * (8 * h8 + t)) * 1024); }
#pragma unroll
            for (int t = 0; t < 8; ++t) { const int row = row0 + 4 * (8 * h8 + t);
                if (row < 62) *(LAS v4u*)(tile + row * 512 + 4 * c16) = tv[t]; }
            asm volatile("" ::: "memory");
        }
    }
    __syncthreads();
    f32x2 w[31];
#pragma unroll
    for (int j = 0; j < 31; ++j) w[j] = *(const f32x2*)(cw + j * 1024 + 2 * tid);
    const f32x2 bias = *(const f32x2*)(cb + 2 * tid);
    const f32x2 g = *(const f32x2*)(lg + 2 * tid), be = *(const f32x2*)(lb + 2 * tid);
#pragma unroll 1
    for (int ck = 0; ck < 4; ++ck) {
        f32x2 c[8];
#pragma unroll
        for (int o = 0; o < 8; ++o) c[o] = bias;
#pragma unroll
        for (int rr = 0; rr < 38; ++rr) {
            const unsigned pv = tile[(8 * ck + rr) * 512 + tid];
            const f32x2 v = {bf2f(pv & 0xffffu), bf2f(pv >> 16)};
#pragma unroll
            for (int o = 0; o < 8; ++o) { const int j = rr - o; if (j >= 0 && j <= 30) c[o] = c[o] + w[j] * v; }
            if ((rr & 7) == 7) asm volatile("" ::: "memory");
        }
#pragma unroll
        for (int o = 0; o < 8; ++o) {
            const f32x2 x = c[o];
            const float s1 = wave_sum(x[0] + x[1]), s2 = wave_sum(x[0] * x[0] + x[1] * x[1]);
            if (lane == 0) { red[(wave * 8 + o) * 2] = s1; red[(wave * 8 + o) * 2 + 1] = s2; }
        }
        asm volatile("s_waitcnt lgkmcnt(0)\n\ts_barrier" ::: "memory");
        if (tid < 16) { float s = 0.f;
#pragma unroll
            for (int wv = 0; wv < 8; ++wv) s += red[wv * 16 + tid];
            fin[tid] = s; }
        asm volatile("s_waitcnt lgkmcnt(0)\n\ts_barrier" ::: "memory");
#pragma unroll
        for (int t = 0; t < 8; ++t) {
            const float mean = fin[2 * t] * (1.0f / CCH), var = fin[2 * t + 1] * (1.0f / CCH) - mean * mean, rstd = rsqrtf(fmaxf(var, 0.f) + EPS);
            const f32x2 y = (c[t] - mean) * rstd * g + be;
            const float o0 = y[0] * sigmoidf_(y[0]), o1 = y[1] * sigmoidf_(y[1]);
            *(unsigned*)(MIX + (size_t)(b * SEQ + s0 + 8 * ck + t) * DM + 1024 + 2 * tid) = pk2(o0, o1);
        }
        if (ck == 0 && xpre) {
            const float* xr = xpre + (size_t)(wave * 32) * DM + lane * 4;
#pragma unroll 8
            for (int i = 0; i < 32; ++i) glds16_pf(xr + (size_t)i * DM, (unsigned)(PF_LDS_OFF + wave * 1024));
        }
    }
    asm volatile("s_waitcnt lgkmcnt(0)\n\ts_barrier" ::: "memory");
}

__device__ __forceinline__ void sample_att(LAS unsigned char* lds, int b, const float* ZS, const float* cache_k, const float* cache_v, const float* state,
                                             const float* gq, const float* gk, const float* sinks, const float* cw, const float* cb, const float* lg, const float* lb,
                                             const float* cosT, const float* sinT, float* out, bf16* MIX, int tid, int wave, int lane) {
    LAS float* zs = (LAS float*)lds;
    LAS float* qs = zs + 3584;
    LAS float* kn = qs + 1024;
    LAS float* vn = kn + 256;
    LAS float* sc = vn + 256;
    LAS float* rd = sc + 2048;
    LAS float* part = rd + 16;
    for (int i = tid; i < INC; i += 512) zs[i] = ZS[b * INC + i];
    __syncthreads();
    for (int hh = wave; hh < 20; hh += 8) {
        const int base = hh < 16 ? 64 * hh : 1024 + 64 * (hh - 16);
        const float x = zs[base + lane];
        const float rstd = rsqrtf(wave_sum(x * x) * (1.0f / 64.0f) + EPS);
        const float y = x * rstd * (hh < 16 ? gq : gk)[lane];
        const float p = __shfl_xor(y, 32);
        const float co = cosT[2048 * 32 + (lane & 31)], si = sinT[2048 * 32 + (lane & 31)];
        const float o = lane < 32 ? y * co - p * si : y * co + p * si;
        if (hh < 16) qs[hh * 64 + lane] = o * 0.125f;
        else { kn[(hh - 16) * 64 + lane] = o; out[O_KS + ((size_t)(b * 128 + 127) * 4 + (hh - 16)) * 64 + lane] = o; }
    }
    if (tid < 256) { const float vv = zs[1280 + tid]; vn[tid] = vv; out[O_VS + (size_t)(b * 128 + 127) * 256 + tid] = vv; }
    __syncthreads();
    {
        const int jj = tid >> 2, kh = tid & 3, j = jj + 1;
        float d0 = 0.f, d1 = 0.f, d2 = 0.f, d3 = 0.f;
        const LAS float* q0 = qs + (4 * kh) * 64;
        if (j < 128) {
            const f32x4* kr = (const f32x4*)(cache_k + ((size_t)(b * 128 + j) * 4 + kh) * 64);
#pragma unroll
            for (int d4 = 0; d4 < 16; ++d4) { const f32x4 kv = kr[d4];
                d0 += dot4(kv, *(const LAS f32x4*)(q0 + 4 * d4)); d1 += dot4(kv, *(const LAS f32x4*)(q0 + 64 + 4 * d4));
                d2 += dot4(kv, *(const LAS f32x4*)(q0 + 128 + 4 * d4)); d3 += dot4(kv, *(const LAS f32x4*)(q0 + 192 + 4 * d4)); }
        } else {
#pragma unroll 4
            for (int d4 = 0; d4 < 16; ++d4) { const f32x4 kv = *(const LAS f32x4*)(kn + kh * 64 + 4 * d4);
                d0 += dot4(kv, *(const LAS f32x4*)(q0 + 4 * d4)); d1 += dot4(kv, *(const LAS f32x4*)(q0 + 64 + 4 * d4));
                d2 += dot4(kv, *(const LAS f32x4*)(q0 + 128 + 4 * d4)); d3 += dot4(kv, *(const LAS f32x4*)(q0 + 192 + 4 * d4)); }
        }
        sc[(4 * kh + 0) * 128 + jj] = d0; sc[(4 * kh + 1) * 128 + jj] = d1; sc[(4 * kh + 2) * 128 + jj] = d2; sc[(4 * kh + 3) * 128 + jj] = d3;
    }
    __syncthreads();
    for (int h = 2 * wave; h < 2 * wave + 2; ++h) {
        const float a = sc[h * 128 + lane], c2 = sc[h * 128 + 64 + lane], sink = sinks[h];
        const float m = fmaxf(wave_max(fmaxf(a, c2)), sink);
        const float pa = __expf(a - m), pb = __expf(c2 - m);
        const float den = wave_sum(pa + pb) + __expf(sink - m), inv = 1.0f / den;
        sc[h * 128 + lane] = pa * inv; sc[h * 128 + 64 + lane] = pb * inv;
    }
    __syncthreads();
    {
        const int d = tid & 63, kg = wave;
#pragma unroll 1
        for (int kh = 0; kh < 4; ++kh) {
            float vv[16];
#pragma unroll
            for (int t = 0; t < 16; ++t) { const int jj = 16 * kg + t;
                vv[t] = (jj < 127) ? cache_v[((size_t)(b * 128 + jj + 1) * 4 + kh) * 64 + d] : vn[kh * 64 + d]; }
            float a0 = 0.f, a1 = 0.f, a2 = 0.f, a3 = 0.f;
            const LAS float* sp = sc + (4 * kh) * 128 + 16 * kg;
#pragma unroll
            for (int t = 0; t < 16; ++t) { a0 += sp[t] * vv[t]; a1 += sp[128 + t] * vv[t]; a2 += sp[256 + t] * vv[t]; a3 += sp[384 + t] * vv[t]; }
            LAS float* pp = part + (kg * 16 + 4 * kh) * 64 + d;
            pp[0] = a0; pp[64] = a1; pp[128] = a2; pp[192] = a3;
        }
        __syncthreads();
#pragma unroll
        for (int hi = 0; hi < 2; ++hi) {
            const int h = (tid >> 6) + 8 * hi; float o = 0.f;
#pragma unroll
            for (int k8 = 0; k8 < 8; ++k8) o += part[(k8 * 16 + h) * 64 + d];
            MIX[(size_t)(MP + b) * DM + 64 * h + d] = (bf16)f2bf(o);
        }
    }
    __syncthreads();
}
__device__ __forceinline__ void sample_conv(LAS unsigned char* lds, int b, const float* ZS, const float* cache_k, const float* cache_v, const float* state,
                                             const float* gq, const float* gk, const float* sinks, const float* cw, const float* cb, const float* lg, const float* lb,
                                             const float* cosT, const float* sinT, float* out, bf16* MIX, int tid, int wave, int lane) {
    LAS float* zs = (LAS float*)lds;
    LAS float* qs = zs + 3584;
    LAS float* kn = qs + 1024;
    LAS float* vn = kn + 256;
    LAS float* sc = vn + 256;
    LAS float* rd = sc + 2048;
    LAS float* part = rd + 16;
    for (int i = 1536 + tid; i < INC; i += 512) zs[i] = ZS[b * INC + i];
    __syncthreads();
    {
        const int ch = 2 * tid;
        const float u0 = zs[1536 + ch] * sigmoidf_(zs[2560 + ch]), u1 = zs[1536 + ch + 1] * sigmoidf_(zs[2560 + ch + 1]);
        *(f32x2*)(out + O_CS + (size_t)(b * 30 + 29) * 1024 + ch) = (f32x2){u0, u1};
        f32x2 c = *(const f32x2*)(cb + ch);
#pragma unroll 10
        for (int j = 0; j < 30; ++j) c = c + *(const f32x2*)(cw + j * 1024 + ch) * *(const f32x2*)(state + (size_t)(b * 30 + j) * 1024 + ch);
        c = c + *(const f32x2*)(cw + 30 * 1024 + ch) * (f32x2){u0, u1};
        const float s1 = wave_sum(c[0] + c[1]), s2 = wave_sum(c[0] * c[0] + c[1] * c[1]);
        if (lane == 0) { rd[wave * 2] = s1; rd[wave * 2 + 1] = s2; }
        __syncthreads();
        float t1 = 0.f, t2 = 0.f;
#pragma unroll
        for (int wv = 0; wv < 8; ++wv) { t1 += rd[wv * 2]; t2 += rd[wv * 2 + 1]; }
        const float mean = t1 * (1.0f / CCH), var = t2 * (1.0f / CCH) - mean * mean, rstd = rsqrtf(fmaxf(var, 0.f) + EPS);
        const f32x2 y = (c - mean) * rstd * *(const f32x2*)(lg + ch) + *(const f32x2*)(lb + ch);
        *(unsigned*)(MIX + (size_t)(MP + b) * DM + 1024 + ch) = pk2(y[0] * sigmoidf_(y[0]), y[1] * sigmoidf_(y[1]));
    }
    __syncthreads();
}

#ifndef MK_DUP
#define MK_DUP (-1)
#endif
#define REPS(k)
#ifndef MK_CG_SEAMS
#define MK_CG_SEAMS 0
#endif
#define P2_CVT() do { const DecDn D{w_down, WdnT}; cvt_items<3, DecDn, true>((LAS float*)(lds + wave * 16384), bx * NWAVES + wave, (FF / 64) * (DM / 32), ncv * NWAVES, lane, D); \
                const int gt = bx * (NWAVES * 64) + tid, NT = ncv * NWAVES * 64;        \
                for (int i = gt; i < 32 * 8128; i += NT) { const int b = i / 8128, o = i % 8128; \
                    __builtin_nontemporal_store(((const f32x4*)(cache_k + (size_t)b * 32768 + 256))[o], (f32x4*)(out + O_KS + (size_t)b * 32768) + o); \
                    __builtin_nontemporal_store(((const f32x4*)(cache_v + (size_t)b * 32768 + 256))[o], (f32x4*)(out + O_VS + (size_t)b * 32768) + o); } \
                for (int i = gt; i < 32 * 7424; i += NT) { const int b = i / 7424, o = i % 7424; \
                    __builtin_nontemporal_store(((const f32x4*)(state + (size_t)b * 30720 + 1024))[o], (f32x4*)(out + O_CS + (size_t)b * 30720) + o); } } while (0)
struct Args { const float* in[18]; float* out; unsigned char* ws; int ph_lo, ph_hi, dry, pad; };
__global__ void __launch_bounds__(NWAVES * 64, 2) mk_fwd(Args args) {
    extern __shared__ __attribute__((aligned(16))) unsigned char lds_raw[];
    LAS unsigned char* lds = (LAS unsigned char*)lds_raw;
    const int wave_k = __builtin_amdgcn_readfirstlane((int)threadIdx.x >> 6);
    const int tid = wave_k * 64 + mk_fresh_lane();
    const int G = gridDim.x, bx = blockIdx.x;
    const int vcu = (G % 8 == 0) ? (bx % 8) * (G / 8) + bx / 8 : bx;
    unsigned char* ws = args.ws;
    const float *xp = args.in[0], *xs = args.in[1], *cache_k = args.in[2], *cache_v = args.in[3], *state = args.in[4], *g_mix = args.in[5], *w_in = args.in[6],
                *gq = args.in[7], *gk = args.in[8], *sinks = args.in[9], *conv_w = args.in[10], *conv_b = args.in[11], *ln_g = args.in[12], *ln_b = args.in[13],
                *w_out = args.in[14], *g_mlp = args.in[15], *w_up = args.in[16], *w_down = args.in[17];
    float* out = args.out;
    float* SSQ = (float*)(ws + WS_SSQ); float* SSQ0 = (float*)(ws + WS_SSQ0); float* cosT = (float*)(ws + WS_COS); float* sinT = (float*)(ws + WS_SIN); float* ZS = (float*)(ws + WS_ZS);
    bf16 *WinT = (bf16*)(ws + WS_WIN), *WoutT = (bf16*)(ws + WS_WOUT), *WupT = (bf16*)(ws + WS_WUP), *WdnT = (bf16*)(ws + WS_WDN);
    bf16 *X1G = (bf16*)(ws + WS_X1G), *HID = (bf16*)(ws + WS_HID), *XN = (bf16*)(ws + WS_XN), *Qb = (bf16*)(ws + WS_Q), *Kb = (bf16*)(ws + WS_K), *Vb = (bf16*)(ws + WS_V),
         *Ub = (bf16*)(ws + WS_U), *MIX = (bf16*)(ws + WS_MIX);
    for (int u = tid; u < (LDS_BYTES - LDSCTL_OFF) / 4; u += NWAVES * 64) ((LAS unsigned*)(lds + LDSCTL_OFF))[u] = 0u;
    __syncthreads();
    volatile LAS unsigned* MISC = (volatile LAS unsigned*)(lds + MISC_OFF);
    XcdBarrier bar; bar.bar = (unsigned*)(ws + WS_CTL) + CW_BAR; bar.x = 0; bar.st = nullptr;
    if (MK_N_LAUNCHES == 1) bar = xcd_barrier_post((unsigned*)(ws + WS_CTL) + CW_BAR, MISC + 8);
#define GRID_BAR(seam) do { if (MK_N_LAUNCHES == 1) { if ((MK_CG_SEAMS >> (seam)) & 1) cg::this_grid().sync(); else xcd_barrier(bar); } STAMP((seam) + 1); } while (0)
#define FRESH_IDS() const int wave = wave_k; int tid = wave * 64 + mk_fresh_lane(); asm volatile("" : "+v"(tid)); const int lane = tid & 63; (void)lane
#ifdef MK_TA
    unsigned long long* TS = (unsigned long long*)(ws + WS_SSQ + 128 * 1024);
#define STAMP(k) do { if (bx == G - 1 && tid == 0) TS[k] = __builtin_amdgcn_s_memrealtime(); } while (0)
#else
#define STAMP(k) do { } while (0)
#endif
    STAMP(0);
    const int lo = args.ph_lo, hi = args.ph_hi;
#ifndef MK_PLAIN
    if (args.pad == 0x5eed) cg::this_grid().sync();
#endif
#define IN(k) (lo <= (k) && (k) < hi)

    if (IN(0)) { REPS(0) {
        FRESH_IDS();
        LAS float* scr = (LAS float*)(lds + wave * 16384);
        const int gw = vcu * NWAVES + wave, NGW = G * NWAVES;
        { const DecP0 D{w_in, WinT, g_mix}; cvt_items<3>(scr, gw, (DM / 64) * (INC / 32), NGW, lane, D); }
        for (int m = gw; m < MT; m += NGW) row_to_bf16(m < MP ? xp + (size_t)m * DM : xs + (size_t)(m - MP) * DM, XN + (size_t)m * DM, SSQ0 + m, lane);
        const int gt = vcu * (NWAVES * 64) + tid, NT = G * NWAVES * 64;
        for (int i = gt; i < 2049 * 32; i += NT) {
            const int pos = i >> 5, k = i & 31; double inv = 1.0;
            for (int j = 0; j < k; ++j) inv *= 0.7498942093324559;
            const float ang = (pos == 2048 ? 16384.0f : (float)pos) * (float)inv;
            double rev = (double)ang * 0.15915494309189535; rev -= __builtin_rint(rev);
            const float rf = (float)rev;
            cosT[i] = __builtin_amdgcn_cosf(rf); sinT[i] = __builtin_amdgcn_sinf(rf);
        }
        }
        if (IN(1)) GRID_BAR(0);
    }
    if (IN(1)) { REPS(1) {
        const int nun = (MP / 256) * (INC / 256), rounds = (nun + G - 1) / G, GG = (nun + rounds - 1) / rounds, nsv = G - GG;
        if (bx < GG) {
            pg8::Gemm g{XN, WinT, MP, INC, DM}; pg8::StaticOrder S; S.init(MP, INC, GG, bx);
            Epi1 E{Qb, Kb, Vb, Ub, out, gq, gk, cosT, sinT, SSQ0};
            pg8::gemm_phase<Epi1, pg8::StaticOrder, true, true>(lds, g, S, E, wave_k);
        }
        FRESH_IDS();
        STAMP(9);
        EpiS1 ES{ZS, SSQ0};
        skinny_phase(lds, XN + (size_t)MP * DM, WinT, INC, DM, bx, G, ES, wave_k);
        {   const DecUp D{w_up, w_out, WupT, WoutT, g_mlp}; constexpr int NIT = (DM / 64) * (FF / 32) + (DM / 64) * (DM / 32);
            if (nsv > 0) { if (bx >= GG) cvt_items<5>((LAS float*)(lds + wave * 16384), (bx - GG) * NWAVES + wave, NIT, nsv * NWAVES, lane, D); }
            else cvt_items<5>((LAS float*)(lds + wave * 16384), bx * NWAVES + wave, NIT, G * NWAVES, lane, D);
        }
        }
        STAMP(12);
        if (IN(2)) GRID_BAR(1);
    }
    if (IN(2)) { REPS(2) {
        FRESH_IDS();
        const int ncv = G > 2 * MS ? G - 2 * MS : G;
        const bool cvt_first = bx < ncv && ((bx >> 3) & 1);
        if (cvt_first) { P2_CVT(); __syncthreads(); }
        for (int a = vcu; a < 256; a += G) attn_unit(lds, a >> 6, (a >> 2) & 15, a & 3, Qb, Kb, Vb, MIX, sinks, tid, wave, lane);
        STAMP(6);
        for (int c = vcu; c < 256; c += G) conv_unit(lds, c >> 6, c & 63, Ub, MIX, conv_w, conv_b, ln_g, ln_b, nullptr, tid, wave, lane);
        STAMP(7);
        if (bx < ncv && !cvt_first) { P2_CVT(); __syncthreads(); }
        for (int j = G - 1 - bx; j < 2 * MS; j += G) {
            if (j < MS) sample_att(lds, j, ZS, cache_k, cache_v, state, gq, gk, sinks, conv_w, conv_b, ln_g, ln_b, cosT, sinT, out, MIX, tid, wave, lane);
            else sample_conv(lds, j - MS, ZS, cache_k, cache_v, state, gq, gk, sinks, conv_w, conv_b, ln_g, ln_b, cosT, sinT, out, MIX, tid, wave, lane);
        }
        }
        STAMP(11);
        if (IN(3)) GRID_BAR(2);
    }
    if (IN(3)) {
        pg8::Gemm g{MIX, WoutT, MP, DM, DM}; pg8::StaticOrder S; S.init(MP, DM, G, bx);
        Epi3 E{XN, out + O_YP, X1G, g_mlp, args.dry ? SSQ + 16384 : SSQ};
        pg8::gemm_phase<Epi3, pg8::StaticOrder, true, true>(lds, g, S, E, wave_k);
        STAMP(13);
        EpiS3 ES{xs, out + O_YP, X1G, g_mlp, args.dry ? SSQ + 16384 : SSQ};
        skinny_phase(lds, MIX + (size_t)MP * DM, WoutT, DM, DM, G - 1 - bx, G, ES, wave_k);
        if (IN(4)) GRID_BAR(3);
    }
    if (IN(4)) { REPS(4) {
        pg8::Gemm g{X1G, WupT, MP, FF, DM}; pg8::StaticOrder S; S.init(MP, FF, G, bx);
        Epi4 E{SSQ, HID};
        EpiS4 ES{SSQ, HID};
        if (bx & 1) skinny_phase<2>(lds, X1G + (size_t)MP * DM, WupT, FF, DM, G - 1 - bx, G, ES, wave_k);
        pg8::gemm_phase<Epi4, pg8::StaticOrder, true, true>(lds, g, S, E, wave_k);
        if (!(bx & 1)) skinny_phase<2>(lds, X1G + (size_t)MP * DM, WupT, FF, DM, G - 1 - bx, G, ES, wave_k);
        }
        if (IN(5)) GRID_BAR(4);
    }
    if (IN(5)) {
        pg8::Gemm g{HID, WdnT, MP, DM, FF}; pg8::StaticOrder S; S.init(MP, DM, G, bx);
        Epi5 E{out + O_YP, X1G};
        pg8::gemm_phase<Epi5, pg8::StaticOrder, true, true>(lds, g, S, E, wave_k);
#ifdef MK_TA
        STAMP(8); __syncthreads();
        EpiS5 ES{out + O_YP, X1G, bx == G - 1 ? 1.0f + 1e-4f * (float)(long long)(__hip_atomic_load(TS + MK_TB, __ATOMIC_RELAXED, __HIP_MEMORY_SCOPE_AGENT) - __hip_atomic_load(TS + MK_TA, __ATOMIC_RELAXED, __HIP_MEMORY_SCOPE_AGENT)) : 1.0f};
#else
        EpiS5 ES{out + O_YP, X1G, 1.0f};
#endif
        skinny_phase(lds, HID + (size_t)MP * FF, WdnT, DM, FF, G - 1 - bx, G, ES, wave_k);
    }
#undef IN
}

extern "C" void kernel_launch(void* const* d_in, const int* in_sizes, int n_in, void* d_out, int out_size, void* d_ws, size_t ws_size, hipStream_t stream) {
    static int grid = 0;
    if (grid == 0) {
        if (n_in != 18 || (size_t)out_size != O_END || ws_size < WS_END) { fprintf(stderr, "kernel_launch: unexpected shapes: n_in %d out %d ws %zu\n", n_in, out_size, ws_size); grid = -1; return; }
        int dev = 0, cus = 0, per_cu = 0;
        if (hipGetDevice(&dev) != hipSuccess || hipDeviceGetAttribute(&cus, hipDeviceAttributeMultiprocessorCount, dev) != hipSuccess) { grid = -1; return; }
        if (hipFuncSetAttribute((const void*)mk_fwd, hipFuncAttributeMaxDynamicSharedMemorySize, LDS_BYTES) != hipSuccess) { fprintf(stderr, "kernel_launch: hipFuncSetAttribute failed\n"); grid = -1; return; }
        if (hipOccupancyMaxActiveBlocksPerMultiprocessor(&per_cu, (const void*)mk_fwd, NWAVES * 64, LDS_BYTES) != hipSuccess || per_cu < 1) { fprintf(stderr, "kernel_launch: occupancy query says %d\n", per_cu); (void)hipGetLastError(); grid = -1; return; }
        grid = cus;
    }
    if (grid < 0) return;
    (void)hipMemsetAsync((char*)d_ws + WS_CTL, 0, CTL_ZERO_BYTES, stream);
    Args a{};
    for (int i = 0; i < 18; ++i) a.in[i] = (const float*)d_in[i];
    a.out = (float*)d_out; a.ws = (unsigned char*)d_ws;
#if MK_N_LAUNCHES == 1 && defined(MK_PLAIN)
    a.ph_lo = 0; a.ph_hi = 6;
    hipLaunchKernelGGL(mk_fwd, dim3(grid), dim3(NWAVES * 64), LDS_BYTES, stream, a);
#elif MK_N_LAUNCHES == 1
    a.ph_lo = 0; a.ph_hi = 6;
    void* params[] = {&a};
    hipError_t e = hipLaunchCooperativeKernel((const void*)mk_fwd, dim3(grid), dim3(NWAVES * 64), params, LDS_BYTES, stream);
    if (e != hipSuccess) fprintf(stderr, "kernel_launch: cooperative launch failed: %s (grid %d)\n", hipGetErrorString(e), grid);
#else
    for (int p = 0; p < 6; ++p) for (int rep = 0; rep < (p == MK_DUP ? 2 : 1); ++rep) { a.ph_lo = p; a.ph_hi = p + 1; a.dry = (p == MK_DUP && rep == 0 && (p == 3 || p == 5)) ? 1 : 0; hipLaunchKernelGGL(mk_fwd, dim3(grid), dim3(NWAVES * 64), LDS_BYTES, stream, a); }
#endif
}
```
